# Optimizing an MI355X kernel written in HIP

```python
import math
import jax, jax.numpy as jnp
from jax import lax
import numpy as np

D_MODEL = 1024
BATCH = 2
SEQ = 8192
DEPTH = 1

MIX_WIDTH = D_MODEL
CONV_WIDTH = MIX_WIDTH // 2
FFT_WIDTH = MIX_WIDTH - CONV_WIDTH
GROUP_DIM = 64
CONV_HEADS = CONV_WIDTH // GROUP_DIM
FFT_GROUPS = FFT_WIDTH // GROUP_DIM
IN_PROJ_WIDTH = 3 * CONV_WIDTH + FFT_WIDTH
CONV_K = 3
MEM_LEN = 256
XATTN_HEADS = 4
XATTN_HEAD_DIM = D_MODEL // XATTN_HEADS
N_EXPERTS = 32
TOP_K = 4
D_EXPERT = D_MODEL
SWIGLU_LIMIT = 7.0
SWIGLU_ALPHA = 1.702
ROW_BLOCK = 128
EPS = 1e-5

kernel_name = "hymba_conv_fnet_xmem_moe_encoder"


def rmsnorm(x, g):
    xf = x.astype(jnp.float32)
    y = xf * lax.rsqrt(jnp.mean(xf * xf, axis=-1, keepdims=True) + EPS)
    return (y * g.astype(jnp.float32)).astype(x.dtype)


def short_conv3(u, w):
    up = jnp.pad(u, ((0, 0), (1, 1), (0, 0)))
    return w[0] * up[:, :-2] + w[1] * up[:, 1:-1] + w[2] * up[:, 2:]


def hybrid_mixer(h, w_in, conv_w, g_conv_out, g_fft_out, w_out):
    bsz, s, _ = h.shape
    z = h @ w_in
    b_gate = z[..., :CONV_WIDTH]
    c_gate = z[..., CONV_WIDTH:2 * CONV_WIDTH]
    v = z[..., 2 * CONV_WIDTH:3 * CONV_WIDTH]
    u = z[..., 3 * CONV_WIDTH:]
    y_conv = b_gate * short_conv3(c_gate * v, conv_w)
    uf = u.astype(jnp.float32).reshape(bsz, s, FFT_GROUPS, GROUP_DIM)
    y_fft = jnp.fft.fftn(uf, axes=(1, 3), norm="ortho").real
    y_fft = y_fft.reshape(bsz, s, FFT_WIDTH).astype(h.dtype)
    y = jnp.concatenate([rmsnorm(y_conv, g_conv_out), rmsnorm(y_fft, g_fft_out)], axis=-1)
    return y @ w_out


def memory_cross_attention(h, mem_n, w_q, w_k, w_v, w_o):
    bsz, s, d = h.shape
    m = mem_n.shape[1]
    q = (h @ w_q).reshape(bsz, s, XATTN_HEADS, XATTN_HEAD_DIM)
    k = (mem_n @ w_k).reshape(bsz, m, XATTN_HEADS, XATTN_HEAD_DIM)
    v = (mem_n @ w_v).reshape(bsz, m, XATTN_HEADS, XATTN_HEAD_DIM)
    scores = jnp.einsum('bshd,bmhd->bhsm', q, k).astype(jnp.float32) * (XATTN_HEAD_DIM ** -0.5)
    p = jax.nn.softmax(scores, axis=-1).astype(v.dtype)
    o = jnp.einsum('bhsm,bmhd->bshd', p, v).reshape(bsz, s, d)
    return o @ w_o


def moe_ffn(h, w_router, b_router, w_gate_up, b_gate_up, w_down, b_down):
    bsz, s, d = h.shape
    t = bsz * s
    hf = h.reshape(t, d)
    logits = (hf @ w_router).astype(jnp.float32) + b_router.astype(jnp.float32)
    top_v, top_i = lax.top_k(logits, TOP_K)
    top_w = jax.nn.softmax(top_v, axis=-1)
    n_assign = t * TOP_K
    flat_e = top_i.reshape(n_assign)
    flat_tok = jnp.repeat(jnp.arange(t, dtype=jnp.int32), TOP_K)
    flat_w = top_w.reshape(n_assign)
    order = jnp.argsort(flat_e)
    sorted_e = flat_e[order]
    counts = jnp.bincount(flat_e, length=N_EXPERTS)
    padded = ((counts + ROW_BLOCK - 1) // ROW_BLOCK) * ROW_BLOCK
    start = jnp.cumsum(counts) - counts
    pad_end = jnp.cumsum(padded)
    pad_start = pad_end - padded
    dest = pad_start[sorted_e] + jnp.arange(n_assign) - start[sorted_e]
    n_blocks = -(-n_assign // ROW_BLOCK) + N_EXPERTS
    n_rows = n_blocks * ROW_BLOCK
    row_tok = jnp.full((n_rows,), t, dtype=jnp.int32).at[dest].set(flat_tok[order])
    row_w = jnp.zeros((n_rows,), jnp.float32).at[dest].set(flat_w[order])
    block_e = jnp.minimum(
        jnp.searchsorted(pad_end, jnp.arange(n_blocks) * ROW_BLOCK, side='right'), N_EXPERTS - 1)
    h_pad = jnp.concatenate([hf, jnp.zeros((1, d), hf.dtype)], axis=0)
    xs = h_pad[row_tok].reshape(n_blocks, ROW_BLOCK, d)

    def expert_block(args):
        xb, e = args
        gu = xb @ w_gate_up[e] + b_gate_up[e]
        gate = jnp.minimum(gu[:, :D_EXPERT], SWIGLU_LIMIT)
        up = jnp.clip(gu[:, D_EXPERT:], -SWIGLU_LIMIT, SWIGLU_LIMIT)
        glu = gate * jax.nn.sigmoid(SWIGLU_ALPHA * gate)
        return ((up + 1.0) * glu) @ w_down[e] + b_down[e]

    out = lax.map(expert_block, (xs, block_e)).reshape(n_rows, d)
    y = jnp.zeros((t + 1, d), out.dtype).at[row_tok].add(out * row_w[:, None].astype(out.dtype))
    return y[:t].reshape(bsz, s, d)


def setup_inputs(seed: int = 0) -> dict:
    key = jax.random.key(seed)
    ks = jax.random.split(key, 24)
    f32 = jnp.float32

    def nrm(k, shape, scale):
        return jax.random.normal(k, shape, f32) * scale

    def gain(k, shape):
        return 1.0 + 0.02 * jax.random.normal(k, shape, f32)

    L = DEPTH
    return {
        "x": nrm(ks[0], (BATCH, SEQ, D_MODEL), 1.0),
        "mem": nrm(ks[1], (BATCH, MEM_LEN, D_MODEL), 1.0),
        "norm_mix": gain(ks[2], (L, D_MODEL)),
        "w_in": nrm(ks[3], (L, D_MODEL, IN_PROJ_WIDTH), D_MODEL ** -0.5),
        "conv_w": nrm(ks[4], (L, CONV_K, CONV_WIDTH), CONV_K ** -0.5),
        "g_conv_out": gain(ks[5], (L, CONV_WIDTH)),
        "g_fft_out": gain(ks[6], (L, FFT_WIDTH)),
        "w_out": nrm(ks[7], (L, MIX_WIDTH, D_MODEL), MIX_WIDTH ** -0.5),
        "norm_xattn": gain(ks[8], (L, D_MODEL)),
        "norm_mem": gain(ks[9], (L, D_MODEL)),
        "w_q": nrm(ks[10], (L, D_MODEL, D_MODEL), D_MODEL ** -0.5),
        "w_k": nrm(ks[11], (L, D_MODEL, D_MODEL), D_MODEL ** -0.5),
        "w_v": nrm(ks[12], (L, D_MODEL, D_MODEL), D_MODEL ** -0.5),
        "w_o": nrm(ks[13], (L, D_MODEL, D_MODEL), D_MODEL ** -0.5),
        "norm_ffn": gain(ks[14], (L, D_MODEL)),
        "w_router": nrm(ks[15], (L, D_MODEL, N_EXPERTS), D_MODEL ** -0.5),
        "b_router": nrm(ks[16], (L, N_EXPERTS), 0.01),
        "w_gate_up": nrm(ks[17], (L, N_EXPERTS, D_MODEL, 2 * D_EXPERT), D_MODEL ** -0.5),
        "b_gate_up": nrm(ks[18], (L, N_EXPERTS, 2 * D_EXPERT), 0.02),
        "w_down": nrm(ks[19], (L, N_EXPERTS, D_EXPERT, D_MODEL), D_EXPERT ** -0.5),
        "b_down": nrm(ks[20], (L, N_EXPERTS, D_MODEL), 0.02),
        "norm_final": gain(ks[21], (D_MODEL,)),
    }


def reference(x, mem, norm_mix, w_in, conv_w, g_conv_out, g_fft_out, w_out,
              norm_xattn, norm_mem, w_q, w_k, w_v, w_o, norm_ffn, w_router, b_router,
              w_gate_up, b_gate_up, w_down, b_down, norm_final):
    for l in range(DEPTH):
        h = rmsnorm(x, norm_mix[l])
        x = x + hybrid_mixer(h, w_in[l], conv_w[l], g_conv_out[l], g_fft_out[l], w_out[l])
        h = rmsnorm(x, norm_xattn[l])
        mem_n = rmsnorm(mem, norm_mem[l])
        x = x + memory_cross_attention(h, mem_n, w_q[l], w_k[l], w_v[l], w_o[l])
        h = rmsnorm(x, norm_ffn[l])
        x = x + moe_ffn(h, w_router[l], b_router[l], w_gate_up[l], b_gate_up[l], w_down[l], b_down[l])
    return rmsnorm(x, norm_final)
```

```cpp
#include <hip/hip_runtime.h>
#include <cstdio>
#include <cstdint>

#ifndef MK_ONE_LAUNCH
#define MK_ONE_LAUNCH 1
#endif
#ifndef MK_DUP
#define MK_DUP 0
#endif

__device__ __forceinline__ int lane_id() { return (int)__builtin_amdgcn_mbcnt_hi(~0u, __builtin_amdgcn_mbcnt_lo(~0u, 0u)) & 63; }
__device__ __forceinline__ void seam_arrive(unsigned long long* c1, bool leader);
__device__ __forceinline__ void seam_wait(unsigned* bar, unsigned long long* c1, unsigned* c2, bool leader);
namespace pg8 {
#define PG8_LAS __attribute__((address_space(3)))
typedef unsigned short bf16_t;
typedef short bf16x8 __attribute__((ext_vector_type(8)));
typedef float f32x4 __attribute__((ext_vector_type(4)));
typedef unsigned u32x4 __attribute__((ext_vector_type(4)));
typedef unsigned u32x2 __attribute__((ext_vector_type(2)));
constexpr int BM = 256, BK = 64, HALF = 128, HTB = HALF * BK * 2, STAGE_BYTES = 8 * HTB, NXCD = 8, WGM = 8;

__host__ __device__ __forceinline__ int lds_byte(int r, int c) { const int st = (r >> 4) * 2 + (c >> 5), rr = r & 15, cc = c & 31, ob = rr * 64 + cc * 2; return st * 1024 + (ob ^ (((ob >> 9) & 1) << 5)); }
__host__ __device__ __forceinline__ void stage_rc(int b, int& R, int& C) { const int st = b / 1024, sb = b % 1024, swz = sb ^ (((sb >> 9) & 1) << 5); R = (st >> 1) * 16 + swz / 64; C = (st & 1) * 32 + (swz % 64) / 2; }
__host__ __device__ __forceinline__ int perm32(int rho) { const int n = rho >> 4, i = rho & 15; return 8 * (i >> 2) + 4 * n + (i & 3); }

struct Unit { int pm, pn, e; };
struct Gemm { const bf16_t* A; const bf16_t* Bt; int K; size_t bstride; };

struct StaticOrder {
    static constexpr bool GATHER = false, HAS_SEAM = true;
    unsigned* sbar = nullptr; unsigned long long* sgs = nullptr;
    int nM, nN, nwg, G, c, eshift;
    __device__ __forceinline__ void init(int M, int N, int G_, int c_, int eshift_ = -1) { nM = M / BM; nN = N / BM; nwg = nM * nN; G = G_; c = c_; eshift = eshift_; }
    __device__ __forceinline__ bool next(int i, Unit& u) const {
        const long L = (long)i * G + c; if (L >= nwg) return false;
        int wgid = (int)L; { const int q = nwg / NXCD, r = nwg % NXCD, xcd = wgid % NXCD, off = wgid / NXCD; wgid = (xcd < r ? xcd * (q + 1) : r * (q + 1) + (xcd - r) * q) + off; }
        const int nig = WGM * nN, gid = wgid / nig, fm = gid * WGM, gsz = (nM - fm) < WGM ? (nM - fm) : WGM;
        u.pm = fm + ((wgid % nig) % gsz); u.pn = (wgid % nig) / gsz; u.e = eshift >= 0 ? (u.pm >> eshift) : 0; return true;
    }
    __device__ __forceinline__ int arow(int, int) const { return 0; }
};
template <bool GATHER_>
struct GroupedOrder {
    static constexpr bool GATHER = GATHER_, HAS_SEAM = false;
    int nM, nN, nwg, G, c;
    const PG8_LAS int* tile_e;
    const PG8_LAS int* tile0;
    const PG8_LAS int* cnt;
    const int* etok;
    int ecap;
    __device__ __forceinline__ bool next(int i, Unit& u) const {
        const long L = (long)i * G + c; if (L >= nwg) return false;
        int wgid = (int)L; { const int q = nwg / NXCD, r = nwg % NXCD, xcd = wgid % NXCD, off = wgid / NXCD; wgid = (xcd < r ? xcd * (q + 1) : r * (q + 1) + (xcd - r) * q) + off; }
        const int nig = WGM * nN, gid = wgid / nig, fm = gid * WGM, gsz = (nM - fm) < WGM ? (nM - fm) : WGM;
        u.pm = fm + ((wgid % nig) % gsz); u.pn = (wgid % nig) / gsz; u.e = tile_e[u.pm]; return true;
    }
    const PG8_LAS int* rowtok;
    __device__ __forceinline__ int arow(int ui, int r) const { return rowtok[ui * BM + r]; }
};

typedef float f32x2_t __attribute__((ext_vector_type(2)));
typedef float f32x16_t __attribute__((ext_vector_type(16)));
typedef unsigned u32x6 __attribute__((ext_vector_type(6)));
__device__ __forceinline__ u32x6 pk32_fp6(const f32x16_t s0, const f32x16_t s1) { return __builtin_amdgcn_cvt_scalef32_2xpk16_fp6_f32(s0, s1, 1.0f); }
typedef __bf16 bf16x2_t __attribute__((ext_vector_type(2)));
__device__ __forceinline__ unsigned cvt_pk_bf16(float lo, float hi) { const f32x2_t v = {lo, hi}; return __builtin_bit_cast(unsigned, __builtin_convertvector(v, bf16x2_t)); }

__device__ __forceinline__ unsigned pk4_fp8(float a, float b, float c, float d) { int v = __builtin_amdgcn_cvt_pk_fp8_f32(a, b, 0, false); v = __builtin_amdgcn_cvt_pk_fp8_f32(c, d, v, true); return (unsigned)v; }
struct EpiBf16 {
    struct Pre {}; __device__ __forceinline__ Pre pre(const Unit&, int, int, int, int) const { return Pre{}; }
    static constexpr bool PERM = true;
    bf16_t* O; int ldc; float scale;
    __device__ __forceinline__ void operator()(const f32x4 (&acc)[2][2][4][2], const Unit& u, int wr, int wc, int fr, int fq, const Pre& P) const {
        const int row0 = u.pm * BM + wr * 64 + fr, col0 = u.pn * BM + wc * 32 + 8 * fq;
#pragma unroll
        for (int ai = 0; ai < 2; ++ai)
#pragma unroll
            for (int m = 0; m < 4; ++m) { bf16_t* rowp = O + (size_t)(row0 + ai * HALF + m * 16) * ldc + col0;
#pragma unroll
                for (int bj = 0; bj < 2; ++bj) { const f32x4 v0 = acc[ai][bj][m][0] * scale, v1 = acc[ai][bj][m][1] * scale;
                    u32x4 w; w.x = cvt_pk_bf16(v0[0], v0[1]); w.y = cvt_pk_bf16(v0[2], v0[3]); w.z = cvt_pk_bf16(v1[0], v1[1]); w.w = cvt_pk_bf16(v1[2], v1[3]);
                    *(u32x4*)(rowp + bj * HALF) = w; } }
    }
};
struct EpiRowScaleBf16 {
    struct Pre { float rq[2][4]; };
    __device__ __forceinline__ Pre pre(const Unit& u, int wr, int, int fr, int) const { Pre p; const int row0 = u.pm * BM + wr * 64 + fr;
        _Pragma("unroll") for (int ai = 0; ai < 2; ++ai) _Pragma("unroll") for (int m = 0; m < 4; ++m) p.rq[ai][m] = rowsq[row0 + ai * HALF + m * 16]; return p; }
    static constexpr bool PERM = true;
    bf16_t* O; int ldc; const float* rowsq; float inv_n, eps, scale;
    __device__ __forceinline__ void operator()(const f32x4 (&acc)[2][2][4][2], const Unit& u, int wr, int wc, int fr, int fq, const Pre& P) const {
        const int row0 = u.pm * BM + wr * 64 + fr, col0 = u.pn * BM + wc * 32 + 8 * fq;
#pragma unroll
        for (int ai = 0; ai < 2; ++ai)
#pragma unroll
            for (int m = 0; m < 4; ++m) { const int r = row0 + ai * HALF + m * 16; const float s = __builtin_amdgcn_rsqf(P.rq[ai][m] * inv_n + eps) * scale;
                bf16_t* rowp = O + (size_t)r * ldc + col0;
#pragma unroll
                for (int bj = 0; bj < 2; ++bj) { const f32x4 v0 = acc[ai][bj][m][0] * s, v1 = acc[ai][bj][m][1] * s;
                    u32x4 w; w.x = cvt_pk_bf16(v0[0], v0[1]); w.y = cvt_pk_bf16(v0[2], v0[3]); w.z = cvt_pk_bf16(v1[0], v1[1]); w.w = cvt_pk_bf16(v1[2], v1[3]);
                    *(u32x4*)(rowp + bj * HALF) = w; } }
    }
};
struct EpiResidIn {
    struct Pre {}; __device__ __forceinline__ Pre pre(const Unit&, int, int, int, int) const { return Pre{}; }
    static constexpr bool PERM = true;
    const float* base; bf16_t* xo; unsigned char* x8; float* rowsq; int ldc;
    __device__ __forceinline__ void operator()(const f32x4 (&acc)[2][2][4][2], const Unit& u, int wr, int wc, int fr, int fq, const Pre& P) const {
        const int row0 = u.pm * BM + wr * 64 + fr, col0 = u.pn * BM + wc * 32 + 8 * fq;
#pragma unroll
        for (int ai = 0; ai < 2; ++ai) {
            f32x4 b[4][2][2];
#pragma unroll
            for (int m = 0; m < 4; ++m)
#pragma unroll
                for (int bj = 0; bj < 2; ++bj)
#pragma unroll
                    for (int n = 0; n < 2; ++n) b[m][bj][n] = *(const f32x4*)(base + (size_t)(row0 + ai * HALF + m * 16) * ldc + col0 + bj * HALF + 4 * n);
#pragma unroll
            for (int m = 0; m < 4; ++m) { const int r = row0 + ai * HALF + m * 16; const size_t off = (size_t)r * ldc + col0; float ss = 0.f;
#pragma unroll
                for (int bj = 0; bj < 2; ++bj) { const f32x4 v0 = b[m][bj][0] + acc[ai][bj][m][0], v1 = b[m][bj][1] + acc[ai][bj][m][1];
                    u32x4 w; w.x = cvt_pk_bf16(v0[0], v0[1]); w.y = cvt_pk_bf16(v0[2], v0[3]); w.z = cvt_pk_bf16(v1[0], v1[1]); w.w = cvt_pk_bf16(v1[2], v1[3]);
                    *(u32x4*)(xo + off + bj * HALF) = w;
                    u32x2 q; q.x = pk4_fp8(v0[0], v0[1], v0[2], v0[3]); q.y = pk4_fp8(v1[0], v1[1], v1[2], v1[3]); *(u32x2*)(x8 + off + bj * HALF) = q;
                    ss += ((v0[0] * v0[0] + v0[1] * v0[1]) + (v0[2] * v0[2] + v0[3] * v0[3])) + ((v1[0] * v1[0] + v1[1] * v1[1]) + (v1[2] * v1[2] + v1[3] * v1[3])); }
                ss += __shfl_xor(ss, 16); ss += __shfl_xor(ss, 32); if (fq == 0) atomicAdd(rowsq + r, ss); }
            asm volatile("" ::: "memory"); }
    }
};
struct EpiResidBf {
    struct Pre {}; __device__ __forceinline__ Pre pre(const Unit&, int, int, int, int) const { return Pre{}; }
    static constexpr bool PERM = true;
    bf16_t* x; int ldc; float ascale;
    __device__ __forceinline__ void operator()(const f32x4 (&acc)[2][2][4][2], const Unit& u, int wr, int wc, int fr, int fq, const Pre& P) const {
        const int row0 = u.pm * BM + wr * 64 + fr, col0 = u.pn * BM + wc * 32 + 8 * fq;
        u32x4 b[2][4][2];
#pragma unroll
        for (int ai = 0; ai < 2; ++ai)
#pragma unroll
            for (int m = 0; m < 4; ++m)
#pragma unroll
                for (int bj = 0; bj < 2; ++bj) b[ai][m][bj] = *(const u32x4*)(x + (size_t)(row0 + ai * HALF + m * 16) * ldc + col0 + bj * HALF);
#pragma unroll
        for (int ai = 0; ai < 2; ++ai)
#pragma unroll
            for (int m = 0; m < 4; ++m) { const size_t off = (size_t)(row0 + ai * HALF + m * 16) * ldc + col0;
#pragma unroll
                for (int bj = 0; bj < 2; ++bj) { const f32x4 a0 = acc[ai][bj][m][0] * ascale, a1 = acc[ai][bj][m][1] * ascale; const u32x4 p = b[ai][m][bj];
                    u32x4 w; w.x = cvt_pk_bf16(__builtin_bit_cast(float, p.x << 16) + a0[0], __builtin_bit_cast(float, p.x & 0xffff0000u) + a0[1]);
                    w.y = cvt_pk_bf16(__builtin_bit_cast(float, p.y << 16) + a0[2], __builtin_bit_cast(float, p.y & 0xffff0000u) + a0[3]);
                    w.z = cvt_pk_bf16(__builtin_bit_cast(float, p.z << 16) + a1[0], __builtin_bit_cast(float, p.z & 0xffff0000u) + a1[1]);
                    w.w = cvt_pk_bf16(__builtin_bit_cast(float, p.w << 16) + a1[2], __builtin_bit_cast(float, p.w & 0xffff0000u) + a1[3]);
                    *(u32x4*)(x + off + bj * HALF) = w; } }
    }
};
struct EpiSoftmaxF8 {
    static constexpr bool PERM = true;
    struct Pre { float rq[2][4]; };
    __device__ __forceinline__ Pre pre(const Unit& u, int wr, int, int fr, int) const { Pre p; const int row0 = u.pm * BM + wr * 64 + fr;
        _Pragma("unroll") for (int ai = 0; ai < 2; ++ai) _Pragma("unroll") for (int m = 0; m < 4; ++m) p.rq[ai][m] = rowsq[row0 + ai * HALF + m * 16]; return p; }
    unsigned char* O; int ldc; const float* rowsq; float inv_n, eps, sscale; PG8_LAS float* xch;
    __device__ __forceinline__ void operator()(f32x4 (&acc)[2][2][4][2], const Unit& u, int wr, int wc, int fr, int fq, const Pre& P) const {
        const int row0 = u.pm * BM + wr * 64 + fr, col0 = u.pn * BM + wc * 32 + 8 * fq, rl0 = wr * 64 + fr;
        float f[2][4];
#pragma unroll
        for (int ai = 0; ai < 2; ++ai)
#pragma unroll
            for (int m = 0; m < 4; ++m) { f[ai][m] = __builtin_amdgcn_rsqf(P.rq[ai][m] * inv_n + eps) * sscale; float mx = -INFINITY;
#pragma unroll
                for (int bj = 0; bj < 2; ++bj)
#pragma unroll
                    for (int n = 0; n < 2; ++n) { const f32x4 v = acc[ai][bj][m][n]; mx = fmaxf(mx, fmaxf(fmaxf(v[0], v[1]), fmaxf(v[2], v[3]))); }
                mx = fmaxf(mx, __shfl_xor(mx, 16)); mx = fmaxf(mx, __shfl_xor(mx, 32));
                if (fq == 0) xch[(rl0 + ai * HALF + m * 16) * 4 + wc] = mx * f[ai][m]; }
        asm volatile("s_waitcnt lgkmcnt(0)" ::: "memory"); __builtin_amdgcn_s_barrier(); asm volatile("" ::: "memory");
#pragma unroll
        for (int ai = 0; ai < 2; ++ai)
#pragma unroll
            for (int m = 0; m < 4; ++m) { const f32x4 x4 = *(const PG8_LAS f32x4*)(xch + (rl0 + ai * HALF + m * 16) * 4); const float M = fmaxf(fmaxf(x4[0], x4[1]), fmaxf(x4[2], x4[3])); float sm = 0.f;
#pragma unroll
                for (int bj = 0; bj < 2; ++bj)
#pragma unroll
                    for (int n = 0; n < 2; ++n) { f32x4 v = acc[ai][bj][m][n];
#pragma unroll
                        for (int i = 0; i < 4; ++i) { v[i] = __builtin_amdgcn_exp2f(v[i] * f[ai][m] - M); sm += v[i]; }
                        acc[ai][bj][m][n] = v; }
                sm += __shfl_xor(sm, 16); sm += __shfl_xor(sm, 32);
                if (fq == 0) xch[1024 + (rl0 + ai * HALF + m * 16) * 4 + wc] = sm; }
        asm volatile("s_waitcnt lgkmcnt(0)" ::: "memory"); __builtin_amdgcn_s_barrier(); asm volatile("" ::: "memory");
#pragma unroll
        for (int ai = 0; ai < 2; ++ai)
#pragma unroll
            for (int m = 0; m < 4; ++m) { const f32x4 s4 = *(const PG8_LAS f32x4*)(xch + 1024 + (rl0 + ai * HALF + m * 16) * 4); const float sc = 128.0f * __builtin_amdgcn_rcpf((s4[0] + s4[1]) + (s4[2] + s4[3]));
                unsigned char* rowp = O + (size_t)(row0 + ai * HALF + m * 16) * ldc + col0;
#pragma unroll
                for (int bj = 0; bj < 2; ++bj) { const f32x4 v0 = acc[ai][bj][m][0] * sc, v1 = acc[ai][bj][m][1] * sc;
                    u32x2 w; w.x = pk4_fp8(v0[0], v0[1], v0[2], v0[3]); w.y = pk4_fp8(v1[0], v1[1], v1[2], v1[3]); *(u32x2*)(rowp + bj * HALF) = w; } }
    }
};
struct EpiSwiGLU {
    struct Pre { f32x4 bgv[2], buv[2]; };
    __device__ __forceinline__ Pre pre(const Unit& u, int, int wc, int, int fq) const { Pre p; const float* bg = bias + (size_t)u.e * 2048 + u.pn * HALF + wc * 32 + 8 * fq;
        _Pragma("unroll") for (int n = 0; n < 2; ++n) { p.bgv[n] = *(const f32x4*)(bg + 4 * n); p.buv[n] = *(const f32x4*)(bg + 1024 + 4 * n); } return p; }
    static constexpr bool PERM = true;
    unsigned char* O; const float* bias; float wscale;
    __device__ __forceinline__ void operator()(const f32x4 (&acc)[2][2][4][2], const Unit& u, int wr, int wc, int fr, int fq, const Pre& P) const {
        const int row0 = u.pm * BM + wr * 64 + fr, colj = u.pn * HALF + wc * 32 + 8 * fq;
#pragma unroll
        for (int ai = 0; ai < 2; ++ai)
#pragma unroll
            for (int m = 0; m < 4; ++m) { unsigned char* rowp = O + (size_t)(row0 + ai * HALF + m * 16) * 1024 + colj; float o[8];
#pragma unroll
                for (int n = 0; n < 2; ++n) { const f32x4 g4 = acc[ai][0][m][n] * wscale + P.bgv[n], u4 = acc[ai][1][m][n] * wscale + P.buv[n];
#pragma unroll
                    for (int i = 0; i < 4; ++i) { const float g = fminf(g4[i], 7.0f), up = fminf(fmaxf(u4[i], -7.0f), 7.0f);
                        const float sg = __builtin_amdgcn_rcpf(1.0f + __builtin_amdgcn_exp2f(g * (-1.702f * 1.44269504f)));
                        o[4 * n + i] = (up + 1.0f) * (g * sg); } }
                u32x2 w; w.x = pk4_fp8(o[0], o[1], o[2], o[3]); w.y = pk4_fp8(o[4], o[5], o[6], o[7]);
                *(u32x2*)rowp = w; }
    }
};
struct EpiBiasF8 {
    static constexpr bool PERM = true;
    struct Pre { f32x4 bv[2][2]; };
    __device__ __forceinline__ Pre pre(const Unit& u, int, int wc, int, int fq) const { Pre p; const float* bp = bias + (size_t)u.e * 1024 + u.pn * BM + wc * 32 + 8 * fq;
        _Pragma("unroll") for (int bj = 0; bj < 2; ++bj) _Pragma("unroll") for (int n = 0; n < 2; ++n) p.bv[bj][n] = *(const f32x4*)(bp + bj * HALF + 4 * n); return p; }
    unsigned char* O; const float* bias; float wscale;
    __device__ __forceinline__ void operator()(const f32x4 (&acc)[2][2][4][2], const Unit& u, int wr, int wc, int fr, int fq, const Pre& P) const {
        const int row0 = u.pm * BM + wr * 64 + fr, col0 = u.pn * BM + wc * 32 + 8 * fq;
#pragma unroll
        for (int ai = 0; ai < 2; ++ai)
#pragma unroll
            for (int m = 0; m < 4; ++m) { unsigned char* rowp = O + (size_t)(row0 + ai * HALF + m * 16) * 1024 + col0;
#pragma unroll
                for (int bj = 0; bj < 2; ++bj) { const f32x4 v0 = acc[ai][bj][m][0] * wscale + P.bv[bj][0], v1 = acc[ai][bj][m][1] * wscale + P.bv[bj][1];
                    u32x2 w; w.x = pk4_fp8(v0[0], v0[1], v0[2], v0[3]); w.y = pk4_fp8(v1[0], v1[1], v1[2], v1[3]);
                    *(u32x2*)(rowp + bj * HALF) = w; } }
    }
};

typedef int i32x4 __attribute__((ext_vector_type(4)));
typedef int i32x8 __attribute__((ext_vector_type(8)));
__device__ __forceinline__ i32x8 cat16(bf16x8 a, bf16x8 b) { return __builtin_shufflevector(__builtin_bit_cast(i32x4, a), __builtin_bit_cast(i32x4, b), 0, 1, 2, 3, 4, 5, 6, 7); }
typedef int i32x6 __attribute__((ext_vector_type(6)));
typedef bf16x8 __attribute__((aligned(8))) bf16x8_a8;
__device__ __forceinline__ i32x6 cat6(bf16x8 a, bf16x8 b) { return __builtin_shufflevector(__builtin_bit_cast(i32x4, a), __builtin_bit_cast(i32x4, b), 0, 1, 2, 3, 4, 5); }
constexpr int B6_KT = 256 * 96, B6_TILE = 8 * B6_KT;
template <class Epi, class Sched, bool ALIGN_EPI, int FP8 = 0>
__device__ __forceinline__ void gemm_phase(PG8_LAS unsigned char* lds, const Gemm g, const Sched& S, const Epi& E, int wid) {
    const int lane = lane_id(), tid = wid * 64 + lane, wr = wid >> 2, wc = wid & 3, fr = lane & 15, fq = lane >> 4;
    const int K = g.K, nt = K / BK, kmask = nt - 1, krot = nt >> 3;
    bool ownk = false; if constexpr (Sched::HAS_SEAM) ownk = (S.sgs != nullptr);
#define PG8_KOFF(u) (ownk ? (((u).pn * 2) & kmask) : (((u).pm + (u).pn) * krot & kmask))
    unsigned voffA[2], voffB[2]; int RA[2], CA[2];
#pragma unroll
    for (int i = 0; i < 2; ++i) { int R, C; stage_rc(tid * 16 + i * 8192, R, C); const int Rb = Epi::PERM ? ((R & ~31) + perm32(R & 31)) : R;
        RA[i] = R; CA[i] = C; voffA[i] = (unsigned)(R * K + C) * 2u; voffB[i] = (unsigned)(Rb * K + C) * 2u; }
    const size_t kstep = (size_t)(BK * 2);
    const size_t hstep = (size_t)HALF * K * 2;
    const size_t tstep = 2 * hstep;
    const unsigned ldsw = (unsigned)wid * 1024u;
    const int aoff = lds_byte(wr * 64 + fr, fq * 8), boff = (FP8 == 2) ? (wc * 32 + fr) * 96 + ((fq + 2 * (fr >> 3)) & 3) * 24 : lds_byte(wc * 32 + fr, fq * 8);
    const unsigned voffB6 = (unsigned)tid * 16u;
#define PG8_SA(b, h) (((b) * 2 + (h)) * HTB)
#define PG8_SB(b, h) ((4 + (b) * 2 + (h)) * HTB)
#define PG8_STAGEB6(b, gbase) do { _Pragma("unroll") for (int _i = 0; _i < 3; ++_i) \
        __builtin_amdgcn_global_load_lds((const unsigned*)((const char*)(gbase) + voffB6 + _i * 8192), (PG8_LAS unsigned*)(lds + PG8_SB(b, 0) + ldsw + _i * 8192), 16, 0, 0); } while (0)
#define PG8_STB(b, pb, p6) do { if constexpr (FP8 == 2) { PG8_STAGEB6(b, p6); } else { PG8_STAGE(PG8_SB(b, 0), pb, voffB); PG8_STAGE(PG8_SB(b, 1), (pb) + hstep, voffB); } } while (0)
#define PG8_STAGE(bufoff, gbase, voff) do { _Pragma("unroll") for (int _i = 0; _i < 2; ++_i) \
        __builtin_amdgcn_global_load_lds((const unsigned*)((const char*)(gbase) + (voff)[_i]), (PG8_LAS unsigned*)(lds + (bufoff) + ldsw + _i * 8192), 16, 0, 0); } while (0)
#define PG8_STAGE2(bufoff, gbase, v0, v1) do { \
        __builtin_amdgcn_global_load_lds((const unsigned*)((const char*)(gbase) + (v0)), (PG8_LAS unsigned*)(lds + (bufoff) + ldsw), 16, 0, 0); \
        __builtin_amdgcn_global_load_lds((const unsigned*)((const char*)(gbase) + (v1)), (PG8_LAS unsigned*)(lds + (bufoff) + ldsw + 8192), 16, 0, 0); } while (0)
#define PG8_STA(bufoff, h, pNG, pG, nx) do { if constexpr (Sched::GATHER) { const unsigned _v0 = (nx) ? nv[h][0] : cv[h][0], _v1 = (nx) ? nv[h][1] : cv[h][1]; PG8_STAGE2(bufoff, pG, _v0, _v1); } \
        else { PG8_STAGE(bufoff, (pNG) + (h) * hstep, voffA); } } while (0)
#define PG8_LDA(dst, b, h) do { _Pragma("unroll") for (int m = 0; m < 4; ++m) _Pragma("unroll") for (int k = 0; k < 2; ++k) dst[m][k] = *(const PG8_LAS bf16x8*)(lds + PG8_SA(b, h) + aoff + m * 2048 + k * 1024); } while (0)
#define PG8_LDB(dst, b, h) do { if constexpr (FP8 == 2) { _Pragma("unroll") for (int n = 0; n < 2; ++n) { const PG8_LAS unsigned char* _p = lds + PG8_SB(b, 0) + boff + (h) * 12288 + n * 1536; \
            const u32x2 _t0 = *(const volatile PG8_LAS u32x2*)_p, _t1 = *(const volatile PG8_LAS u32x2*)(_p + 8), _t2 = *(const volatile PG8_LAS u32x2*)(_p + 16); \
            dst[n][0] = __builtin_bit_cast(bf16x8, __builtin_shufflevector(_t0, _t1, 0, 1, 2, 3)); dst[n][1] = __builtin_bit_cast(bf16x8, __builtin_shufflevector(_t2, _t2, 0, 1, -1, -1)); } } \
        else { _Pragma("unroll") for (int n = 0; n < 2; ++n) _Pragma("unroll") for (int k = 0; k < 2; ++k) dst[n][k] = *(const PG8_LAS bf16x8*)(lds + PG8_SB(b, h) + boff + n * 2048 + k * 1024); } } while (0)
#define PG8_MMA(ai, bj, At, Bt) do { __builtin_amdgcn_s_setprio(1); \
        if constexpr (FP8 == 2) { _Pragma("unroll") for (int m = 0; m < 4; ++m) _Pragma("unroll") for (int n = 0; n < 2; ++n) \
            asm volatile("s_nop 1\n\tv_mfma_scale_f32_16x16x128_f8f6f4 %0, %1, %2, %0, %3, %3 op_sel_hi:[0,0,0] cbsz:2" : "+v"(acc[ai][bj][m][n]) : "v"(cat6(Bt[n][0], Bt[n][1])), "v"(cat16(At[m][0], At[m][1])), "v"(mxs)); } \
        else if constexpr (FP8 == 1) { _Pragma("unroll") for (int m = 0; m < 4; ++m) _Pragma("unroll") for (int n = 0; n < 2; ++n) \
            asm volatile("v_mfma_scale_f32_16x16x128_f8f6f4 %0, %1, %2, %0, %3, %3 op_sel_hi:[0,0,0]" : "+v"(acc[ai][bj][m][n]) : "v"(cat16(Bt[n][0], Bt[n][1])), "v"(cat16(At[m][0], At[m][1])), "v"(mxs)); } \
        else { _Pragma("unroll") for (int m = 0; m < 4; ++m) _Pragma("unroll") for (int n = 0; n < 2; ++n) _Pragma("unroll") for (int k = 0; k < 2; ++k) \
            acc[ai][bj][m][n] = __builtin_amdgcn_mfma_f32_16x16x32_bf16(Bt[n][k], At[m][k], acc[ai][bj][m][n], 0, 0, 0); } \
        __builtin_amdgcn_s_setprio(0); } while (0)
#define PG8_WAIT_V(n) asm volatile("s_waitcnt vmcnt(" #n ")" ::: "memory")
#define PG8_WAIT_L(n) asm volatile("s_waitcnt lgkmcnt(" #n ")" ::: "memory")
#define PG8_WAIT_VK do { if constexpr (FP8 == 2) PG8_WAIT_V(7); else PG8_WAIT_V(8); } while (0)
#define PG8_BAR __builtin_amdgcn_s_barrier()
#define PG8_SCHED __builtin_amdgcn_sched_barrier(0)
    Unit cur, nxt; int ui = 0;
    if (!S.next(0, cur)) return;
    if constexpr (Sched::HAS_SEAM) { if (S.sgs) seam_arrive(S.sgs, wid == 0 && lane == 0); }
    const int mxs = 0x7f7f7f7f;
    f32x4 acc[2][2][4][2];
#pragma unroll
    for (int a = 0; a < 2; ++a)
#pragma unroll
        for (int b = 0; b < 2; ++b)
#pragma unroll
            for (int m = 0; m < 4; ++m)
#pragma unroll
                for (int n = 0; n < 2; ++n) acc[a][b][m][n] = (f32x4){0.f, 0.f, 0.f, 0.f};
    bf16x8 At[4][2], B0[2][2], B1[2][2];
    const char* gA0 = (const char*)g.A;
    const size_t btstep = (FP8 == 2) ? (size_t)B6_TILE : tstep, kmulB = (FP8 == 2) ? (size_t)(B6_KT / (BK * 2)) : (size_t)1;
    const char* cA = gA0 + (size_t)cur.pm * tstep; const char* cB = (const char*)g.Bt + (size_t)cur.e * g.bstride + (size_t)cur.pn * btstep;
    unsigned cv[2][2], nv[2][2];
#pragma unroll
    for (int h = 0; h < 2; ++h)
#pragma unroll
        for (int i = 0; i < 2; ++i) { cv[h][i] = 0u; nv[h][i] = 0u; }
    if constexpr (Sched::GATHER) {
#pragma unroll
        for (int h = 0; h < 2; ++h)
#pragma unroll
            for (int i = 0; i < 2; ++i) cv[h][i] = ((unsigned)S.arow(0, h * HALF + RA[i]) * (unsigned)K + (unsigned)CA[i]) * 2u;
    }
    int coff = PG8_KOFF(cur);
    { const size_t k0 = (size_t)coff * kstep, k1 = (size_t)((coff + 1) & kmask) * kstep;
    PG8_STB(0, cB + k0 * kmulB, cB + k0 * kmulB); PG8_STA(PG8_SA(0, 0), 0, cA + k0, gA0 + k0, false); PG8_STA(PG8_SA(0, 1), 1, cA + k0, gA0 + k0, false);
    if (wr == 1) PG8_BAR;
    PG8_WAIT_V(2); PG8_BAR;
    if constexpr (FP8 == 2) { PG8_STB(1, cB + k1 * kmulB, cB + k1 * kmulB); PG8_STA(PG8_SA(1, 0), 0, cA + k1, gA0 + k1, false); }
    else { PG8_STAGE(PG8_SB(1, 0), cB + k1, voffB); PG8_STA(PG8_SA(1, 0), 0, cA + k1, gA0 + k1, false); PG8_STAGE(PG8_SB(1, 1), cB + hstep + k1, voffB); } }
    if constexpr (FP8 == 2) PG8_WAIT_V(5); else PG8_WAIT_V(6);
    PG8_BAR;
    if constexpr (Sched::HAS_SEAM) { if (S.sgs) seam_wait(S.sbar, S.sgs, (unsigned*)S.sgs + 2, wid == 0 && lane == 0); }
    for (;;) {
        const bool has_next = S.next(ui + 1, nxt);
        const typename Epi::Pre epre = E.pre(cur, wr, wc, fr, fq);
        const int noff = has_next ? PG8_KOFF(nxt) : coff;
        const char* nA = has_next ? gA0 + (size_t)nxt.pm * tstep : cA; const char* nB = has_next ? (const char*)g.Bt + (size_t)nxt.e * g.bstride + (size_t)nxt.pn * btstep : cB;
        if constexpr (Sched::GATHER) {
#pragma unroll
            for (int h = 0; h < 2; ++h)
#pragma unroll
                for (int i = 0; i < 2; ++i) nv[h][i] = has_next ? ((unsigned)S.arow(ui + 1, h * HALF + RA[i]) * (unsigned)K + (unsigned)CA[i]) * 2u : cv[h][i];
        }
#pragma unroll 1
        for (int t = 0; t < nt; t += 2) {
            const bool last = (t == nt - 2);
            const size_t k1 = (size_t)((t + 1 + coff) & kmask) * kstep, k2 = (size_t)((last ? noff : t + 2 + coff) & kmask) * kstep, k3 = (size_t)((last ? noff + 1 : t + 3 + coff) & kmask) * kstep;
            const char* pa = last ? nA : cA; const char* pb = last ? nB : cB;
            const char* a1 = cA + k1; const char* a1g = gA0 + k1;
            const char* a2 = pa + k2; const char* b2 = pb + k2 * kmulB; const char* a2g = gA0 + k2;
            const char* a3 = pa + k3; const char* b3 = pb + k3 * kmulB; const char* a3g = gA0 + k3;
            PG8_LDB(B0, 0, 0); PG8_LDB(B1, 0, 1); PG8_SCHED; PG8_LDA(At, 0, 0); PG8_STA(PG8_SA(1, 1), 1, a1, a1g, false);
            PG8_WAIT_VK; PG8_WAIT_L(0); PG8_BAR; PG8_MMA(0, 0, At, B0); PG8_MMA(0, 1, At, B1); PG8_BAR; PG8_SCHED;
            PG8_LDA(At, 0, 1); PG8_STB(0, b2, b2); PG8_STA(PG8_SA(0, 0), 0, a2, a2g, last);
            PG8_WAIT_VK; PG8_WAIT_L(0); PG8_BAR; PG8_MMA(1, 0, At, B0); PG8_MMA(1, 1, At, B1); PG8_BAR; PG8_SCHED;
            PG8_LDB(B0, 1, 0); PG8_LDB(B1, 1, 1); PG8_SCHED; PG8_LDA(At, 1, 0); PG8_STA(PG8_SA(0, 1), 1, a2, a2g, last);
            PG8_WAIT_VK; PG8_WAIT_L(0); PG8_BAR; PG8_MMA(0, 0, At, B0); PG8_MMA(0, 1, At, B1); PG8_BAR; PG8_SCHED;
            PG8_LDA(At, 1, 1); PG8_STB(1, b3, b3); PG8_STA(PG8_SA(1, 0), 0, a3, a3g, last);
            PG8_WAIT_VK; PG8_WAIT_L(0); PG8_BAR; PG8_MMA(1, 0, At, B0); PG8_MMA(1, 1, At, B1); PG8_BAR; PG8_SCHED;
        }
        if constexpr (ALIGN_EPI) { if (wr == 0) PG8_BAR; }
        if constexpr (FP8) asm volatile("s_nop 15\n\ts_nop 3" ::: "memory");
        { int le = lane; asm volatile("" : "+v"(le));
          E(acc, cur, wr, wc, le & 15, le >> 4, epre); }
        if (!has_next) break;
#pragma unroll
        for (int a = 0; a < 2; ++a)
#pragma unroll
            for (int b = 0; b < 2; ++b)
#pragma unroll
                for (int m = 0; m < 4; ++m)
#pragma unroll
                    for (int n = 0; n < 2; ++n) acc[a][b][m][n] = (f32x4){0.f, 0.f, 0.f, 0.f};
        cur = nxt; cA = nA; cB = nB; coff = noff; ++ui;
        if constexpr (Sched::GATHER) {
#pragma unroll
            for (int h = 0; h < 2; ++h)
#pragma unroll
                for (int i = 0; i < 2; ++i) cv[h][i] = nv[h][i];
        }
        if constexpr (ALIGN_EPI) { if (wr == 1) PG8_BAR; }
    }
    PG8_WAIT_V(0);
    if constexpr (!ALIGN_EPI) { if (wr == 0) PG8_BAR; }
    PG8_BAR;
#undef PG8_KOFF
#undef PG8_SA
#undef PG8_SB
#undef PG8_STAGE
#undef PG8_STAGE2
#undef PG8_STA
#undef PG8_LDA
#undef PG8_LDB
#undef PG8_MMA
#undef PG8_WAIT_V
#undef PG8_WAIT_L
#undef PG8_WAIT_VK
#undef PG8_STB
#undef PG8_STAGEB6
#undef PG8_BAR
#undef PG8_SCHED
}
}

constexpr int NWAVES = 8, NTHR = NWAVES * 64;
constexpr int BATCH = 2, SEQ = 8192, D = 1024, M = BATCH * SEQ;
constexpr int NZ = 2048;
constexpr int CW = 512;
constexpr int MEMLEN = 256, NH = 4, HD = 256, MKV = BATCH * MEMLEN;
constexpr int NE = 32, TOPK = 4, DE = 1024, ECAP = 16384;
constexpr int MAXTILES = (M * TOPK) / 256 + NE;
constexpr float EPS = 1e-5f;
constexpr float WSCALE = 32.0f;
constexpr float QSCALE = 0.0625f * 1.44269504f;
constexpr int FN1 = 128, FN2 = 64;

constexpr size_t MiB = 1u << 20;
constexpr size_t WS_CTL = 0, CTL_ZERO_BYTES = 1 * MiB;
constexpr size_t WS_WINT = 2 * MiB, WS_WOUTT = 6 * MiB, WS_WQT = 8 * MiB, WS_WKT = 10 * MiB, WS_WVT = 12 * MiB, WS_WOT = 14 * MiB;
constexpr size_t WS_WRG = 16 * MiB;
constexpr size_t WS_TAB = 17 * MiB;
constexpr size_t WS_MC = 18 * MiB;
constexpr size_t WS_MEMN = 22 * MiB, WS_KB = 23 * MiB, WS_VT = 24 * MiB;
constexpr size_t WS_TOK = 25 * MiB;
constexpr size_t WS_ETOK = 26 * MiB;
constexpr size_t WS_WGUT = 32 * MiB, WS_WDT = 160 * MiB;
constexpr size_t WS_XR = 224 * MiB;
constexpr size_t WS_XN3 = 288 * MiB;
constexpr size_t WS_CTR = 320 * MiB;
constexpr size_t WS_XN = 464 * MiB, WS_Z = 496 * MiB, WS_G = 560 * MiB, WS_Y = 592 * MiB, WS_XB = 624 * MiB, WS_Q = 656 * MiB, WS_O = 688 * MiB;
constexpr size_t WS_ACT = 464 * MiB;
constexpr size_t WS_WQN = 28 * MiB, WS_WOT16 = 30 * MiB;
constexpr size_t WS_MK = WS_Q, WS_MV = WS_Q + 2 * MiB;
constexpr size_t WS_P = WS_O;
constexpr size_t WS_END = 720 * MiB;
constexpr size_t TAB_WA = 128 * 1024;
constexpr size_t TAB_DCH = 256 * 1024;
constexpr int CW_BAR = 4096;
constexpr int CW_CNT = 8192;
constexpr int CW_ROWSQ = 16384;
constexpr int CW_GRP = 65536;
static_assert((CW_GRP + 64 * 64 * 3) * 4 <= (int)CTL_ZERO_BYTES, "ctl");
static_assert((CW_ROWSQ + M) * 4 <= (int)CTL_ZERO_BYTES, "ctl");

constexpr int LDS_BYTES = 147456;
constexpr int RING_BYTES = 131072, LDSCTL_OFF = LDS_BYTES - 512, MISC_OFF = LDSCTL_OFF + 320;
constexpr int MOE_TAB_OFF = 143360;

#define GAS __attribute__((address_space(1)))
#define LAS __attribute__((address_space(3)))
typedef unsigned short bf16;
typedef unsigned v4u __attribute__((ext_vector_type(4)));
typedef unsigned v2u __attribute__((ext_vector_type(2)));
typedef float f32x4 __attribute__((ext_vector_type(4)));
typedef GAS unsigned gu32;
typedef float f32x2v __attribute__((ext_vector_type(2)));
#define RLX_AGENT __ATOMIC_RELAXED, __HIP_MEMORY_SCOPE_AGENT
#define LDS_WAIT() asm volatile("s_waitcnt lgkmcnt(0)" ::: "memory")
__device__ __forceinline__ unsigned pk2(float lo, float hi) { return pg8::cvt_pk_bf16(lo, hi); }
__device__ __forceinline__ unsigned f2bf(float f) { return pg8::cvt_pk_bf16(f, 0.f) & 0xffffu; }
__device__ __forceinline__ float bf2f(unsigned short b) { return __builtin_bit_cast(float, (unsigned)b << 16); }
__device__ __forceinline__ float bflo(unsigned w) { return __builtin_bit_cast(float, w << 16); }
__device__ __forceinline__ float bfhi(unsigned w) { return __builtin_bit_cast(float, w & 0xffff0000u); }

#define XB_TMO      128
#define XB_XCNT(j)  (256  + 64 * (j))
#define XB_XSUB(j)  (1280 + 64 * (j))
#define XB_XGEN(j)  (2304 + 64 * (j))
#define XB_TOP      3328
#define XB_TOPGEN   3392
#define XCD_BAR_WORDS 3456
#define XB_SPIN_CAP (1u << 18)
__device__ __forceinline__ unsigned xb_ld(unsigned* p)              { return __hip_atomic_load(p, __ATOMIC_RELAXED, __HIP_MEMORY_SCOPE_AGENT); }
__device__ __forceinline__ unsigned xb_add(unsigned* p, unsigned v) { return __hip_atomic_fetch_add(p, v, __ATOMIC_RELAXED, __HIP_MEMORY_SCOPE_AGENT); }
__device__ __forceinline__ unsigned xb_xcc_id() { return (unsigned)__builtin_amdgcn_s_getreg((3 << 11) | 20) & 0xFu; }
#define XB_SPIN(cond, bar) do { unsigned _sp = 0; while (cond) { __builtin_amdgcn_s_sleep(1); \
    if ((++_sp & 255u) == 0u) { if (xb_ld(&(bar)[XB_TMO])) break; if (_sp > XB_SPIN_CAP) { atomicAdd(&(bar)[XB_TMO], 1u); break; } } } } while (0)
struct XcdBarrier { unsigned* bar; unsigned x; volatile LAS unsigned* st; };
__device__ __forceinline__ XcdBarrier xcd_barrier_post(unsigned* bar, volatile LAS unsigned* st, bool leader) {
    XcdBarrier b; b.bar = bar; b.x = xb_xcc_id(); b.st = st;
    if (leader) (void)xb_add(&bar[XB_XCNT(b.x)], 1u);
    return b;
}
__device__ __forceinline__ void xcd_barrier_complete(unsigned* bar, unsigned x, unsigned& nloc, unsigned& nx) {
    const unsigned G = gridDim.x * gridDim.y * gridDim.z;
    unsigned sum, cnt, mine, sp = 0u;
    for (;;) {
        sum = 0u; cnt = 0u; mine = 0u;
#pragma unroll
        for (unsigned j = 0; j < 16; ++j) { const unsigned c = xb_ld(&bar[XB_XCNT(j)]); sum += c; cnt += (c > 0u) ? 1u : 0u; mine = (j == x) ? c : mine; }
        if (sum == G) break;
        __builtin_amdgcn_s_sleep(1);
        if ((++sp & 255u) == 0u) { if (xb_ld(&bar[XB_TMO])) break; if (sp > XB_SPIN_CAP) { atomicAdd(&bar[XB_TMO], 1u); break; } }
    }
    nloc = mine > 0u ? mine : 1u; nx = cnt > 0u ? cnt : 1u;
}
__device__ __forceinline__ void xcd_barrier(const XcdBarrier& b, bool leader) {
    asm volatile("s_waitcnt vmcnt(0)" ::: "memory");
    __syncthreads();
    if (leader) {
        unsigned* bar = b.bar;
        __builtin_amdgcn_s_waitcnt(0);
        unsigned nloc = b.st[0], nx = b.st[1];
        if (nloc == 0u) { xcd_barrier_complete(bar, b.x, nloc, nx); b.st[0] = nloc; b.st[1] = nx; }
        const unsigned old = xb_add(&bar[XB_XSUB(b.x)], 1u);
        const unsigned gen = old / nloc;
        if (old + 1u == (gen + 1u) * nloc) {
            __builtin_amdgcn_fence(__ATOMIC_RELEASE, "agent");
            asm volatile("s_waitcnt vmcnt(0)" ::: "memory");
            const unsigned og = xb_add(&bar[XB_TOP], 1u);
            const unsigned tg = og / nx;
            if (og + 1u == (tg + 1u) * nx) xb_add(&bar[XB_TOPGEN], 1u);
            else XB_SPIN(xb_ld(&bar[XB_TOPGEN]) == tg, bar);
            __builtin_amdgcn_fence(__ATOMIC_ACQUIRE, "agent");
            xb_add(&bar[XB_XGEN(b.x)], 1u);
            asm volatile("s_waitcnt vmcnt(0)" ::: "memory");
        } else {
            XB_SPIN(xb_ld(&bar[XB_XGEN(b.x)]) == gen, bar);
            __builtin_amdgcn_fence(__ATOMIC_ACQUIRE, "agent");
            asm volatile("s_waitcnt vmcnt(0)" ::: "memory");
        }
    }
    __syncthreads();
}

constexpr unsigned NGRP = 4;
__device__ __forceinline__ void group_sync(unsigned* bar, unsigned long long* c1, unsigned* c2, bool leader) {
    asm volatile("s_waitcnt vmcnt(0)" ::: "memory");
    __syncthreads();
    if (leader) {
        __builtin_amdgcn_s_waitcnt(0);
        const unsigned x = xb_xcc_id();
        (void)__hip_atomic_fetch_add(c1, 1ull | (1ull << (8 + 3 * x)), __ATOMIC_RELAXED, __HIP_MEMORY_SCOPE_AGENT);
        unsigned long long v = 0ull;
        XB_SPIN(((v = __hip_atomic_load(c1, __ATOMIC_RELAXED, __HIP_MEMORY_SCOPE_AGENT)) & 0xffull) < NGRP, bar);
        if (((v >> (8 + 3 * x)) & 7ull) != NGRP) {
            __builtin_amdgcn_fence(__ATOMIC_RELEASE, "agent");
            asm volatile("s_waitcnt vmcnt(0)" ::: "memory");
            (void)xb_add(c2, 1u);
            XB_SPIN(xb_ld(c2) < NGRP, bar);
        }
        __builtin_amdgcn_fence(__ATOMIC_ACQUIRE, "agent");
        asm volatile("s_waitcnt vmcnt(0)" ::: "memory");
    }
    __syncthreads();
}

__device__ __forceinline__ void seam_arrive(unsigned long long* c1, bool leader) {
    asm volatile("s_waitcnt vmcnt(0)" ::: "memory");
    __syncthreads();
    if (leader) { __builtin_amdgcn_s_waitcnt(0); (void)__hip_atomic_fetch_add(c1, 1ull | (1ull << (8 + 3 * xb_xcc_id())), __ATOMIC_RELAXED, __HIP_MEMORY_SCOPE_AGENT); }
}
__device__ __forceinline__ void seam_wait(unsigned* bar, unsigned long long* c1, unsigned* c2, bool leader) {
    if (leader) {
        const unsigned x = xb_xcc_id(); unsigned long long v = 0ull;
        XB_SPIN(((v = __hip_atomic_load(c1, __ATOMIC_RELAXED, __HIP_MEMORY_SCOPE_AGENT)) & 0xffull) < NGRP, bar);
        if (((v >> (8 + 3 * x)) & 7ull) != NGRP) {
            __builtin_amdgcn_fence(__ATOMIC_RELEASE, "agent");
            asm volatile("s_waitcnt vmcnt(0)" ::: "memory");
            (void)xb_add(c2, 1u);
            XB_SPIN(xb_ld(c2) < NGRP, bar);
        }
        __builtin_amdgcn_fence(__ATOMIC_ACQUIRE, "agent");
    }
    __syncthreads();
}

struct Args { const float* in[22]; float* out; unsigned char* ws; int ph_lo, ph_hi; };
struct Frame {
    LAS unsigned char* lds;
    unsigned char* ws;
    int wave, vcu, G;
    __device__ __forceinline__ int lane() const { return lane_id(); }
    __device__ __forceinline__ int tid() const { return wave * 64 + lane_id(); }
};
__device__ __forceinline__ float wave_sum(float v) {
#pragma unroll
    for (int o = 1; o < 64; o <<= 1) v += __shfl_xor(v, o);
    return v;
}
__device__ __forceinline__ float wave_max(float v) {
#pragma unroll
    for (int o = 1; o < 64; o <<= 1) v = fmaxf(v, __shfl_xor(v, o));
    return v;
}

template <bool F8>
__device__ __forceinline__ void p0_item(const float* W, int N, unsigned char* WT, int ldt, int k0, int n0s, int n0d, const float* gk, float scale, LAS float* scr, int lane) {
    const int n4 = lane & 15, kr = lane >> 4;
    f32x4 wv[16];
#pragma unroll
    for (int i = 0; i < 16; ++i) wv[i] = *(const GAS f32x4*)(W + (size_t)(k0 + 4 * i + kr) * N + n0s + 4 * n4);
#pragma unroll
    for (int i = 0; i < 16; ++i) { const int kk = 4 * i + kr; float g = scale; if (gk) g *= gk[kk];
        LAS float* d = scr + kk * 65 + 4 * n4; d[0] = wv[i].x * g; d[1] = wv[i].y * g; d[2] = wv[i].z * g; d[3] = wv[i].w * g; }
    LDS_WAIT(); asm volatile("" ::: "memory");
    if constexpr (!F8) { const int c = lane & 7;
#pragma unroll
        for (int j = 0; j < 8; ++j) { const int n = (lane >> 3) + 8 * j; const LAS float* sp = scr + (8 * c) * 65 + n;
            v4u o; o.x = pk2(sp[0 * 65], sp[1 * 65]); o.y = pk2(sp[2 * 65], sp[3 * 65]); o.z = pk2(sp[4 * 65], sp[5 * 65]); o.w = pk2(sp[6 * 65], sp[7 * 65]);
            *(GAS v4u*)(WT + (size_t)(n0d + n) * ldt + (k0 + 8 * c) * 2) = o; }
    } else { const int c = lane & 3;
#pragma unroll
        for (int j = 0; j < 4; ++j) { const int n = (lane >> 2) + 16 * j; const LAS float* sp = scr + (16 * c) * 65 + n;
            v4u o; o.x = pg8::pk4_fp8(sp[0 * 65], sp[1 * 65], sp[2 * 65], sp[3 * 65]); o.y = pg8::pk4_fp8(sp[4 * 65], sp[5 * 65], sp[6 * 65], sp[7 * 65]);
            o.z = pg8::pk4_fp8(sp[8 * 65], sp[9 * 65], sp[10 * 65], sp[11 * 65]); o.w = pg8::pk4_fp8(sp[12 * 65], sp[13 * 65], sp[14 * 65], sp[15 * 65]);
            *(GAS v4u*)(WT + (size_t)(n0d + n) * ldt + k0 + 16 * c) = o; }
    }
    LDS_WAIT(); asm volatile("" ::: "memory");
}
constexpr int MOE_IT_GU = (D / 128) * (2 * DE / 32), MOE_IT_DN = (DE / 128) * (D / 32), MOE_ITEMS = NE * (MOE_IT_GU + MOE_IT_DN);
constexpr float W6SCALE = 64.0f;
constexpr size_t WGU6_E = (size_t)(2 * DE / 256) * pg8::B6_TILE, WDN6_E = (size_t)(D / 256) * pg8::B6_TILE;
__device__ __forceinline__ void p0_moe_decode(const Args& a, unsigned char* ws, int it, const float*& src, unsigned char*& dst, int& N) {
    if (it < NE * MOE_IT_GU) { const int e = it / MOE_IT_GU, q = it % MOE_IT_GU, kb = q / (2 * DE / 32), nb = q % (2 * DE / 32);
        const int n0d = 32 * nb, pn = n0d >> 8, hf = (n0d >> 7) & 1, jj = n0d & 127, n0s = hf * DE + 128 * pn + jj;
        N = 2 * DE; src = a.in[17] + (size_t)e * D * 2 * DE + (size_t)(128 * kb) * (2 * DE) + n0s; dst = ws + WS_WGUT + (size_t)e * WGU6_E + (size_t)pn * pg8::B6_TILE + (size_t)kb * pg8::B6_KT + (size_t)(n0d & 255) * 96; }
    else { it -= NE * MOE_IT_GU; const int e = it / MOE_IT_DN, q = it % MOE_IT_DN, kb = q / (D / 32), nb = q % (D / 32);
        N = D; src = a.in[19] + (size_t)e * DE * D + (size_t)(128 * kb) * D + 32 * nb; dst = ws + WS_WDT + (size_t)e * WDN6_E + (size_t)((32 * nb) >> 8) * pg8::B6_TILE + (size_t)kb * pg8::B6_KT + (size_t)((32 * nb) & 255) * 96; }
}
#define P0M_LOAD(wv, src, N) do { const unsigned _vo = (unsigned)(((lane >> 3) * (N) + 4 * (lane & 7)) * 4); _Pragma("unroll") for (int _i = 0; _i < 16; ++_i) \
        wv[_i] = __builtin_nontemporal_load((const GAS f32x4*)((const GAS char*)((src) + (size_t)(8 * _i) * (N)) + _vo)); } while (0)
#define P0M_PROC(wv, dst) do { _Pragma("unroll") for (int _i = 0; _i < 16; ++_i) { LAS float* _d = scr + (8 * _i + (lane >> 3)) * 33 + 4 * (lane & 7); _d[0] = wv[_i].x * WSCALE; _d[1] = wv[_i].y * WSCALE; _d[2] = wv[_i].z * WSCALE; _d[3] = wv[_i].w * WSCALE; } \
        LDS_WAIT(); asm volatile("" ::: "memory"); \
        _Pragma("unroll") for (int _j = 0; _j < 4; ++_j) { const int _n = (lane >> 3) + 8 * _j; const LAS float* _s = scr + (16 * (lane & 7)) * 33 + _n; \
            v4u _o; _o.x = pg8::pk4_fp8(_s[0 * 33], _s[1 * 33], _s[2 * 33], _s[3 * 33]); _o.y = pg8::pk4_fp8(_s[4 * 33], _s[5 * 33], _s[6 * 33], _s[7 * 33]); \
            _o.z = pg8::pk4_fp8(_s[8 * 33], _s[9 * 33], _s[10 * 33], _s[11 * 33]); _o.w = pg8::pk4_fp8(_s[12 * 33], _s[13 * 33], _s[14 * 33], _s[15 * 33]); \
            *(GAS v4u*)((dst) + (size_t)_n * D + 16 * (lane & 7)) = _o; } \
        LDS_WAIT(); asm volatile("" ::: "memory"); } while (0)
#define P0M_PROC6(wv, dst) do { _Pragma("unroll") for (int _i = 0; _i < 16; ++_i) { LAS float* _d = scr + (8 * _i + (lane >> 3)) * 33 + 4 * (lane & 7); _d[0] = wv[_i].x * W6SCALE; _d[1] = wv[_i].y * W6SCALE; _d[2] = wv[_i].z * W6SCALE; _d[3] = wv[_i].w * W6SCALE; } \
        LDS_WAIT(); asm volatile("" ::: "memory"); \
        _Pragma("unroll 1") for (int _j = 0; _j < 2; ++_j) { const int _g = (lane >> 2) + 16 * _j, _q = lane & 3; const LAS float* _s = scr + (32 * _q) * 33 + _g; pg8::f32x16_t _s0, _s1; \
            if (ilv) { _Pragma("unroll") for (int _e = 0; _e < 16; ++_e) { _s0[_e] = _s[(2 * _e) * 33]; _s1[_e] = _s[(2 * _e + 1) * 33]; } } \
            else { _Pragma("unroll") for (int _e = 0; _e < 16; ++_e) { _s0[_e] = _s[_e * 33]; _s1[_e] = _s[(16 + _e) * 33]; } } \
            const pg8::u32x6 _p = pg8::pk32_fp6(_s0, _s1); const int _r = 16 * ((_g >> 2) & 1) + 4 * (_g >> 3) + (_g & 3); unsigned char* _o = (dst) + (size_t)(_r * 96 + 24 * ((_q + 2 * (_r >> 3)) & 3)); \
            *(GAS v2u*)_o = (v2u){_p[0], _p[1]}; *(GAS v2u*)(_o + 8) = (v2u){_p[2], _p[3]}; *(GAS v2u*)(_o + 16) = (v2u){_p[4], _p[5]}; } \
        LDS_WAIT(); asm volatile("" ::: "memory"); } while (0)
__device__ __forceinline__ void p0_moe_stream(Frame& F, const Args& a, int lo, int hi, int gw, int NGW) {
    LAS float* scr = (LAS float*)(F.lds + F.wave * 16896); const int lane = F.lane(); unsigned char* ws = F.ws;
    f32x4 wA[16], wB[16]; const float* sA; const float* sB; unsigned char* dA; unsigned char* dB; int nA, nB;
    bool ilv; { pg8::f32x16_t t0 = {}, t1 = {}; float one = 1.0f, two = 2.0f; asm volatile("" : "+v"(one), "+v"(two)); t0[0] = one; t1[0] = two; const pg8::u32x6 tp = pg8::pk32_fp6(t0, t1);
                ilv = (((tp[0] >> 6) & 63u) == 16u) || (((tp[3] >> 0) & 63u) != 16u); }
    int it = lo + gw;
    if (it < hi) { p0_moe_decode(a, ws, it, sA, dA, nA); P0M_LOAD(wA, sA, nA); }
    for (; it < hi; it += 2 * NGW) {
        const int it2 = it + NGW, it3 = it + 2 * NGW;
        if (it2 < hi) { p0_moe_decode(a, ws, it2, sB, dB, nB); P0M_LOAD(wB, sB, nB); }
        P0M_PROC6(wA, dA);
        if (it3 < hi) { p0_moe_decode(a, ws, it3, sA, dA, nA); P0M_LOAD(wA, sA, nA); }
        if (it2 < hi) P0M_PROC6(wB, dB);
    }
}
__device__ __forceinline__ void rms_row_to_bf16(const float* xrow, const float* gain, bf16* orow, int lane) {
    const GAS f32x4* xr = (const GAS f32x4*)xrow + lane; const GAS f32x4* gr = (const GAS f32x4*)gain + lane;
    f32x4 v[4]; float s = 0.f;
#pragma unroll
    for (int j = 0; j < 4; ++j) { v[j] = xr[64 * j]; s += (v[j].x * v[j].x + v[j].y * v[j].y) + (v[j].z * v[j].z + v[j].w * v[j].w); }
    const float rs = 1.0f / sqrtf(wave_sum(s) * (1.f / D) + EPS);
    GAS unsigned long long* o8 = (GAS unsigned long long*)orow + lane;
#pragma unroll
    for (int j = 0; j < 4; ++j) { const f32x4 g = gr[64 * j]; o8[64 * j] = (unsigned long long)pk2(v[j].x * rs * g.x, v[j].y * rs * g.y) | ((unsigned long long)pk2(v[j].z * rs * g.z, v[j].w * rs * g.w) << 32); }
}
__device__ __forceinline__ void p0_prologue(Frame& F, const Args& a) {
    LAS float* scr = (LAS float*)(F.lds + F.wave * 16896);
    const int gw = F.vcu * NWAVES + F.wave, NGW = F.G * NWAVES;
    unsigned char* ws = F.ws;
    constexpr int I_WIN = (D / 64) * (NZ / 64);
    constexpr int I_SQ = (D / 64) * (D / 64);
    constexpr int NITEMS = I_WIN + 4 * I_SQ + 4 * D;
    for (int it = gw; it < NITEMS; it += NGW) {
        int r = it;
        if (r < I_WIN) { const int nb = r % (NZ / 64), kb = r / (NZ / 64); p0_item<false>(a.in[3], NZ, ws + WS_WINT, D * 2, 64 * kb, 64 * nb, 64 * nb, nullptr, 1.0f, scr, F.lane()); continue; } r -= I_WIN;
        if (r < 2 * I_SQ) { const int w = r / I_SQ, q = r % I_SQ, nb = q % (D / 64), kb = q / (D / 64), k0 = 64 * kb;
            if (w == 0) p0_item<false>(a.in[7], D, ws + WS_WOUTT, D * 2, k0, 64 * nb, 64 * nb, (k0 < CW) ? a.in[5] + k0 : a.in[6] + (k0 - CW), 1.0f, scr, F.lane());
            else p0_item<false>(a.in[13], D, ws + WS_WOT16, D * 2, k0, 64 * nb, 64 * nb, nullptr, 1.0f, scr, F.lane());
            continue; } r -= 2 * I_SQ;
        if (r < 2 * I_SQ) { const int w = r / I_SQ, q = r % I_SQ, nb = q % (D / 64), kb = q / (D / 64), k0 = 64 * kb;
            p0_item<true>(w == 0 ? a.in[11] : a.in[12], D, ws + (w == 0 ? WS_WKT : WS_WVT), D, k0, 64 * nb, 64 * nb, nullptr, WSCALE, scr, F.lane()); continue; } r -= 2 * I_SQ;
        { const int k = r >> 2, c0 = (r & 3) * 256 + 4 * F.lane(); const float g = a.in[8][k];
            const f32x4 v = *(const GAS f32x4*)(a.in[10] + (size_t)k * D + c0); v2u o; o.x = pk2(v.x * g, v.y * g); o.y = pk2(v.z * g, v.w * g);
            *(GAS v2u*)((bf16*)(ws + WS_WQN) + (size_t)k * D + c0) = o; }
    }
    for (int m = 2 * gw; m < M; m += 2 * NGW) {
        const GAS f32x4* x0 = (const GAS f32x4*)(a.in[0] + (size_t)m * D) + F.lane(); const GAS f32x4* x1 = x0 + D / 4; const GAS f32x4* gr = (const GAS f32x4*)a.in[2] + F.lane();
        f32x4 v0[4], v1[4]; float s0 = 0.f, s1 = 0.f;
#pragma unroll
        for (int j = 0; j < 4; ++j) { v0[j] = x0[64 * j]; v1[j] = x1[64 * j]; }
#pragma unroll
        for (int j = 0; j < 4; ++j) { s0 += (v0[j].x * v0[j].x + v0[j].y * v0[j].y) + (v0[j].z * v0[j].z + v0[j].w * v0[j].w); s1 += (v1[j].x * v1[j].x + v1[j].y * v1[j].y) + (v1[j].z * v1[j].z + v1[j].w * v1[j].w); }
        const float r0 = 1.0f / sqrtf(wave_sum(s0) * (1.f / D) + EPS), r1 = 1.0f / sqrtf(wave_sum(s1) * (1.f / D) + EPS);
        GAS unsigned long long* o0 = (GAS unsigned long long*)((bf16*)(ws + WS_XN) + (size_t)m * D) + F.lane(); GAS unsigned long long* o1 = o0 + D / 4;
#pragma unroll
        for (int j = 0; j < 4; ++j) { const f32x4 g = gr[64 * j];
            o0[64 * j] = (unsigned long long)pk2(v0[j].x * r0 * g.x, v0[j].y * r0 * g.y) | ((unsigned long long)pk2(v0[j].z * r0 * g.z, v0[j].w * r0 * g.w) << 32);
            o1[64 * j] = (unsigned long long)pk2(v1[j].x * r1 * g.x, v1[j].y * r1 * g.y) | ((unsigned long long)pk2(v1[j].z * r1 * g.z, v1[j].w * r1 * g.w) << 32); }
    }
    for (int m = gw; m < MKV; m += NGW) {
        const GAS f32x4* xr = (const GAS f32x4*)(a.in[1] + (size_t)m * D) + F.lane(); const GAS f32x4* gr = (const GAS f32x4*)a.in[9] + F.lane();
        f32x4 v[4]; float ss = 0.f;
#pragma unroll
        for (int j = 0; j < 4; ++j) { v[j] = xr[64 * j]; ss += (v[j].x * v[j].x + v[j].y * v[j].y) + (v[j].z * v[j].z + v[j].w * v[j].w); }
        const float rs = 1.0f / sqrtf(wave_sum(ss) * (1.f / D) + EPS);
        GAS unsigned* o4 = (GAS unsigned*)(ws + WS_MEMN + (size_t)m * D) + F.lane();
#pragma unroll
        for (int j = 0; j < 4; ++j) { const f32x4 g = gr[64 * j]; o4[64 * j] = pg8::pk4_fp8(v[j].x * rs * g.x, v[j].y * rs * g.y, v[j].z * rs * g.z, v[j].w * rs * g.w); }
    }
    const int gt = F.vcu * NTHR + F.tid(), NGT = F.G * NTHR;
    float* wrg = (float*)(ws + WS_WRG);
    for (int i = gt; i < D * NE; i += NGT) { const int e = i >> 10, k = i & 1023; wrg[i] = a.in[15][k * NE + e] * a.in[14][k]; }
    bf16* wa = (bf16*)(ws + WS_TAB + TAB_WA); bf16* mc = (bf16*)(ws + WS_MC); bf16* dch = (bf16*)(ws + WS_TAB + TAB_DCH);
    for (int i = gt; i < 256 * 128; i += NGT) { const int m = i >> 7, k = i & 127; float sn, cs; sincospif((float)((k * (m & 127)) & 127) * (2.0f / 128.0f), &sn, &cs); wa[i] = (bf16)f2bf(m < 128 ? cs : -sn); }
    for (int i = gt; i < 128 * 128 * 128; i += NGT) { const int s1p = i >> 14, mp = (i >> 7) & 127, k = i & 127, op = mp >> 6, s2q = mp & 63, s2 = k >> 1, part = k & 1;
        const int sp = s1p + 128 * s2q, r = (s2 * sp) & 8191; float sn, cs; sincospif((float)r * (2.0f / 8192.0f), &sn, &cs);
        mc[i] = (bf16)f2bf(op == 0 ? (part == 0 ? cs : sn) : (part == 0 ? -sn : cs)); }
    for (int i = gt; i < 8192; i += NGT) { const int p = i >> 12, hc = (i >> 11) & 1, cp = (i >> 5) & 63, q = (i >> 3) & 3, j = i & 7, c = 32 * hc + (j < 4 ? 4 * q + j : 16 + 4 * q + (j - 4));
        float sn, cs; sincospif((float)((c * cp) & 63) * (2.0f / 64.0f), &sn, &cs); dch[i] = (bf16)f2bf(p == 0 ? cs : sn); }
}

typedef short s16x4 __attribute__((ext_vector_type(4)));
typedef short bf16x8v __attribute__((ext_vector_type(8)));
__device__ __forceinline__ bf16x8v tr_pair(LAS unsigned char* p0, int delta) {
    const s16x4 lo = __builtin_amdgcn_ds_read_tr16_b64_v4i16((LAS s16x4*)p0); const s16x4 hi = __builtin_amdgcn_ds_read_tr16_b64_v4i16((LAS s16x4*)(p0 + delta));
    return __builtin_shufflevector(lo, hi, 0, 1, 2, 3, 4, 5, 6, 7);
}
constexpr int FA_P = 544;
constexpr int FC_P = 1056;
__device__ __forceinline__ void fftA_phase(Frame& F) {
    const bf16* Z = (const bf16*)(F.ws + WS_Z); bf16* G = (bf16*)(F.ws + WS_G); const bf16* WA = (const bf16*)(F.ws + WS_TAB + TAB_WA);
    const int tid = F.tid(), lane = F.lane(), w = F.wave, nb = w & 3, mh = w >> 2, g = lane >> 4, q = (lane & 15) >> 2, p = lane & 3;
    for (int unit = F.vcu; unit < BATCH * FN2 * 2; unit += F.G) {
        const int b = unit >> 7, s2 = (unit >> 1) & 63, ch = unit & 1;
        __syncthreads();
#pragma unroll
        for (int i = 0; i < 8; ++i) { const int row = 16 * i + (tid >> 5), piece = tid & 31;
            const v4u v = *(const GAS v4u*)(Z + ((size_t)b * SEQ + 64 * row + s2) * NZ + 1536 + 256 * ch + 8 * piece);
            *(LAS v4u*)(F.lds + row * FA_P + piece * 16) = v; }
        __syncthreads();
        bf16x8v af[4][4];
#pragma unroll
        for (int nt = 0; nt < 4; ++nt)
#pragma unroll
            for (int ks = 0; ks < 4; ++ks) af[nt][ks] = tr_pair(F.lds + (32 * ks + 8 * g + q) * FA_P + (64 * nb + 16 * nt) * 2 + 8 * p, 4 * FA_P);
#pragma unroll
        for (int mt = 0; mt < 8; ++mt) {
            const int m0 = 128 * mh + 16 * mt;
            bf16x8v bfr[4];
#pragma unroll
            for (int ks = 0; ks < 4; ++ks) bfr[ks] = *(const GAS bf16x8v*)(WA + (size_t)(m0 + (lane & 15)) * 128 + 32 * ks + 8 * (lane >> 4));
            const int s1p = 16 * mt + (lane & 15);
            bf16* gp = G + ((((size_t)b * FN1 + s1p) * FN2 + s2) * 2 + mh) * CW + 256 * ch + 64 * nb + 4 * (lane >> 4);
#pragma unroll
            for (int nt = 0; nt < 4; ++nt) { f32x4 acc = {0.f, 0.f, 0.f, 0.f};
#pragma unroll
                for (int ks = 0; ks < 4; ++ks) acc = __builtin_amdgcn_mfma_f32_16x16x32_bf16(af[nt][ks], bfr[ks], acc, 0, 0, 0);
                v2u o; o.x = pk2(acc[0], acc[1]); o.y = pk2(acc[2], acc[3]);
                *(GAS v2u*)(gp + 16 * nt) = o; }
        }
    }
}
__device__ __forceinline__ void conv_phase(Frame& F, const Args& a, int wgi, int nwg) {
    const bf16* Z = (const bf16*)(F.ws + WS_Z); bf16* Y = (bf16*)(F.ws + WS_Y);
    const int gw = wgi * NWAVES + F.wave, NGW = nwg * NWAVES, lane = F.lane();
    const float* cw = a.in[4];
    float w0[8], w1[8], w2[8];
#pragma unroll
    for (int j = 0; j < 8; ++j) { w0[j] = cw[8 * lane + j]; w1[j] = cw[CW + 8 * lane + j]; w2[j] = cw[2 * CW + 8 * lane + j]; }
    constexpr int CH = 8;
    for (int c = gw; c < M / CH; c += NGW) {
        const int t0 = c * CH, s0 = t0 & (SEQ - 1);
        v4u zc[CH + 2], zv[CH + 2], zb[CH];
#pragma unroll
        for (int i = 0; i < CH + 2; ++i) { const int t = t0 - 1 + i; const bool valid = (i == 0) ? (s0 > 0) : ((i == CH + 1) ? (s0 + CH < SEQ) : true);
            if (valid) { zc[i] = *(const GAS v4u*)(Z + (size_t)t * NZ + CW + 8 * lane); zv[i] = *(const GAS v4u*)(Z + (size_t)t * NZ + 2 * CW + 8 * lane); }
            else { zc[i] = (v4u){0u, 0u, 0u, 0u}; zv[i] = (v4u){0u, 0u, 0u, 0u}; } }
#pragma unroll
        for (int i = 0; i < CH; ++i) zb[i] = *(const GAS v4u*)(Z + (size_t)(t0 + i) * NZ + 8 * lane);
        float prev[8], cur[8], nxt[8];
#define CV_OF(dst, cc, vv) do { dst[0] = bflo(cc.x) * bflo(vv.x); dst[1] = bfhi(cc.x) * bfhi(vv.x); dst[2] = bflo(cc.y) * bflo(vv.y); dst[3] = bfhi(cc.y) * bfhi(vv.y); \
            dst[4] = bflo(cc.z) * bflo(vv.z); dst[5] = bfhi(cc.z) * bfhi(vv.z); dst[6] = bflo(cc.w) * bflo(vv.w); dst[7] = bfhi(cc.w) * bfhi(vv.w); } while (0)
        CV_OF(prev, zc[0], zv[0]);
        CV_OF(cur, zc[1], zv[1]);
#pragma unroll
        for (int i = 0; i < CH; ++i) {
            const int t = t0 + i;
            CV_OF(nxt, zc[i + 2], zv[i + 2]);
            const v4u bb = zb[i];
            float bg[8] = {bflo(bb.x), bfhi(bb.x), bflo(bb.y), bfhi(bb.y), bflo(bb.z), bfhi(bb.z), bflo(bb.w), bfhi(bb.w)};
            float y[8]; float ss = 0.f;
#pragma unroll
            for (int j = 0; j < 8; ++j) { y[j] = bg[j] * (w0[j] * prev[j] + w1[j] * cur[j] + w2[j] * nxt[j]); ss += y[j] * y[j]; }
            const float rs = 1.0f / sqrtf(wave_sum(ss) * (1.f / CW) + EPS);
            v4u o; o.x = pk2(y[0] * rs, y[1] * rs); o.y = pk2(y[2] * rs, y[3] * rs); o.z = pk2(y[4] * rs, y[5] * rs); o.w = pk2(y[6] * rs, y[7] * rs);
            *(GAS v4u*)(Y + (size_t)t * D + 8 * lane) = o;
#pragma unroll
            for (int j = 0; j < 8; ++j) { prev[j] = cur[j]; cur[j] = nxt[j]; }
        }
#undef CV_OF
    }
}
__device__ __forceinline__ void absorb_phase(Frame& F) {
    const bf16* KB = (const bf16*)(F.ws + WS_KB); const bf16* VB = (const bf16*)(F.ws + WS_VT); const bf16* WQN = (const bf16*)(F.ws + WS_WQN); const bf16* WOT = (const bf16*)(F.ws + WS_WOT16);
    const int lane = F.lane(), w = F.wave, li = lane & 15, q = lane >> 4;
    for (int unit = F.vcu; unit < 256; unit += F.G) {
        const int type = unit >> 7, bh = (unit >> 4) & 7, slab = unit & 15, b = bh >> 2, h = bh & 3;
        const bf16* Xp; const bf16* Yp; unsigned char* outp; int itf, jtf, dit, djt;
        if (type == 0) { Xp = WQN + (size_t)(64 * slab) * D + h * HD; Yp = KB + (size_t)(b * MEMLEN) * D + h * HD;
            outp = F.ws + WS_MK + (size_t)b * MiB + (size_t)(h * HD) * D + 64 * slab; itf = w & 3; dit = 0; jtf = (w >> 2) * 8; djt = 1; }
        else { Xp = VB + (size_t)(b * MEMLEN) * D + h * HD; Yp = WOT + (size_t)(64 * slab) * D + h * HD;
            outp = F.ws + WS_MV + (size_t)b * MiB + (size_t)(64 * slab) * D + h * HD; jtf = w & 3; djt = 0; itf = (w >> 2) * 8; dit = 1; }
#pragma unroll 2
        for (int t = 0; t < 8; ++t) { const int it = itf + dit * t, jt = jtf + djt * t;
            const bf16* xr = Xp + (size_t)(it * 16 + li) * D + 8 * q; const bf16* yr = Yp + (size_t)(jt * 16 + li) * D + 8 * q;
            bf16x8v xf[8], yf[8];
#pragma unroll
            for (int ks = 0; ks < 8; ++ks) { xf[ks] = *(const GAS bf16x8v*)(xr + 32 * ks); yf[ks] = *(const GAS bf16x8v*)(yr + 32 * ks); }
            f32x4 acc = {0.f, 0.f, 0.f, 0.f};
#pragma unroll
            for (int ks = 0; ks < 8; ++ks) acc = __builtin_amdgcn_mfma_f32_16x16x32_bf16(xf[ks], yf[ks], acc, 0, 0, 0);
            *(GAS unsigned*)(outp + (size_t)(jt * 16 + li) * D + it * 16 + 4 * q) = pg8::pk4_fp8(acc[0] * WSCALE, acc[1] * WSCALE, acc[2] * WSCALE, acc[3] * WSCALE); }
    }
}
__device__ __forceinline__ void fftC_phase(Frame& F) {
    const bf16* G = (const bf16*)(F.ws + WS_G); bf16* Y = (bf16*)(F.ws + WS_Y); const bf16* MC = (const bf16*)(F.ws + WS_MC); const bf16* DCH = (const bf16*)(F.ws + WS_TAB + TAB_DCH);
    const int tid = F.tid(), lane = F.lane(), w = F.wave, tt = w & 3, ch = w >> 2, g = lane >> 4, q = (lane & 15) >> 2, p = lane & 3;
    const float scale = 1.0f / sqrtf((float)SEQ * 64.0f);
    LAS float* ex = (LAS float*)(F.lds + 128 * FC_P);
    for (int unit = F.vcu; unit < BATCH * FN1; unit += F.G) {
        const int b = unit >> 7, s1p = unit & 127;
        __syncthreads();
        const bf16* Gt = G + (size_t)(b * FN1 + s1p) * (FN2 * 2) * CW;
#pragma unroll
        for (int i = 0; i < 16; ++i) { const int idx = i * NTHR + tid, row = idx >> 6, piece = idx & 63;
            const v4u v = *(const GAS v4u*)(Gt + (size_t)row * CW + 8 * piece);
            *(LAS v4u*)(F.lds + row * FC_P + piece * 16) = v; }
        __syncthreads();
        bf16x8v Bre[4], Bim[4];
#pragma unroll
        for (int ks = 0; ks < 4; ++ks) { const bf16* mp = MC + ((size_t)s1p * 128 + 16 * tt + (lane & 15)) * 128 + 32 * ks + 8 * (lane >> 4);
            Bre[ks] = *(const GAS bf16x8v*)mp; Bim[ks] = *(const GAS bf16x8v*)(mp + 64 * 128); }
        bf16x8v dfr[4][2][2];
#pragma unroll
        for (int ct = 0; ct < 4; ++ct)
#pragma unroll
            for (int pp = 0; pp < 2; ++pp)
#pragma unroll
                for (int hc = 0; hc < 2; ++hc) dfr[ct][pp][hc] = *(const GAS bf16x8v*)(DCH + ((((pp * 2 + hc) * 64 + 16 * ct + (lane & 15)) * 4 + (lane >> 4)) * 8));
        v2u y[4][4]; float ssq = 0.f;
#pragma unroll
        for (int g4 = 0; g4 < 4; ++g4) {
            f32x4 are[4], aim[4];
#pragma unroll
            for (int nt = 0; nt < 4; ++nt) { are[nt] = (f32x4){0.f, 0.f, 0.f, 0.f}; aim[nt] = (f32x4){0.f, 0.f, 0.f, 0.f};
#pragma unroll
                for (int ks = 0; ks < 4; ++ks) { const bf16x8v af = tr_pair(F.lds + (32 * ks + 8 * g + q) * FC_P + (256 * ch + 64 * g4 + 16 * nt) * 2 + 8 * p, 4 * FC_P);
                    are[nt] = __builtin_amdgcn_mfma_f32_16x16x32_bf16(af, Bre[ks], are[nt], 0, 0, 0);
                    aim[nt] = __builtin_amdgcn_mfma_f32_16x16x32_bf16(af, Bim[ks], aim[nt], 0, 0, 0); } }
            bf16x8v xf[2][2];
#pragma unroll
            for (int hc = 0; hc < 2; ++hc) {
                { v4u t; t.x = pk2(are[2 * hc][0], are[2 * hc][1]); t.y = pk2(are[2 * hc][2], are[2 * hc][3]); t.z = pk2(are[2 * hc + 1][0], are[2 * hc + 1][1]); t.w = pk2(are[2 * hc + 1][2], are[2 * hc + 1][3]); xf[0][hc] = __builtin_bit_cast(bf16x8v, t); }
                { v4u t; t.x = pk2(aim[2 * hc][0], aim[2 * hc][1]); t.y = pk2(aim[2 * hc][2], aim[2 * hc][3]); t.z = pk2(aim[2 * hc + 1][0], aim[2 * hc + 1][1]); t.w = pk2(aim[2 * hc + 1][2], aim[2 * hc + 1][3]); xf[1][hc] = __builtin_bit_cast(bf16x8v, t); }
            }
#pragma unroll
            for (int ct = 0; ct < 4; ++ct) { f32x4 ya = {0.f, 0.f, 0.f, 0.f};
#pragma unroll
                for (int pp = 0; pp < 2; ++pp)
#pragma unroll
                    for (int hc = 0; hc < 2; ++hc) ya = __builtin_amdgcn_mfma_f32_16x16x32_bf16(dfr[ct][pp][hc], xf[pp][hc], ya, 0, 0, 0);
                ya = ya * scale; y[g4][ct].x = pk2(ya[0], ya[1]); y[g4][ct].y = pk2(ya[2], ya[3]); ssq += (ya[0] * ya[0] + ya[1] * ya[1]) + (ya[2] * ya[2] + ya[3] * ya[3]); }
        }
        ssq += __shfl_xor(ssq, 16); ssq += __shfl_xor(ssq, 32);
        if (lane < 16) ex[w * 16 + lane] = ssq;
        __syncthreads();
        const float tot = ex[w * 16 + (lane & 15)] + ex[(w ^ 4) * 16 + (lane & 15)];
        const float rf = 1.0f / sqrtf(tot * (1.f / CW) + EPS);
        const int t = b * SEQ + s1p + 128 * (16 * tt + (lane & 15));
        bf16* yp = Y + (size_t)t * D + CW + 256 * ch + 4 * (lane >> 4);
#pragma unroll
        for (int g4 = 0; g4 < 4; ++g4)
#pragma unroll
            for (int ct = 0; ct < 4; ++ct) { const v2u p = y[g4][ct]; v2u o; o.x = pk2(bflo(p.x) * rf, bfhi(p.x) * rf); o.y = pk2(bflo(p.y) * rf, bfhi(p.y) * rf); *(GAS v2u*)(yp + 64 * g4 + 16 * ct) = o; }
    }
}
typedef float f32x16 __attribute__((ext_vector_type(16)));
constexpr int AT_P = 528;
__device__ __forceinline__ void attn_phase(Frame& F) {
    const bf16* Q = (const bf16*)(F.ws + WS_Q); const bf16* KB = (const bf16*)(F.ws + WS_KB); const bf16* VT = (const bf16*)(F.ws + WS_VT); unsigned char* O = F.ws + WS_O;
    const int tid = F.tid(), lane = F.lane(), w = F.wave, r = lane & 31, h = lane >> 5, pr = (r & ~12) | ((r & 4) << 1) | ((r & 8) >> 1);
    for (int unit = F.vcu; unit < BATCH * NH * (SEQ / 256); unit += F.G) {
        const int bh = unit >> 5, qt = unit & 31, b = bh >> 2, hh = bh & 3;
        const int t0 = b * SEQ + qt * 256 + 32 * w;
        bf16x8v qf[16];
#pragma unroll
        for (int ds = 0; ds < 16; ++ds) qf[ds] = *(const GAS bf16x8v*)(Q + (size_t)(t0 + r) * D + hh * HD + 16 * ds + 8 * h);
        __syncthreads();
#pragma unroll
        for (int i = 0; i < 16; ++i) { const int idx = i * NTHR + tid, row = idx >> 5, piece = idx & 31;
            const v4u v = *(const GAS v4u*)(KB + (size_t)(b * MEMLEN + row) * D + hh * HD + 8 * piece);
            *(LAS v4u*)(F.lds + row * AT_P + piece * 16) = v; }
        __syncthreads();
        f32x16 sacc[8];
#pragma unroll
        for (int kt = 0; kt < 8; ++kt) {
#pragma unroll
            for (int i = 0; i < 16; ++i) sacc[kt][i] = 0.f;
#pragma unroll
            for (int ds = 0; ds < 16; ++ds) { const bf16x8v kf = *(const LAS bf16x8v*)(F.lds + (32 * kt + pr) * AT_P + (16 * ds + 8 * h) * 2);
                sacc[kt] = __builtin_amdgcn_mfma_f32_32x32x16_bf16(kf, qf[ds], sacc[kt], 0, 0, 0); }
        }
        float mx = -INFINITY;
#pragma unroll
        for (int kt = 0; kt < 8; ++kt)
#pragma unroll
            for (int i = 0; i < 16; ++i) mx = fmaxf(mx, sacc[kt][i]);
        mx = fmaxf(mx, __shfl_xor(mx, 32));
        float sum = 0.f; bf16x8v pf[8][2];
#pragma unroll
        for (int kt = 0; kt < 8; ++kt)
#pragma unroll
            for (int s2 = 0; s2 < 2; ++s2) { float pv[8];
#pragma unroll
                for (int j = 0; j < 8; ++j) { pv[j] = __builtin_amdgcn_exp2f(sacc[kt][8 * s2 + j] - mx); sum += pv[j]; }
                v4u t; t.x = pk2(pv[0], pv[1]); t.y = pk2(pv[2], pv[3]); t.z = pk2(pv[4], pv[5]); t.w = pk2(pv[6], pv[7]); pf[kt][s2] = __builtin_bit_cast(bf16x8v, t); }
        sum += __shfl_xor(sum, 32);
        const float inv = 1.0f / sum;
        __syncthreads();
#pragma unroll
        for (int i = 0; i < 16; ++i) { const int idx = i * NTHR + tid, row = idx >> 5, piece = idx & 31;
            const v4u v = *(const GAS v4u*)(VT + (size_t)(hh * HD + row) * MKV + b * MEMLEN + 8 * piece);
            *(LAS v4u*)(F.lds + row * AT_P + piece * 16) = v; }
        __syncthreads();
        unsigned char* op = O + (size_t)(t0 + r) * D + hh * HD + 4 * h;
#pragma unroll
        for (int dt = 0; dt < 8; ++dt) { f32x16 oacc;
#pragma unroll
            for (int i = 0; i < 16; ++i) oacc[i] = 0.f;
#pragma unroll
            for (int kt = 0; kt < 8; ++kt)
#pragma unroll
                for (int s2 = 0; s2 < 2; ++s2) { const bf16x8v vf = *(const LAS bf16x8v*)(F.lds + (32 * dt + r) * AT_P + (32 * kt + 16 * s2 + 8 * h) * 2);
                    oacc = __builtin_amdgcn_mfma_f32_32x32x16_bf16(vf, pf[kt][s2], oacc, 0, 0, 0); }
#pragma unroll
            for (int i = 0; i < 4; ++i) *(GAS unsigned*)(op + 32 * dt + 8 * i) = pg8::pk4_fp8(oacc[4 * i] * inv, oacc[4 * i + 1] * inv, oacc[4 * i + 2] * inv, oacc[4 * i + 3] * inv);
        }
    }
}
constexpr int RT_P = 2064;
constexpr int RT_LO = 32 * RT_P, RT_PART = 2 * 32 * RT_P, RT_SQP = RT_PART + 8192, RT_RSB = RT_SQP + 256, RT_HIST = RT_RSB + 256, RT_BASE = RT_HIST + 128;
static_assert(RT_BASE + 128 <= MOE_TAB_OFF, "router LDS map");
__device__ __forceinline__ void router_phase(Frame& F, const Args& a, int blk0, unsigned long long* gs1) {
    const bf16* XR = (const bf16*)(F.ws + WS_XR); unsigned char* XN3 = F.ws + WS_XN3; const float* wrgT = (const float*)(F.ws + WS_WRG);
    int* tok_e = (int*)(F.ws + WS_TOK); float* tok_w = (float*)(F.ws + WS_TOK + 256 * 1024); int* tok_rank = (int*)(F.ws + WS_TOK + 512 * 1024);
    int* etok = (int*)(F.ws + WS_ETOK); unsigned* ctl = (unsigned*)(F.ws + WS_CTL);
    const int tid = F.tid(), lane = F.lane(), w = F.wave, tt = w & 3, kh = w >> 2, li = lane & 15, kq = lane >> 4;
    LAS float* part = (LAS float*)(F.lds + RT_PART); LAS float* sqp = (LAS float*)(F.lds + RT_SQP); LAS float* rsb = (LAS float*)(F.lds + RT_RSB);
    LAS unsigned* hist = (LAS unsigned*)(F.lds + RT_HIST); LAS unsigned* base = (LAS unsigned*)(F.lds + RT_BASE);
    const float* gain = a.in[14]; const float* brt = a.in[16];
    __syncthreads();
#pragma unroll
    for (int i = 0; i < 16; ++i) { const int idx = i * NTHR + tid, e = idx >> 8, piece = idx & 255;
        const f32x4 v = *(const GAS f32x4*)(wrgT + (size_t)e * D + 4 * piece);
        v2u hi; hi.x = pk2(v.x, v.y); hi.y = pk2(v.z, v.w);
        v2u lo; lo.x = pk2(v.x - bflo(hi.x), v.y - bfhi(hi.x)); lo.y = pk2(v.z - bflo(hi.y), v.w - bfhi(hi.y));
        *(LAS v2u*)(F.lds + e * RT_P + piece * 8) = hi; *(LAS v2u*)(F.lds + RT_LO + e * RT_P + piece * 8) = lo; }
    if (tid < NE) hist[tid] = 0u;
    if (gs1) group_sync(ctl + CW_BAR, gs1, (unsigned*)gs1 + 2, F.wave == 0 && lane_id() == 0);
    f32x4 gv[4];
#pragma unroll
    for (int j = 0; j < 4; ++j) gv[j] = ((const GAS f32x4*)gain + lane)[64 * j];
    for (int blk = blk0; blk < M / 64; blk += F.G) {
        __syncthreads();
        const int t = blk * 64 + 16 * tt + li;
        f32x4 acc[2]; acc[0] = (f32x4){0.f, 0.f, 0.f, 0.f}; acc[1] = (f32x4){0.f, 0.f, 0.f, 0.f}; float ssq = 0.f;
        const bf16* xp = XR + (size_t)t * D + 512 * kh + 8 * kq;
        bf16x8v xb[16];
#pragma unroll
        for (int ks = 0; ks < 16; ++ks) xb[ks] = *(const GAS bf16x8v*)(xp + 32 * ks);
        v2u xw[8][4];
#pragma unroll
        for (int i = 0; i < 8; ++i) { const GAS v2u* xr = (const GAS v2u*)(XR + (size_t)(blk * 64 + 8 * w + i) * D) + lane;
#pragma unroll
            for (int j = 0; j < 4; ++j) xw[i][j] = xr[64 * j]; }
#pragma unroll
        for (int ks = 0; ks < 16; ++ks) {
            { const v4u u4 = __builtin_bit_cast(v4u, xb[ks]); const float x0 = bflo(u4.x), x1 = bfhi(u4.x), x2 = bflo(u4.y), x3 = bfhi(u4.y), x4 = bflo(u4.z), x5 = bfhi(u4.z), x6 = bflo(u4.w), x7 = bfhi(u4.w);
              ssq += ((x0 * x0 + x1 * x1) + (x2 * x2 + x3 * x3)) + ((x4 * x4 + x5 * x5) + (x6 * x6 + x7 * x7)); }
#pragma unroll
            for (int mt = 0; mt < 2; ++mt) { const int off = (16 * mt + li) * RT_P + (512 * kh + 32 * ks + 8 * kq) * 2;
                const bf16x8v whi = *(const LAS bf16x8v*)(F.lds + off), wlo = *(const LAS bf16x8v*)(F.lds + RT_LO + off);
                acc[mt] = __builtin_amdgcn_mfma_f32_16x16x32_bf16(whi, xb[ks], acc[mt], 0, 0, 0);
                acc[mt] = __builtin_amdgcn_mfma_f32_16x16x32_bf16(wlo, xb[ks], acc[mt], 0, 0, 0); }
        }
        ssq += __shfl_xor(ssq, 16); ssq += __shfl_xor(ssq, 32);
        if (kh == 1) {
#pragma unroll
            for (int mt = 0; mt < 2; ++mt)
#pragma unroll
                for (int rg = 0; rg < 4; ++rg) part[(tt * 32 + 16 * mt + 4 * kq + rg) * 16 + li] = acc[mt][rg];
            if (lane < 16) sqp[tt * 16 + lane] = ssq;
        }
        __syncthreads();
        int my_e = 0; float my_w = 0.f; unsigned my_lr = 0u;
        if (kh == 0) {
            const float rs = 1.0f / sqrtf((ssq + sqp[tt * 16 + li]) * (1.f / D) + EPS);
            if (kq == 0) rsb[16 * tt + li] = rs;
            float val[8];
#pragma unroll
            for (int mt = 0; mt < 2; ++mt)
#pragma unroll
                for (int rg = 0; rg < 4; ++rg) { const int e = 16 * mt + 4 * kq + rg; val[4 * mt + rg] = (acc[mt][rg] + part[(tt * 32 + e) * 16 + li]) * rs + brt[e]; }
            float sv[4]; int se[4];
#pragma unroll
            for (int k = 0; k < TOPK; ++k) {
                float bv = val[0]; int be = 4 * kq;
#pragma unroll
                for (int i = 1; i < 8; ++i) { const int e = 16 * (i >> 2) + 4 * kq + (i & 3); if (val[i] > bv) { bv = val[i]; be = e; } }
#pragma unroll
                for (int o = 16; o < 64; o <<= 1) { const float ov = __shfl_xor(bv, o); const int oe = __shfl_xor(be, o); if (ov > bv || (ov == bv && oe < be)) { bv = ov; be = oe; } }
                sv[k] = bv; se[k] = be;
#pragma unroll
                for (int i = 0; i < 8; ++i) { const int e = 16 * (i >> 2) + 4 * kq + (i & 3); if (e == be) val[i] = -INFINITY; }
            }
            float wk[4]; float wsum = 0.f;
#pragma unroll
            for (int k = 0; k < TOPK; ++k) { wk[k] = __expf(sv[k] - sv[0]); wsum += wk[k]; }
            my_e = (kq == 0) ? se[0] : (kq == 1) ? se[1] : (kq == 2) ? se[2] : se[3];
            my_w = ((kq == 0) ? wk[0] : (kq == 1) ? wk[1] : (kq == 2) ? wk[2] : wk[3]) / wsum;
            my_lr = __hip_atomic_fetch_add(hist + my_e, 1u, __ATOMIC_RELAXED, __HIP_MEMORY_SCOPE_WORKGROUP);
        }
        __syncthreads();
        unsigned basev = 0u;
        if (tid < NE) { const unsigned c = hist[tid]; basev = c ? __hip_atomic_fetch_add(ctl + CW_CNT + 64 * tid, c, RLX_AGENT) : 0u; hist[tid] = 0u; }
#pragma unroll
        for (int i = 0; i < 8; ++i) { const int tk = blk * 64 + 8 * w + i; const float rs = rsb[8 * w + i]; GAS unsigned* o4 = (GAS unsigned*)(XN3 + (size_t)tk * D) + lane;
#pragma unroll
            for (int j = 0; j < 4; ++j) { const v2u x2 = xw[i][j]; const f32x4 g = gv[j];
                o4[64 * j] = pg8::pk4_fp8(bflo(x2.x) * rs * g.x, bfhi(x2.x) * rs * g.y, bflo(x2.y) * rs * g.z, bfhi(x2.y) * rs * g.w); } }
        if (tid < NE) base[tid] = basev;
        __syncthreads();
        if (kh == 0) { const unsigned rank = base[my_e] + my_lr;
            tok_e[t * 4 + kq] = my_e; tok_w[t * 4 + kq] = my_w; tok_rank[t * 4 + kq] = (int)rank; etok[(size_t)my_e * ECAP + rank] = t; }
    }
}
__device__ __forceinline__ int moe_tables(Frame& F) {
    LAS int* tile_e = (LAS int*)(F.lds + MOE_TAB_OFF); LAS int* tile0 = tile_e + 320; LAS int* cnt = tile0 + 40;
    const unsigned* ctl = (const unsigned*)(F.ws + WS_CTL);
    __syncthreads();
    if (F.tid() < NE) cnt[F.tid()] = (int)__hip_atomic_load(ctl + CW_CNT + 64 * F.tid(), RLX_AGENT);
    __syncthreads();
    if (F.tid() == 0) { int acc = 0; for (int e = 0; e < NE; ++e) { tile0[e] = acc; acc += (cnt[e] + 255) >> 8; } tile0[NE] = acc; }
    __syncthreads();
    const int R = tile0[NE];
    for (int rt = F.tid(); rt < R; rt += NTHR) { int e = 0; for (int q = 0; q < NE; ++q) if (rt >= tile0[q] && rt < tile0[q + 1]) e = q; tile_e[rt] = e; }
    __syncthreads();
    return R;
}
__device__ __forceinline__ void combine_phase(Frame& F, const Args& a) {
    const bf16* XR = (const bf16*)(F.ws + WS_XR); const unsigned char* CTR = F.ws + WS_CTR;
    const int* tok_e = (const int*)(F.ws + WS_TOK); const float* tok_w = (const float*)(F.ws + WS_TOK + 256 * 1024); const int* tok_rank = (const int*)(F.ws + WS_TOK + 512 * 1024);
    LAS int* tile0 = (LAS int*)(F.lds + MOE_TAB_OFF) + 320;
    const int gw = F.vcu * NWAVES + F.wave, NGW = F.G * NWAVES, lane = F.lane();
    const float* gain = a.in[21];
    constexpr int TPW = 8;
    const GAS f32x4* gr = (const GAS f32x4*)gain; const f32x4 gv[4] = {gr[2 * lane], gr[2 * lane + 1], gr[128 + 2 * lane], gr[128 + 2 * lane + 1]};
    for (int tb = gw * TPW; tb < M; tb += NGW * TPW) {
        int myslot = 0; float myw = 0.f;
        if (lane < 4 * TPW) { const int q = (tb + (lane >> 2)) * 4 + (lane & 3); const int e = tok_e[q]; myw = tok_w[q]; myslot = tile0[e] * 256 + tok_rank[q]; }
#pragma unroll 4
        for (int i = 0; i < TPW; ++i) {
            const int t = tb + i;
            const GAS v4u* xr = (const GAS v4u*)(XR + (size_t)t * D);
            v4u xw[2]; v2u cw[4][2]; float wk[4];
            xw[0] = xr[lane]; xw[1] = xr[64 + lane];
#pragma unroll
            for (int k = 0; k < TOPK; ++k) { const int slot = __builtin_amdgcn_readlane(myslot, 4 * i + k); wk[k] = __builtin_bit_cast(float, __builtin_amdgcn_readlane(__builtin_bit_cast(int, myw), 4 * i + k));
                const GAS v2u* cp = (const GAS v2u*)(CTR + (size_t)slot * D); cw[k][0] = cp[lane]; cw[k][1] = cp[64 + lane]; }
            f32x4 v[4]; float s = 0.f;
#pragma unroll
            for (int h = 0; h < 2; ++h) { v[2 * h] = (f32x4){bflo(xw[h].x), bfhi(xw[h].x), bflo(xw[h].y), bfhi(xw[h].y)}; v[2 * h + 1] = (f32x4){bflo(xw[h].z), bfhi(xw[h].z), bflo(xw[h].w), bfhi(xw[h].w)};
#pragma unroll
                for (int k = 0; k < TOPK; ++k) {
#pragma unroll
                    for (int u = 0; u < 2; ++u) { const int cwd = (int)(u ? cw[k][h].y : cw[k][h].x); const f32x2v lo = __builtin_amdgcn_cvt_pk_f32_fp8(cwd, false), hi = __builtin_amdgcn_cvt_pk_f32_fp8(cwd, true);
                        v[2 * h + u].x += wk[k] * lo.x; v[2 * h + u].y += wk[k] * lo.y; v[2 * h + u].z += wk[k] * hi.x; v[2 * h + u].w += wk[k] * hi.y; } }
#pragma unroll
                for (int u = 0; u < 2; ++u) s += (v[2 * h + u].x * v[2 * h + u].x + v[2 * h + u].y * v[2 * h + u].y) + (v[2 * h + u].z * v[2 * h + u].z + v[2 * h + u].w * v[2 * h + u].w); }
            const float rs = 1.0f / sqrtf(wave_sum(s) * (1.f / D) + EPS);
            GAS f32x4* op = (GAS f32x4*)(a.out + (size_t)t * D);
#pragma unroll
            for (int h = 0; h < 2; ++h)
#pragma unroll
                for (int u = 0; u < 2; ++u) { const f32x4 g = gv[2 * h + u], w4 = v[2 * h + u]; op[128 * h + 2 * lane + u] = (f32x4){w4.x * rs * g.x, w4.y * rs * g.y, w4.z * rs * g.z, w4.w * rs * g.w}; }
        }
    }
}

constexpr int NPHASE = 14;
__global__ void __launch_bounds__(NTHR, 2) mk_fwd(Args args) {
    extern __shared__ __attribute__((aligned(16))) unsigned char lds[];
    Frame F;
    F.lds = (LAS unsigned char*)lds; F.ws = args.ws;
    F.wave = __builtin_amdgcn_readfirstlane((int)threadIdx.x >> 6);
    F.G = gridDim.x; { const int bx = blockIdx.x; F.vcu = (F.G % 8 == 0) ? (bx % 8) * (F.G / 8) + bx / 8 : bx; }
    unsigned char* ws = args.ws;
    for (int u = F.tid(); u < (LDS_BYTES - LDSCTL_OFF) / 4; u += NTHR) ((LAS unsigned*)(F.lds + LDSCTL_OFF))[u] = 0u;
    __syncthreads();
    volatile LAS unsigned* MISC = (volatile LAS unsigned*)(F.lds + MISC_OFF);
    XcdBarrier bar; bar.bar = (unsigned*)(ws + WS_CTL) + CW_BAR; bar.x = 0; bar.st = nullptr;
#if MK_ONE_LAUNCH
    bar = xcd_barrier_post((unsigned*)(ws + WS_CTL) + CW_BAR, MISC + 8, F.wave == 0 && lane_id() == 0);
#define GRID_BAR() xcd_barrier(bar, F.wave == 0 && lane_id() == 0)
#else
#define GRID_BAR() do { } while (0)
#endif
    const int lo = args.ph_lo, hi = args.ph_hi;
#define IN(k) (lo <= (k) && (k) < hi)
#define REP(k) for (int _rep = 0; _rep < (((MK_DUP) >> (k)) & 1) + 1; ++_rep)
#define SEAM(k) do { if (IN(k) && IN((k) + 1)) GRID_BAR(); } while (0)
    int gpm = 0, gpn = 0; const bool lsync = MK_ONE_LAUNCH && (F.G == (M / 256) * (D / 256));
    if (lsync) { pg8::StaticOrder S0; S0.init(M, D, F.G, (int)blockIdx.x); pg8::Unit u0; (void)S0.next(0, u0); gpm = u0.pm; gpn = u0.pn; }
#define GSW(s) ((unsigned long long*)((unsigned*)(ws + WS_CTL) + CW_GRP + 64 * (64 * (s) + gpm)))
#define LSEAM(k, s) do { if (IN(k) && IN((k) + 1)) { if (lsync) group_sync((unsigned*)(ws + WS_CTL) + CW_BAR, GSW(s), (unsigned*)GSW(s) + 2, F.wave == 0 && lane_id() == 0); else GRID_BAR(); } } while (0)
    using pg8::Gemm; using pg8::StaticOrder; using pg8::GroupedOrder; using pg8::gemm_phase; using pg8::bf16_t; using pg8::EpiBf16; using pg8::EpiRowScaleBf16; using pg8::EpiResidIn; using pg8::EpiResidBf; using pg8::EpiSwiGLU; using pg8::EpiBiasF8; using pg8::EpiSoftmaxF8;
    if (IN(0)) REP(0) { p0_prologue(F, args); } SEAM(0);
    if (IN(1)) REP(1) { Gemm g{(const bf16_t*)(ws + WS_XN), (const bf16_t*)(ws + WS_WINT), D, 0}; StaticOrder S; S.init(M, NZ, F.G, (int)blockIdx.x);
        const bool split = (F.G % 16) == 0; const int grp = split ? (((int)blockIdx.x >> 3) & 1) : 0, ng = split ? F.G / 2 : F.G;
        const int gi = split ? (((int)blockIdx.x >> 4) * 8 + ((int)blockIdx.x & 7)) : (int)blockIdx.x, mlo = (split && grp) ? MOE_ITEMS / 2 : 0, mhi = (split && !grp) ? MOE_ITEMS / 2 : MOE_ITEMS;
        if (grp == 0) { p0_moe_stream(F, args, mlo, mhi, gi * NWAVES + F.wave, ng * NWAVES); __syncthreads(); }
        EpiBf16 E{(bf16_t*)(ws + WS_Z), NZ, 1.0f}; gemm_phase<EpiBf16, StaticOrder, true>(F.lds, g, S, E, F.wave);
        if (grp == 1) { __syncthreads(); p0_moe_stream(F, args, mlo, mhi, gi * NWAVES + F.wave, ng * NWAVES); } } SEAM(1);
    if (IN(3)) REP(3) {
        const bool split = F.G >= 64;
        if (!split || blockIdx.x < 16) {
            { Gemm g{(const bf16_t*)(ws + WS_MEMN), (const bf16_t*)(ws + WS_WKT), D / 2, 0}; StaticOrder S; S.init(MKV, D, F.G, (int)blockIdx.x);
              EpiBf16 E{(bf16_t*)(ws + WS_KB), D, 1.0f / WSCALE}; gemm_phase<EpiBf16, StaticOrder, true, true>(F.lds, g, S, E, F.wave); }
            { Gemm g{(const bf16_t*)(ws + WS_MEMN), (const bf16_t*)(ws + WS_WVT), D / 2, 0}; StaticOrder S; S.init(MKV, D, F.G, (int)((blockIdx.x + F.G - 8) % F.G));
              EpiBf16 E{(bf16_t*)(ws + WS_VT), D, 1.0f / WSCALE}; gemm_phase<EpiBf16, StaticOrder, true, true>(F.lds, g, S, E, F.wave); }
        }
        if (!split) conv_phase(F, args, F.vcu, F.G); else if (blockIdx.x >= 16) conv_phase(F, args, (int)blockIdx.x - 16, F.G - 16);
        fftA_phase(F); } SEAM(3);
    if (IN(4)) REP(4) { absorb_phase(F); fftC_phase(F); } SEAM(4);
    if (IN(6)) REP(6) { Gemm g{(const bf16_t*)(ws + WS_Y), (const bf16_t*)(ws + WS_WOUTT), D, 0}; StaticOrder S; S.init(M, D, F.G, (int)blockIdx.x);
        EpiResidIn E{args.in[0], (bf16_t*)(ws + WS_XR), ws + WS_XB, (float*)(ws + WS_CTL) + CW_ROWSQ, D}; gemm_phase<EpiResidIn, StaticOrder, false>(F.lds, g, S, E, F.wave); } if (!lsync) SEAM(6);
    if (IN(7)) REP(7) { Gemm g{(const bf16_t*)(ws + WS_XB), (const bf16_t*)(ws + WS_MK), D / 2, MiB}; StaticOrder S; S.init(M, D, F.G, (int)blockIdx.x, 5);
        if (lsync && IN(6)) { S.sbar = (unsigned*)(ws + WS_CTL) + CW_BAR; S.sgs = GSW(0); }
        EpiSoftmaxF8 E{ws + WS_P, D, (const float*)(ws + WS_CTL) + CW_ROWSQ, 1.0f / D, EPS, QSCALE / WSCALE, (LAS float*)(F.lds + RING_BYTES)}; gemm_phase<EpiSoftmaxF8, StaticOrder, true, true>(F.lds, g, S, E, F.wave); } if (!lsync) SEAM(7);
    if (IN(9)) REP(9) { Gemm g{(const bf16_t*)(ws + WS_P), (const bf16_t*)(ws + WS_MV), D / 2, MiB}; StaticOrder S; S.init(M, D, F.G, (int)blockIdx.x, 5);
        if (lsync && IN(7)) { S.sbar = (unsigned*)(ws + WS_CTL) + CW_BAR; S.sgs = GSW(1); }
        EpiResidBf E{(bf16_t*)(ws + WS_XR), D, 1.0f / (128.0f * WSCALE)}; gemm_phase<EpiResidBf, StaticOrder, false, true>(F.lds, g, S, E, F.wave); } if (!lsync) SEAM(9);
    if (IN(10)) REP(10) { router_phase(F, args, lsync ? 4 * gpm + gpn : F.vcu, (lsync && IN(9)) ? GSW(2) : nullptr); } SEAM(10);
    if (IN(11)) REP(11) { const int R = moe_tables(F);
        LAS int* tile_e = (LAS int*)(F.lds + MOE_TAB_OFF);
        GroupedOrder<true> S; S.nM = R; S.nN = 2 * DE / 256; S.nwg = R * S.nN; S.G = F.G; S.c = (int)blockIdx.x; S.tile_e = tile_e; S.tile0 = tile_e + 320; S.cnt = tile_e + 360; S.etok = (const int*)(ws + WS_ETOK); S.ecap = ECAP;
        { LAS int* rowtok = (LAS int*)(F.lds + RING_BYTES); pg8::Unit u;
          for (int ui = 0; ui < 12 && S.next(ui, u); ++ui) if (F.tid() < 256) { const int idx = (u.pm - S.tile0[u.e]) * 256 + F.tid(); rowtok[ui * 256 + F.tid()] = idx < S.cnt[u.e] ? S.etok[(size_t)u.e * ECAP + idx] : 0; }
          __syncthreads(); S.rowtok = rowtok; }
        Gemm g{(const bf16_t*)(ws + WS_XN3), (const bf16_t*)(ws + WS_WGUT), D / 2, WGU6_E};
        EpiSwiGLU E{ws + WS_ACT, args.in[18], 1.0f / W6SCALE}; gemm_phase<EpiSwiGLU, GroupedOrder<true>, true, 2>(F.lds, g, S, E, F.wave); } SEAM(11);
    if (IN(12)) REP(12) { const int R = moe_tables(F);
        LAS int* tile_e = (LAS int*)(F.lds + MOE_TAB_OFF);
        GroupedOrder<false> S; S.nM = R; S.nN = D / 256; S.nwg = R * S.nN; S.G = F.G; S.c = (int)blockIdx.x; S.tile_e = tile_e; S.tile0 = tile_e + 320; S.cnt = tile_e + 360; S.etok = nullptr; S.ecap = ECAP; S.rowtok = nullptr;
        Gemm g{(const bf16_t*)(ws + WS_ACT), (const bf16_t*)(ws + WS_WDT), DE / 2, WDN6_E};
        EpiBiasF8 E{ws + WS_CTR, args.in[20], 1.0f / W6SCALE}; gemm_phase<EpiBiasF8, GroupedOrder<false>, true, 2>(F.lds, g, S, E, F.wave); } SEAM(12);
    if (IN(13)) REP(13) { (void)moe_tables(F); combine_phase(F, args); }
#undef IN
#undef SEAM
}

extern "C" void kernel_launch(void* const* d_in, const int* in_sizes, int n_in, void* d_out, int out_size, void* d_ws, size_t ws_size, hipStream_t stream) {
    static int grid = 0;
    if (grid == 0) {
        if (n_in != 22 || in_sizes[0] != M * D || out_size != M * D || ws_size < WS_END) { fprintf(stderr, "kernel_launch: unexpected problem (n_in %d, in0 %d, out %d, ws %zu)\n", n_in, n_in > 0 ? in_sizes[0] : -1, out_size, ws_size); grid = -1; return; }
        int dev = 0, cus = 0;
        if (hipGetDevice(&dev) != hipSuccess || hipDeviceGetAttribute(&cus, hipDeviceAttributeMultiprocessorCount, dev) != hipSuccess) { grid = -1; return; }
        if (hipFuncSetAttribute((const void*)mk_fwd, hipFuncAttributeMaxDynamicSharedMemorySize, LDS_BYTES) != hipSuccess) { fprintf(stderr, "kernel_launch: hipFuncSetAttribute failed\n"); grid = -1; return; }
        int per_cu = 0;
        if (hipOccupancyMaxActiveBlocksPerMultiprocessor(&per_cu, (const void*)mk_fwd, NTHR, LDS_BYTES) != hipSuccess || per_cu < 1) fprintf(stderr, "kernel_launch: occupancy query reports %d\n", per_cu);
        (void)hipGetLastError();
        grid = cus;
    }
    if (grid < 0) return;
    if (hipMemsetAsync((char*)d_ws + WS_CTL, 0, CTL_ZERO_BYTES, stream) != hipSuccess) return;
    Args a{};
    for (int i = 0; i < 22; ++i) a.in[i] = (const float*)d_in[i];
    a.out = (float*)d_out; a.ws = (unsigned char*)d_ws;
#if MK_ONE_LAUNCH
    a.ph_lo = 0; a.ph_hi = NPHASE;
    hipLaunchKernelGGL(mk_fwd, dim3(grid), dim3(NTHR), LDS_BYTES, stream, a);
#else
    for (int p = 0; p < NPHASE; ++p) { a.ph_lo = p; a.ph_hi = p + 1; hipLaunchKernelGGL(mk_fwd, dim3(grid), dim3(NTHR), LDS_BYTES, stream, a); }
#endif
}
```

```cpp
#include <hip/hip_runtime.h>
#include <cstdio>
#include <cstdint>

#ifndef MK_ONE_LAUNCH
#define MK_ONE_LAUNCH 1
#endif
#ifndef MK_DUP
#define MK_DUP 0
#endif

__device__ __forceinline__ int lane_id() { return (int)__builtin_amdgcn_mbcnt_hi(~0u, __builtin_amdgcn_mbcnt_lo(~0u, 0u)) & 63; }
namespace pg8 {
#define PG8_LAS __attribute__((address_space(3)))
typedef unsigned short bf16_t;
typedef short bf16x8 __attribute__((ext_vector_type(8)));
typedef float f32x4 __attribute__((ext_vector_type(4)));
typedef unsigned u32x4 __attribute__((ext_vector_type(4)));
typedef unsigned u32x2 __attribute__((ext_vector_type(2)));
constexpr int BM = 256, BK = 64, HALF = 128, HTB = HALF * BK * 2, STAGE_BYTES = 8 * HTB, NXCD = 8, WGM = 8;

__host__ __device__ __forceinline__ int lds_byte(int r, int c) { const int st = (r >> 4) * 2 + (c >> 5), rr = r & 15, cc = c & 31, ob = rr * 64 + cc * 2; return st * 1024 + (ob ^ (((ob >> 9) & 1) << 5)); }
__host__ __device__ __forceinline__ void stage_rc(int b, int& R, int& C) { const int st = b / 1024, sb = b % 1024, swz = sb ^ (((sb >> 9) & 1) << 5); R = (st >> 1) * 16 + swz / 64; C = (st & 1) * 32 + (swz % 64) / 2; }
__host__ __device__ __forceinline__ int perm32(int rho) { const int n = rho >> 4, i = rho & 15; return 8 * (i >> 2) + 4 * n + (i & 3); }

struct Unit { int pm, pn, e; };
struct Gemm { const bf16_t* A; const bf16_t* Bt; int K; size_t bstride; };

struct StaticOrder {
    static constexpr bool GATHER = false;
    int nM, nN, nwg, G, c, eshift;
    __device__ __forceinline__ void init(int M, int N, int G_, int c_, int eshift_ = -1) { nM = M / BM; nN = N / BM; nwg = nM * nN; G = G_; c = c_; eshift = eshift_; }
    __device__ __forceinline__ bool next(int i, Unit& u) const {
        const long L = (long)i * G + c; if (L >= nwg) return false;
        int wgid = (int)L; { const int q = nwg / NXCD, r = nwg % NXCD, xcd = wgid % NXCD, off = wgid / NXCD; wgid = (xcd < r ? xcd * (q + 1) : r * (q + 1) + (xcd - r) * q) + off; }
        const int nig = WGM * nN, gid = wgid / nig, fm = gid * WGM, gsz = (nM - fm) < WGM ? (nM - fm) : WGM;
        u.pm = fm + ((wgid % nig) % gsz); u.pn = (wgid % nig) / gsz; u.e = eshift >= 0 ? (u.pm >> eshift) : 0; return true;
    }
    __device__ __forceinline__ int arow(int, int) const { return 0; }
};
template <bool GATHER_>
struct GroupedOrder {
    static constexpr bool GATHER = GATHER_;
    int nM, nN, nwg, G, c;
    int own, lo, start, stride, limit, xhas, xnM, xlo, xslot;
    unsigned* done; unsigned* tmo;
    const PG8_LAS int* tile_e;
    const PG8_LAS int* tile0;
    const PG8_LAS int* cnt;
    const int* etok;
    int ecap;
    __device__ __forceinline__ bool next(int i, Unit& u) const {
        int wgid, nMl = nM, lol = 0;
        if (own) { const int s = start + i * stride;
            if (s < limit) { wgid = s; lol = lo; }
            else { const int nmain = start < limit ? (limit - start + stride - 1) / stride : 0; if (!xhas || i != nmain) return false; wgid = xslot; nMl = xnM; lol = xlo; } }
        else { const long L = (long)i * G + c; if (L >= nwg) return false;
            wgid = (int)L; { const int q = nwg / NXCD, r = nwg % NXCD, xcd = wgid % NXCD, off = wgid / NXCD; wgid = (xcd < r ? xcd * (q + 1) : r * (q + 1) + (xcd - r) * q) + off; } }
        const int nig = WGM * nN, gid = wgid / nig, fm = gid * WGM, gsz = (nMl - fm) < WGM ? (nMl - fm) : WGM;
        u.pm = lol + fm + ((wgid % nig) % gsz); u.pn = (wgid % nig) / gsz; u.e = tile_e[u.pm];
        if constexpr (!GATHER_) { if (done) { const unsigned* dp = done + 64 * u.pm; unsigned sp = 0;
            while (__hip_atomic_load(dp, __ATOMIC_RELAXED, __HIP_MEMORY_SCOPE_AGENT) < 8u) { __builtin_amdgcn_s_sleep(2); if ((++sp & 255u) == 0u && (__hip_atomic_load(tmo, __ATOMIC_RELAXED, __HIP_MEMORY_SCOPE_AGENT) || sp > (1u << 18))) break; } } }
        return true;
    }
    const PG8_LAS int* rowtok;
    __device__ __forceinline__ int arow(int ui, int r) const { return rowtok[ui * BM + r]; }
};

typedef float f32x2_t __attribute__((ext_vector_type(2)));
typedef float f32x16_t __attribute__((ext_vector_type(16)));
typedef unsigned u32x6 __attribute__((ext_vector_type(6)));
__device__ __forceinline__ u32x6 pk32_fp6(const f32x16_t s0, const f32x16_t s1) { return __builtin_amdgcn_cvt_scalef32_2xpk16_fp6_f32(s0, s1, 1.0f); }
typedef __bf16 bf16x2_t __attribute__((ext_vector_type(2)));
__device__ __forceinline__ unsigned cvt_pk_bf16(float lo, float hi) { const f32x2_t v = {lo, hi}; return __builtin_bit_cast(unsigned, __builtin_convertvector(v, bf16x2_t)); }

__device__ __forceinline__ unsigned pk4_fp8(float a, float b, float c, float d) { int v = __builtin_amdgcn_cvt_pk_fp8_f32(a, b, 0, false); v = __builtin_amdgcn_cvt_pk_fp8_f32(c, d, v, true); return (unsigned)v; }
struct EpiBf16 {
    struct Pre {}; __device__ __forceinline__ Pre pre(const Unit&, int, int, int, int) const { return Pre{}; }
    static constexpr bool PERM = true;
    bf16_t* O; int ldc; float scale;
    __device__ __forceinline__ void operator()(const f32x4 (&acc)[2][2][4][2], const Unit& u, int wr, int wc, int fr, int fq, const Pre& P) const {
        const int row0 = u.pm * BM + wr * 64 + fr, col0 = u.pn * BM + wc * 32 + 8 * fq;
#pragma unroll
        for (int ai = 0; ai < 2; ++ai)
#pragma unroll
            for (int m = 0; m < 4; ++m) { bf16_t* rowp = O + (size_t)(row0 + ai * HALF + m * 16) * ldc + col0;
#pragma unroll
                for (int bj = 0; bj < 2; ++bj) { const f32x4 v0 = acc[ai][bj][m][0] * scale, v1 = acc[ai][bj][m][1] * scale;
                    u32x4 w; w.x = cvt_pk_bf16(v0[0], v0[1]); w.y = cvt_pk_bf16(v0[2], v0[3]); w.z = cvt_pk_bf16(v1[0], v1[1]); w.w = cvt_pk_bf16(v1[2], v1[3]);
                    *(u32x4*)(rowp + bj * HALF) = w; } }
    }
};
struct EpiRowScaleBf16 {
    struct Pre { float rq[2][4]; };
    __device__ __forceinline__ Pre pre(const Unit& u, int wr, int, int fr, int) const { Pre p; const int row0 = u.pm * BM + wr * 64 + fr;
        _Pragma("unroll") for (int ai = 0; ai < 2; ++ai) _Pragma("unroll") for (int m = 0; m < 4; ++m) p.rq[ai][m] = rowsq[row0 + ai * HALF + m * 16]; return p; }
    static constexpr bool PERM = true;
    bf16_t* O; int ldc; const float* rowsq; float inv_n, eps, scale;
    __device__ __forceinline__ void operator()(const f32x4 (&acc)[2][2][4][2], const Unit& u, int wr, int wc, int fr, int fq, const Pre& P) const {
        const int row0 = u.pm * BM + wr * 64 + fr, col0 = u.pn * BM + wc * 32 + 8 * fq;
#pragma unroll
        for (int ai = 0; ai < 2; ++ai)
#pragma unroll
            for (int m = 0; m < 4; ++m) { const int r = row0 + ai * HALF + m * 16; const float s = __builtin_amdgcn_rsqf(P.rq[ai][m] * inv_n + eps) * scale;
                bf16_t* rowp = O + (size_t)r * ldc + col0;
#pragma unroll
                for (int bj = 0; bj < 2; ++bj) { const f32x4 v0 = acc[ai][bj][m][0] * s, v1 = acc[ai][bj][m][1] * s;
                    u32x4 w; w.x = cvt_pk_bf16(v0[0], v0[1]); w.y = cvt_pk_bf16(v0[2], v0[3]); w.z = cvt_pk_bf16(v1[0], v1[1]); w.w = cvt_pk_bf16(v1[2], v1[3]);
                    *(u32x4*)(rowp + bj * HALF) = w; } }
    }
};
struct EpiResidIn {
    struct Pre {}; __device__ __forceinline__ Pre pre(const Unit&, int, int, int, int) const { return Pre{}; }
    static constexpr bool PERM = true;
    const float* base; bf16_t* xo; unsigned char* x8; float* rowsq; int ldc;
    __device__ __forceinline__ void operator()(const f32x4 (&acc)[2][2][4][2], const Unit& u, int wr, int wc, int fr, int fq, const Pre& P) const {
        const int row0 = u.pm * BM + wr * 64 + fr, col0 = u.pn * BM + wc * 32 + 8 * fq;
#pragma unroll
        for (int ai = 0; ai < 2; ++ai) {
            f32x4 b[4][2][2];
#pragma unroll
            for (int m = 0; m < 4; ++m)
#pragma unroll
                for (int bj = 0; bj < 2; ++bj)
#pragma unroll
                    for (int n = 0; n < 2; ++n) b[m][bj][n] = *(const f32x4*)(base + (size_t)(row0 + ai * HALF + m * 16) * ldc + col0 + bj * HALF + 4 * n);
#pragma unroll
            for (int m = 0; m < 4; ++m) { const int r = row0 + ai * HALF + m * 16; const size_t off = (size_t)r * ldc + col0; float ss = 0.f;
#pragma unroll
                for (int bj = 0; bj < 2; ++bj) { const f32x4 v0 = b[m][bj][0] + acc[ai][bj][m][0], v1 = b[m][bj][1] + acc[ai][bj][m][1];
                    u32x4 w; w.x = cvt_pk_bf16(v0[0], v0[1]); w.y = cvt_pk_bf16(v0[2], v0[3]); w.z = cvt_pk_bf16(v1[0], v1[1]); w.w = cvt_pk_bf16(v1[2], v1[3]);
                    *(u32x4*)(xo + off + bj * HALF) = w;
                    u32x2 q; q.x = pk4_fp8(v0[0], v0[1], v0[2], v0[3]); q.y = pk4_fp8(v1[0], v1[1], v1[2], v1[3]); *(u32x2*)(x8 + off + bj * HALF) = q;
                    ss += ((v0[0] * v0[0] + v0[1] * v0[1]) + (v0[2] * v0[2] + v0[3] * v0[3])) + ((v1[0] * v1[0] + v1[1] * v1[1]) + (v1[2] * v1[2] + v1[3] * v1[3])); }
                ss += __shfl_xor(ss, 16); ss += __shfl_xor(ss, 32); if (fq == 0) atomicAdd(rowsq + r, ss); }
            asm volatile("" ::: "memory"); }
    }
};
struct EpiResidBf {
    struct Pre {}; __device__ __forceinline__ Pre pre(const Unit&, int, int, int, int) const { return Pre{}; }
    static constexpr bool PERM = true;
    bf16_t* x; int ldc; float ascale;
    __device__ __forceinline__ void operator()(const f32x4 (&acc)[2][2][4][2], const Unit& u, int wr, int wc, int fr, int fq, const Pre& P) const {
        const int row0 = u.pm * BM + wr * 64 + fr, col0 = u.pn * BM + wc * 32 + 8 * fq;
        u32x4 b[2][4][2];
#pragma unroll
        for (int ai = 0; ai < 2; ++ai)
#pragma unroll
            for (int m = 0; m < 4; ++m)
#pragma unroll
                for (int bj = 0; bj < 2; ++bj) b[ai][m][bj] = *(const u32x4*)(x + (size_t)(row0 + ai * HALF + m * 16) * ldc + col0 + bj * HALF);
#pragma unroll
        for (int ai = 0; ai < 2; ++ai)
#pragma unroll
            for (int m = 0; m < 4; ++m) { const size_t off = (size_t)(row0 + ai * HALF + m * 16) * ldc + col0;
#pragma unroll
                for (int bj = 0; bj < 2; ++bj) { const f32x4 a0 = acc[ai][bj][m][0] * ascale, a1 = acc[ai][bj][m][1] * ascale; const u32x4 p = b[ai][m][bj];
                    u32x4 w; w.x = cvt_pk_bf16(__builtin_bit_cast(float, p.x << 16) + a0[0], __builtin_bit_cast(float, p.x & 0xffff0000u) + a0[1]);
                    w.y = cvt_pk_bf16(__builtin_bit_cast(float, p.y << 16) + a0[2], __builtin_bit_cast(float, p.y & 0xffff0000u) + a0[3]);
                    w.z = cvt_pk_bf16(__builtin_bit_cast(float, p.z << 16) + a1[0], __builtin_bit_cast(float, p.z & 0xffff0000u) + a1[1]);
                    w.w = cvt_pk_bf16(__builtin_bit_cast(float, p.w << 16) + a1[2], __builtin_bit_cast(float, p.w & 0xffff0000u) + a1[3]);
                    *(u32x4*)(x + off + bj * HALF) = w; } }
    }
};
struct EpiSoftmaxF8 {
    static constexpr bool PERM = true;
    struct Pre { float rq[2][4]; };
    __device__ __forceinline__ Pre pre(const Unit& u, int wr, int, int fr, int) const { Pre p; const int row0 = u.pm * BM + wr * 64 + fr;
        _Pragma("unroll") for (int ai = 0; ai < 2; ++ai) _Pragma("unroll") for (int m = 0; m < 4; ++m) p.rq[ai][m] = rowsq[row0 + ai * HALF + m * 16]; return p; }
    unsigned char* O; int ldc; const float* rowsq; float inv_n, eps, sscale; PG8_LAS float* xch;
    __device__ __forceinline__ void operator()(f32x4 (&acc)[2][2][4][2], const Unit& u, int wr, int wc, int fr, int fq, const Pre& P) const {
        const int row0 = u.pm * BM + wr * 64 + fr, col0 = u.pn * BM + wc * 32 + 8 * fq, rl0 = wr * 64 + fr;
        float f[2][4];
#pragma unroll
        for (int ai = 0; ai < 2; ++ai)
#pragma unroll
            for (int m = 0; m < 4; ++m) { f[ai][m] = __builtin_amdgcn_rsqf(P.rq[ai][m] * inv_n + eps) * sscale; float mx = -INFINITY;
#pragma unroll
                for (int bj = 0; bj < 2; ++bj)
#pragma unroll
                    for (int n = 0; n < 2; ++n) { const f32x4 v = acc[ai][bj][m][n]; mx = fmaxf(mx, fmaxf(fmaxf(v[0], v[1]), fmaxf(v[2], v[3]))); }
                mx = fmaxf(mx, __shfl_xor(mx, 16)); mx = fmaxf(mx, __shfl_xor(mx, 32));
                if (fq == 0) xch[(rl0 + ai * HALF + m * 16) * 4 + wc] = mx * f[ai][m]; }
        asm volatile("s_waitcnt lgkmcnt(0)" ::: "memory"); __builtin_amdgcn_s_barrier(); asm volatile("" ::: "memory");
#pragma unroll
        for (int ai = 0; ai < 2; ++ai)
#pragma unroll
            for (int m = 0; m < 4; ++m) { const f32x4 x4 = *(const PG8_LAS f32x4*)(xch + (rl0 + ai * HALF + m * 16) * 4); const float M = fmaxf(fmaxf(x4[0], x4[1]), fmaxf(x4[2], x4[3])); float sm = 0.f;
#pragma unroll
                for (int bj = 0; bj < 2; ++bj)
#pragma unroll
                    for (int n = 0; n < 2; ++n) { f32x4 v = acc[ai][bj][m][n];
#pragma unroll
                        for (int i = 0; i < 4; ++i) { v[i] = __builtin_amdgcn_exp2f(v[i] * f[ai][m] - M); sm += v[i]; }
                        acc[ai][bj][m][n] = v; }
                sm += __shfl_xor(sm, 16); sm += __shfl_xor(sm, 32);
                if (fq == 0) xch[1024 + (rl0 + ai * HALF + m * 16) * 4 + wc] = sm; }
        asm volatile("s_waitcnt lgkmcnt(0)" ::: "memory"); __builtin_amdgcn_s_barrier(); asm volatile("" ::: "memory");
#pragma unroll
        for (int ai = 0; ai < 2; ++ai)
#pragma unroll
            for (int m = 0; m < 4; ++m) { const f32x4 s4 = *(const PG8_LAS f32x4*)(xch + 1024 + (rl0 + ai * HALF + m * 16) * 4); const float sc = 128.0f * __builtin_amdgcn_rcpf((s4[0] + s4[1]) + (s4[2] + s4[3]));
                unsigned char* rowp = O + (size_t)(row0 + ai * HALF + m * 16) * ldc + col0;
#pragma unroll
                for (int bj = 0; bj < 2; ++bj) { const f32x4 v0 = acc[ai][bj][m][0] * sc, v1 = acc[ai][bj][m][1] * sc;
                    u32x2 w; w.x = pk4_fp8(v0[0], v0[1], v0[2], v0[3]); w.y = pk4_fp8(v1[0], v1[1], v1[2], v1[3]); *(u32x2*)(rowp + bj * HALF) = w; } }
    }
};
struct EpiSwiGLU {
    struct Pre { f32x4 bgv[2], buv[2]; };
    __device__ __forceinline__ Pre pre(const Unit& u, int, int wc, int, int fq) const { Pre p; const float* bg = bias + (size_t)u.e * 2048 + u.pn * HALF + wc * 32 + 8 * fq;
        _Pragma("unroll") for (int n = 0; n < 2; ++n) { p.bgv[n] = *(const f32x4*)(bg + 4 * n); p.buv[n] = *(const f32x4*)(bg + 1024 + 4 * n); } return p; }
    static constexpr bool PERM = true;
    unsigned char* O; const float* bias; float wscale;
    __device__ __forceinline__ void operator()(const f32x4 (&acc)[2][2][4][2], const Unit& u, int wr, int wc, int fr, int fq, const Pre& P) const {
        const int row0 = u.pm * BM + wr * 64 + fr, colj = u.pn * HALF + wc * 32 + 8 * fq;
#pragma unroll
        for (int ai = 0; ai < 2; ++ai)
#pragma unroll
            for (int m = 0; m < 4; ++m) { unsigned char* rowp = O + (size_t)(row0 + ai * HALF + m * 16) * 1024 + colj; float o[8];
#pragma unroll
                for (int n = 0; n < 2; ++n) { const f32x4 g4 = acc[ai][0][m][n] * wscale + P.bgv[n], u4 = acc[ai][1][m][n] * wscale + P.buv[n];
#pragma unroll
                    for (int i = 0; i < 4; ++i) { const float g = fminf(g4[i], 7.0f), up = fminf(fmaxf(u4[i], -7.0f), 7.0f);
                        const float sg = __builtin_amdgcn_rcpf(1.0f + __builtin_amdgcn_exp2f(g * (-1.702f * 1.44269504f)));
                        o[4 * n + i] = (up + 1.0f) * (g * sg); } }
                u32x2 w; w.x = pk4_fp8(o[0], o[1], o[2], o[3]); w.y = pk4_fp8(o[4], o[5], o[6], o[7]);
                __hip_atomic_store((unsigned long long*)rowp, (unsigned long long)w.x | ((unsigned long long)w.y << 32), __ATOMIC_RELAXED, __HIP_MEMORY_SCOPE_AGENT); }
    }
};
struct EpiBiasF8 {
    static constexpr bool PERM = true;
    struct Pre { f32x4 bv[2][2]; };
    __device__ __forceinline__ Pre pre(const Unit& u, int, int wc, int, int fq) const { Pre p; const float* bp = bias + (size_t)u.e * 1024 + u.pn * BM + wc * 32 + 8 * fq;
        _Pragma("unroll") for (int bj = 0; bj < 2; ++bj) _Pragma("unroll") for (int n = 0; n < 2; ++n) p.bv[bj][n] = *(const f32x4*)(bp + bj * HALF + 4 * n); return p; }
    unsigned char* O; const float* bias; float wscale;
    __device__ __forceinline__ void operator()(const f32x4 (&acc)[2][2][4][2], const Unit& u, int wr, int wc, int fr, int fq, const Pre& P) const {
        const int row0 = u.pm * BM + wr * 64 + fr, col0 = u.pn * BM + wc * 32 + 8 * fq;
#pragma unroll
        for (int ai = 0; ai < 2; ++ai)
#pragma unroll
            for (int m = 0; m < 4; ++m) { unsigned char* rowp = O + (size_t)(row0 + ai * HALF + m * 16) * 1024 + col0;
#pragma unroll
                for (int bj = 0; bj < 2; ++bj) { const f32x4 v0 = acc[ai][bj][m][0] * wscale + P.bv[bj][0], v1 = acc[ai][bj][m][1] * wscale + P.bv[bj][1];
                    u32x2 w; w.x = pk4_fp8(v0[0], v0[1], v0[2], v0[3]); w.y = pk4_fp8(v1[0], v1[1], v1[2], v1[3]);
                    *(u32x2*)(rowp + bj * HALF) = w; } }
    }
};

typedef int i32x4 __attribute__((ext_vector_type(4)));
typedef int i32x8 __attribute__((ext_vector_type(8)));
__device__ __forceinline__ i32x8 cat16(bf16x8 a, bf16x8 b) { return __builtin_shufflevector(__builtin_bit_cast(i32x4, a), __builtin_bit_cast(i32x4, b), 0, 1, 2, 3, 4, 5, 6, 7); }
typedef int i32x6 __attribute__((ext_vector_type(6)));
typedef bf16x8 __attribute__((aligned(8))) bf16x8_a8;
__device__ __forceinline__ i32x6 cat6(bf16x8 a, bf16x8 b) { return __builtin_shufflevector(__builtin_bit_cast(i32x4, a), __builtin_bit_cast(i32x4, b), 0, 1, 2, 3, 4, 5); }
constexpr int B6_KT = 256 * 96, B6_TILE = 8 * B6_KT;
template <class Epi, class Sched, bool ALIGN_EPI, int FP8 = 0>
__device__ __forceinline__ void gemm_phase(PG8_LAS unsigned char* lds, const Gemm g, const Sched& S, const Epi& E, int wid) {
    const int lane = lane_id(), tid = wid * 64 + lane, wr = wid >> 2, wc = wid & 3, fr = lane & 15, fq = lane >> 4;
    const int K = g.K, nt = K / BK, kmask = nt - 1, krot = nt >> 3;
#define PG8_KOFF(u) (((u).pm + (u).pn) * krot & kmask)
    unsigned voffA[2], voffB[2]; int RA[2], CA[2];
#pragma unroll
    for (int i = 0; i < 2; ++i) { int R, C; stage_rc(tid * 16 + i * 8192, R, C); const int Rb = Epi::PERM ? ((R & ~31) + perm32(R & 31)) : R;
        RA[i] = R; CA[i] = C; voffA[i] = (unsigned)(R * K + C) * 2u; voffB[i] = (unsigned)(Rb * K + C) * 2u; }
    const size_t kstep = (size_t)(BK * 2);
    const size_t hstep = (size_t)HALF * K * 2;
    const size_t tstep = 2 * hstep;
    const unsigned ldsw = (unsigned)wid * 1024u;
    const int aoff = lds_byte(wr * 64 + fr, fq * 8), boff = (FP8 == 2) ? (wc * 32 + fr) * 96 + ((fq + 2 * (fr >> 3)) & 3) * 24 : lds_byte(wc * 32 + fr, fq * 8);
    const unsigned voffB6 = (unsigned)tid * 16u;
#define PG8_SA(b, h) (((b) * 2 + (h)) * HTB)
#define PG8_SB(b, h) ((4 + (b) * 2 + (h)) * HTB)
#define PG8_STAGEB6(b, gbase) do { _Pragma("unroll") for (int _i = 0; _i < 3; ++_i) \
        __builtin_amdgcn_global_load_lds((const unsigned*)((const char*)(gbase) + voffB6 + _i * 8192), (PG8_LAS unsigned*)(lds + PG8_SB(b, 0) + ldsw + _i * 8192), 16, 0, 0); } while (0)
#define PG8_STB(b, pb, p6) do { if constexpr (FP8 == 2) { PG8_STAGEB6(b, p6); } else { PG8_STAGE(PG8_SB(b, 0), pb, voffB); PG8_STAGE(PG8_SB(b, 1), (pb) + hstep, voffB); } } while (0)
#define PG8_STAGE(bufoff, gbase, voff) do { _Pragma("unroll") for (int _i = 0; _i < 2; ++_i) \
        __builtin_amdgcn_global_load_lds((const unsigned*)((const char*)(gbase) + (voff)[_i]), (PG8_LAS unsigned*)(lds + (bufoff) + ldsw + _i * 8192), 16, 0, 0); } while (0)
#define PG8_STAGE2(bufoff, gbase, v0, v1) do { \
        __builtin_amdgcn_global_load_lds((const unsigned*)((const char*)(gbase) + (v0)), (PG8_LAS unsigned*)(lds + (bufoff) + ldsw), 16, 0, 0); \
        __builtin_amdgcn_global_load_lds((const unsigned*)((const char*)(gbase) + (v1)), (PG8_LAS unsigned*)(lds + (bufoff) + ldsw + 8192), 16, 0, 0); } while (0)
#define PG8_STA(bufoff, h, pNG, pG, nx) do { if constexpr (Sched::GATHER) { const unsigned _v0 = (nx) ? nv[h][0] : cv[h][0], _v1 = (nx) ? nv[h][1] : cv[h][1]; PG8_STAGE2(bufoff, pG, _v0, _v1); } \
        else { PG8_STAGE(bufoff, (pNG) + (h) * hstep, voffA); } } while (0)
#define PG8_LDA(dst, b, h) do { _Pragma("unroll") for (int m = 0; m < 4; ++m) _Pragma("unroll") for (int k = 0; k < 2; ++k) dst[m][k] = *(const PG8_LAS bf16x8*)(lds + PG8_SA(b, h) + aoff + m * 2048 + k * 1024); } while (0)
#define PG8_LDB(dst, b, h) do { if constexpr (FP8 == 2) { _Pragma("unroll") for (int n = 0; n < 2; ++n) { const PG8_LAS unsigned char* _p = lds + PG8_SB(b, 0) + boff + (h) * 12288 + n * 1536; \
            const u32x2 _t0 = *(const volatile PG8_LAS u32x2*)_p, _t1 = *(const volatile PG8_LAS u32x2*)(_p + 8), _t2 = *(const volatile PG8_LAS u32x2*)(_p + 16); \
            dst[n][0] = __builtin_bit_cast(bf16x8, __builtin_shufflevector(_t0, _t1, 0, 1, 2, 3)); dst[n][1] = __builtin_bit_cast(bf16x8, __builtin_shufflevector(_t2, _t2, 0, 1, -1, -1)); } } \
        else { _Pragma("unroll") for (int n = 0; n < 2; ++n) _Pragma("unroll") for (int k = 0; k < 2; ++k) dst[n][k] = *(const PG8_LAS bf16x8*)(lds + PG8_SB(b, h) + boff + n * 2048 + k * 1024); } } while (0)
#define PG8_MMA(ai, bj, At, Bt) do { __builtin_amdgcn_s_setprio(1); \
        if constexpr (FP8 == 2) { _Pragma("unroll") for (int m = 0; m < 4; ++m) _Pragma("unroll") for (int n = 0; n < 2; ++n) \
            asm volatile("s_nop 1\n\tv_mfma_scale_f32_16x16x128_f8f6f4 %0, %1, %2, %0, %3, %3 op_sel_hi:[0,0,0] cbsz:2" : "+v"(acc[ai][bj][m][n]) : "v"(cat6(Bt[n][0], Bt[n][1])), "v"(cat16(At[m][0], At[m][1])), "v"(mxs)); } \
        else if constexpr (FP8 == 1) { _Pragma("unroll") for (int m = 0; m < 4; ++m) _Pragma("unroll") for (int n = 0; n < 2; ++n) \
            asm volatile("v_mfma_scale_f32_16x16x128_f8f6f4 %0, %1, %2, %0, %3, %3 op_sel_hi:[0,0,0]" : "+v"(acc[ai][bj][m][n]) : "v"(cat16(Bt[n][0], Bt[n][1])), "v"(cat16(At[m][0], At[m][1])), "v"(mxs)); } \
        else { _Pragma("unroll") for (int m = 0; m < 4; ++m) _Pragma("unroll") for (int n = 0; n < 2; ++n) _Pragma("unroll") for (int k = 0; k < 2; ++k) \
            acc[ai][bj][m][n] = __builtin_amdgcn_mfma_f32_16x16x32_bf16(Bt[n][k], At[m][k], acc[ai][bj][m][n], 0, 0, 0); } \
        __builtin_amdgcn_s_setprio(0); } while (0)
#define PG8_WAIT_V(n) asm volatile("s_waitcnt vmcnt(" #n ")" ::: "memory")
#define PG8_WAIT_L(n) asm volatile("s_waitcnt lgkmcnt(" #n ")" ::: "memory")
#define PG8_WAIT_VK do { if constexpr (FP8 == 2) PG8_WAIT_V(7); else PG8_WAIT_V(8); } while (0)
#define PG8_BAR __builtin_amdgcn_s_barrier()
#define PG8_SCHED __builtin_amdgcn_sched_barrier(0)
    Unit cur, nxt; int ui = 0;
    if (!S.next(0, cur)) return;
    int sig_pm = -1;
    const int mxs = 0x7f7f7f7f;
    f32x4 acc[2][2][4][2];
#pragma unroll
    for (int a = 0; a < 2; ++a)
#pragma unroll
        for (int b = 0; b < 2; ++b)
#pragma unroll
            for (int m = 0; m < 4; ++m)
#pragma unroll
                for (int n = 0; n < 2; ++n) acc[a][b][m][n] = (f32x4){0.f, 0.f, 0.f, 0.f};
    bf16x8 At[4][2], B0[2][2], B1[2][2];
    const char* gA0 = (const char*)g.A;
    const size_t btstep = (FP8 == 2) ? (size_t)B6_TILE : tstep, kmulB = (FP8 == 2) ? (size_t)(B6_KT / (BK * 2)) : (size_t)1;
    const char* cA = gA0 + (size_t)cur.pm * tstep; const char* cB = (const char*)g.Bt + (size_t)cur.e * g.bstride + (size_t)cur.pn * btstep;
    unsigned cv[2][2], nv[2][2];
#pragma unroll
    for (int h = 0; h < 2; ++h)
#pragma unroll
        for (int i = 0; i < 2; ++i) { cv[h][i] = 0u; nv[h][i] = 0u; }
    if constexpr (Sched::GATHER) {
#pragma unroll
        for (int h = 0; h < 2; ++h)
#pragma unroll
            for (int i = 0; i < 2; ++i) cv[h][i] = ((unsigned)S.arow(0, h * HALF + RA[i]) * (unsigned)K + (unsigned)CA[i]) * 2u;
    }
    int coff = PG8_KOFF(cur);
    { const size_t k0 = (size_t)coff * kstep, k1 = (size_t)((coff + 1) & kmask) * kstep;
    PG8_STB(0, cB + k0 * kmulB, cB + k0 * kmulB); PG8_STA(PG8_SA(0, 0), 0, cA + k0, gA0 + k0, false); PG8_STA(PG8_SA(0, 1), 1, cA + k0, gA0 + k0, false);
    if (wr == 1) PG8_BAR;
    PG8_WAIT_V(2); PG8_BAR;
    if constexpr (FP8 == 2) { PG8_STB(1, cB + k1 * kmulB, cB + k1 * kmulB); PG8_STA(PG8_SA(1, 0), 0, cA + k1, gA0 + k1, false); }
    else { PG8_STAGE(PG8_SB(1, 0), cB + k1, voffB); PG8_STA(PG8_SA(1, 0), 0, cA + k1, gA0 + k1, false); PG8_STAGE(PG8_SB(1, 1), cB + hstep + k1, voffB); } }
    if constexpr (FP8 == 2) PG8_WAIT_V(5); else PG8_WAIT_V(6);
    PG8_BAR;
    for (;;) {
        const bool has_next = S.next(ui + 1, nxt);
        const typename Epi::Pre epre = E.pre(cur, wr, wc, fr, fq);
        const int noff = has_next ? PG8_KOFF(nxt) : coff;
        const char* nA = has_next ? gA0 + (size_t)nxt.pm * tstep : cA; const char* nB = has_next ? (const char*)g.Bt + (size_t)nxt.e * g.bstride + (size_t)nxt.pn * btstep : cB;
        if constexpr (Sched::GATHER) {
#pragma unroll
            for (int h = 0; h < 2; ++h)
#pragma unroll
                for (int i = 0; i < 2; ++i) nv[h][i] = has_next ? ((unsigned)S.arow(ui + 1, h * HALF + RA[i]) * (unsigned)K + (unsigned)CA[i]) * 2u : cv[h][i];
        }
#pragma unroll 1
        for (int t = 0; t < nt; t += 2) {
            const bool last = (t == nt - 2);
            if constexpr (Sched::GATHER) { if (t == 2 && sig_pm >= 0) {
                if (S.done && tid == 0) (void)__hip_atomic_fetch_add(S.done + 64 * sig_pm, 1u, __ATOMIC_RELAXED, __HIP_MEMORY_SCOPE_AGENT); sig_pm = -1; } }
            const size_t k1 = (size_t)((t + 1 + coff) & kmask) * kstep, k2 = (size_t)((last ? noff : t + 2 + coff) & kmask) * kstep, k3 = (size_t)((last ? noff + 1 : t + 3 + coff) & kmask) * kstep;
            const char* pa = last ? nA : cA; const char* pb = last ? nB : cB;
            const char* a1 = cA + k1; const char* a1g = gA0 + k1;
            const char* a2 = pa + k2; const char* b2 = pb + k2 * kmulB; const char* a2g = gA0 + k2;
            const char* a3 = pa + k3; const char* b3 = pb + k3 * kmulB; const char* a3g = gA0 + k3;
            PG8_LDB(B0, 0, 0); PG8_LDB(B1, 0, 1); PG8_SCHED; PG8_LDA(At, 0, 0); PG8_STA(PG8_SA(1, 1), 1, a1, a1g, false);
            PG8_WAIT_VK; PG8_WAIT_L(0); PG8_BAR; PG8_MMA(0, 0, At, B0); PG8_MMA(0, 1, At, B1); PG8_BAR; PG8_SCHED;
            PG8_LDA(At, 0, 1); PG8_STB(0, b2, b2); PG8_STA(PG8_SA(0, 0), 0, a2, a2g, last);
            PG8_WAIT_VK; PG8_WAIT_L(0); PG8_BAR; PG8_MMA(1, 0, At, B0); PG8_MMA(1, 1, At, B1); PG8_BAR; PG8_SCHED;
            PG8_LDB(B0, 1, 0); PG8_LDB(B1, 1, 1); PG8_SCHED; PG8_LDA(At, 1, 0); PG8_STA(PG8_SA(0, 1), 1, a2, a2g, last);
            PG8_WAIT_VK; PG8_WAIT_L(0); PG8_BAR; PG8_MMA(0, 0, At, B0); PG8_MMA(0, 1, At, B1); PG8_BAR; PG8_SCHED;
            PG8_LDA(At, 1, 1); PG8_STB(1, b3, b3); PG8_STA(PG8_SA(1, 0), 0, a3, a3g, last);
            PG8_WAIT_VK; PG8_WAIT_L(0); PG8_BAR; PG8_MMA(1, 0, At, B0); PG8_MMA(1, 1, At, B1); PG8_BAR; PG8_SCHED;
        }
        if constexpr (ALIGN_EPI) { if (wr == 0) PG8_BAR; }
        if constexpr (FP8) asm volatile("s_nop 15\n\ts_nop 3" ::: "memory");
        { int le = lane; asm volatile("" : "+v"(le));
          E(acc, cur, wr, wc, le & 15, le >> 4, epre); }
        if (!has_next) break;
#pragma unroll
        for (int a = 0; a < 2; ++a)
#pragma unroll
            for (int b = 0; b < 2; ++b)
#pragma unroll
                for (int m = 0; m < 4; ++m)
#pragma unroll
                    for (int n = 0; n < 2; ++n) acc[a][b][m][n] = (f32x4){0.f, 0.f, 0.f, 0.f};
        if constexpr (Sched::GATHER) sig_pm = cur.pm;
        cur = nxt; cA = nA; cB = nB; coff = noff; ++ui;
        if constexpr (Sched::GATHER) {
#pragma unroll
            for (int h = 0; h < 2; ++h)
#pragma unroll
                for (int i = 0; i < 2; ++i) cv[h][i] = nv[h][i];
        }
        if constexpr (ALIGN_EPI) { if (wr == 1) PG8_BAR; }
    }
    PG8_WAIT_V(0);
    if constexpr (!ALIGN_EPI) { if (wr == 0) PG8_BAR; }
    PG8_BAR;
    if constexpr (Sched::GATHER) { if (S.done && tid == 0) { if (sig_pm >= 0) (void)__hip_atomic_fetch_add(S.done + 64 * sig_pm, 1u, __ATOMIC_RELAXED, __HIP_MEMORY_SCOPE_AGENT);
            (void)__hip_atomic_fetch_add(S.done + 64 * cur.pm, 1u, __ATOMIC_RELAXED, __HIP_MEMORY_SCOPE_AGENT); } }
#undef PG8_KOFF
#undef PG8_SA
#undef PG8_SB
#undef PG8_STAGE
#undef PG8_STAGE2
#undef PG8_STA
#undef PG8_LDA
#undef PG8_LDB
#undef PG8_MMA
#undef PG8_WAIT_V
#undef PG8_WAIT_L
#undef PG8_WAIT_VK
#undef PG8_STB
#undef PG8_STAGEB6
#undef PG8_BAR
#undef PG8_SCHED
}
}

constexpr int NWAVES = 8, NTHR = NWAVES * 64;
constexpr int BATCH = 2, SEQ = 8192, D = 1024, M = BATCH * SEQ;
constexpr int NZ = 2048;
constexpr int CW = 512;
constexpr int MEMLEN = 256, NH = 4, HD = 256, MKV = BATCH * MEMLEN;
constexpr int NE = 32, TOPK = 4, DE = 1024, ECAP = 16384;
constexpr int MAXTILES = (M * TOPK) / 256 + NE;
constexpr float EPS = 1e-5f;
constexpr float WSCALE = 32.0f;
constexpr float QSCALE = 0.0625f * 1.44269504f;
constexpr int FN1 = 128, FN2 = 64;

constexpr size_t MiB = 1u << 20;
constexpr size_t WS_CTL = 0, CTL_ZERO_BYTES = 1 * MiB;
constexpr size_t WS_WINT = 2 * MiB, WS_WOUTT = 6 * MiB, WS_WQT = 8 * MiB, WS_WKT = 10 * MiB, WS_WVT = 12 * MiB, WS_WOT = 14 * MiB;
constexpr size_t WS_WRG = 16 * MiB;
constexpr size_t WS_TAB = 17 * MiB;
constexpr size_t WS_MC = 18 * MiB;
constexpr size_t WS_MEMN = 22 * MiB, WS_KB = 23 * MiB, WS_VT = 24 * MiB;
constexpr size_t WS_TOK = 25 * MiB;
constexpr size_t WS_ETOK = 26 * MiB;
constexpr size_t WS_WGUT = 32 * MiB, WS_WDT = 160 * MiB;
constexpr size_t WS_XR = 224 * MiB;
constexpr size_t WS_XN3 = 288 * MiB;
constexpr size_t WS_CTR = 320 * MiB;
constexpr size_t WS_XN = 464 * MiB, WS_Z = 496 * MiB, WS_G = 560 * MiB, WS_Y = 592 * MiB, WS_XB = 624 * MiB, WS_Q = 656 * MiB, WS_O = 688 * MiB;
constexpr size_t WS_ACT = 464 * MiB;
constexpr size_t WS_WQN = 28 * MiB, WS_WOT16 = 30 * MiB;
constexpr size_t WS_MK = WS_Q, WS_MV = WS_Q + 2 * MiB;
constexpr size_t WS_P = WS_O;
constexpr size_t WS_END = 720 * MiB;
constexpr size_t TAB_WA = 128 * 1024;
constexpr size_t TAB_DCH = 256 * 1024;
constexpr int CW_BAR = 4096;
constexpr int CW_CNT = 8192;
constexpr int CW_ROWSQ = 16384;
constexpr int CW_DONE = 131072;
static_assert((CW_DONE + 64 * 320) * 4 <= (int)CTL_ZERO_BYTES, "ctl");
constexpr int CW_GRP = 65536;
static_assert((CW_GRP + 64 * 64 * 3) * 4 <= (int)CTL_ZERO_BYTES, "ctl");
static_assert((CW_ROWSQ + M) * 4 <= (int)CTL_ZERO_BYTES, "ctl");

constexpr int LDS_BYTES = 147456;
constexpr int RING_BYTES = 131072, LDSCTL_OFF = LDS_BYTES - 512, MISC_OFF = LDSCTL_OFF + 320;
constexpr int MOE_TAB_OFF = 143360;

#define GAS __attribute__((address_space(1)))
#define LAS __attribute__((address_space(3)))
typedef unsigned short bf16;
typedef unsigned v4u __attribute__((ext_vector_type(4)));
typedef unsigned v2u __attribute__((ext_vector_type(2)));
typedef float f32x4 __attribute__((ext_vector_type(4)));
typedef GAS unsigned gu32;
typedef float f32x2v __attribute__((ext_vector_type(2)));
#define RLX_AGENT __ATOMIC_RELAXED, __HIP_MEMORY_SCOPE_AGENT
#define LDS_WAIT() asm volatile("s_waitcnt lgkmcnt(0)" ::: "memory")
__device__ __forceinline__ unsigned pk2(float lo, float hi) { return pg8::cvt_pk_bf16(lo, hi); }
__device__ __forceinline__ unsigned f2bf(float f) { return pg8::cvt_pk_bf16(f, 0.f) & 0xffffu; }
__device__ __forceinline__ float bf2f(unsigned short b) { return __builtin_bit_cast(float, (unsigned)b << 16); }
__device__ __forceinline__ float bflo(unsigned w) { return __builtin_bit_cast(float, w << 16); }
__device__ __forceinline__ float bfhi(unsigned w) { return __builtin_bit_cast(float, w & 0xffff0000u); }

#define XB_TMO      128
#define XB_XCNT(j)  (256  + 64 * (j))
#define XB_XSUB(j)  (1280 + 64 * (j))
#define XB_XGEN(j)  (2304 + 64 * (j))
#define XB_TOP      3328
#define XB_TOPGEN   3392
#define XCD_BAR_WORDS 3456
#define XB_SPIN_CAP (1u << 18)
__device__ __forceinline__ unsigned xb_ld(unsigned* p)              { return __hip_atomic_load(p, __ATOMIC_RELAXED, __HIP_MEMORY_SCOPE_AGENT); }
__device__ __forceinline__ unsigned xb_add(unsigned* p, unsigned v) { return __hip_atomic_fetch_add(p, v, __ATOMIC_RELAXED, __HIP_MEMORY_SCOPE_AGENT); }
__device__ __forceinline__ unsigned xb_xcc_id() { return (unsigned)__builtin_amdgcn_s_getreg((3 << 11) | 20) & 0xFu; }
#define XB_SPIN(cond, bar) do { unsigned _sp = 0; while (cond) { __builtin_amdgcn_s_sleep(1); \
    if ((++_sp & 255u) == 0u) { if (xb_ld(&(bar)[XB_TMO])) break; if (_sp > XB_SPIN_CAP) { atomicAdd(&(bar)[XB_TMO], 1u); break; } } } } while (0)
struct XcdBarrier { unsigned* bar; unsigned x; volatile LAS unsigned* st; };
__device__ __forceinline__ XcdBarrier xcd_barrier_post(unsigned* bar, volatile LAS unsigned* st, bool leader) {
    XcdBarrier b; b.bar = bar; b.x = xb_xcc_id(); b.st = st;
    if (leader) (void)xb_add(&bar[XB_XCNT(b.x)], 1u);
    return b;
}
__device__ __forceinline__ void xcd_barrier_complete(unsigned* bar, unsigned x, unsigned& nloc, unsigned& nx) {
    const unsigned G = gridDim.x * gridDim.y * gridDim.z;
    unsigned sum, cnt, mine, sp = 0u;
    for (;;) {
        sum = 0u; cnt = 0u; mine = 0u;
#pragma unroll
        for (unsigned j = 0; j < 16; ++j) { const unsigned c = xb_ld(&bar[XB_XCNT(j)]); sum += c; cnt += (c > 0u) ? 1u : 0u; mine = (j == x) ? c : mine; }
        if (sum == G) break;
        __builtin_amdgcn_s_sleep(1);
        if ((++sp & 255u) == 0u) { if (xb_ld(&bar[XB_TMO])) break; if (sp > XB_SPIN_CAP) { atomicAdd(&bar[XB_TMO], 1u); break; } }
    }
    nloc = mine > 0u ? mine : 1u; nx = cnt > 0u ? cnt : 1u;
}
__device__ __forceinline__ void xcd_barrier(const XcdBarrier& b, bool leader) {
    asm volatile("s_waitcnt vmcnt(0)" ::: "memory");
    __syncthreads();
    if (leader) {
        unsigned* bar = b.bar;
        __builtin_amdgcn_s_waitcnt(0);
        unsigned nloc = b.st[0], nx = b.st[1];
        if (nloc == 0u) { xcd_barrier_complete(bar, b.x, nloc, nx); b.st[0] = nloc; b.st[1] = nx; }
        const unsigned old = xb_add(&bar[XB_XSUB(b.x)], 1u);
        const unsigned gen = old / nloc;
        if (old + 1u == (gen + 1u) * nloc) {
            __builtin_amdgcn_fence(__ATOMIC_RELEASE, "agent");
            asm volatile("s_waitcnt vmcnt(0)" ::: "memory");
            const unsigned og = xb_add(&bar[XB_TOP], 1u);
            const unsigned tg = og / nx;
            if (og + 1u == (tg + 1u) * nx) xb_add(&bar[XB_TOPGEN], 1u);
            else XB_SPIN(xb_ld(&bar[XB_TOPGEN]) == tg, bar);
            __builtin_amdgcn_fence(__ATOMIC_ACQUIRE, "agent");
            xb_add(&bar[XB_XGEN(b.x)], 1u);
            asm volatile("s_waitcnt vmcnt(0)" ::: "memory");
        } else {
            XB_SPIN(xb_ld(&bar[XB_XGEN(b.x)]) == gen, bar);
            __builtin_amdgcn_fence(__ATOMIC_ACQUIRE, "agent");
            asm volatile("s_waitcnt vmcnt(0)" ::: "memory");
        }
    }
    __syncthreads();
}

constexpr unsigned NGRP = 4;
__device__ __forceinline__ void group_sync(unsigned* bar, unsigned long long* c1, unsigned* c2, bool leader) {
    asm volatile("s_waitcnt vmcnt(0)" ::: "memory");
    __syncthreads();
    if (leader) {
        __builtin_amdgcn_s_waitcnt(0);
        const unsigned x = xb_xcc_id();
        (void)__hip_atomic_fetch_add(c1, 1ull | (1ull << (8 + 3 * x)), __ATOMIC_RELAXED, __HIP_MEMORY_SCOPE_AGENT);
        unsigned long long v = 0ull;
        XB_SPIN(((v = __hip_atomic_load(c1, __ATOMIC_RELAXED, __HIP_MEMORY_SCOPE_AGENT)) & 0xffull) < NGRP, bar);
        if (((v >> (8 + 3 * x)) & 7ull) != NGRP) {
            __builtin_amdgcn_fence(__ATOMIC_RELEASE, "agent");
            asm volatile("s_waitcnt vmcnt(0)" ::: "memory");
            (void)xb_add(c2, 1u);
            XB_SPIN(xb_ld(c2) < NGRP, bar);
        }
        __builtin_amdgcn_fence(__ATOMIC_ACQUIRE, "agent");
        asm volatile("s_waitcnt vmcnt(0)" ::: "memory");
    }
    __syncthreads();
}

struct Args { const float* in[22]; float* out; unsigned char* ws; int ph_lo, ph_hi; };
struct Frame {
    LAS unsigned char* lds;
    unsigned char* ws;
    int wave, vcu, G;
    __device__ __forceinline__ int lane() const { return lane_id(); }
    __device__ __forceinline__ int tid() const { return wave * 64 + lane_id(); }
};
__device__ __forceinline__ float wave_sum(float v) {
#pragma unroll
    for (int o = 1; o < 64; o <<= 1) v += __shfl_xor(v, o);
    return v;
}
__device__ __forceinline__ float wave_max(float v) {
#pragma unroll
    for (int o = 1; o < 64; o <<= 1) v = fmaxf(v, __shfl_xor(v, o));
    return v;
}

template <bool F8>
__device__ __forceinline__ void p0_item(const float* W, int N, unsigned char* WT, int ldt, int k0, int n0s, int n0d, const float* gk, float scale, LAS float* scr, int lane) {
    const int n4 = lane & 15, kr = lane >> 4;
    f32x4 wv[16];
#pragma unroll
    for (int i = 0; i < 16; ++i) wv[i] = *(const GAS f32x4*)(W + (size_t)(k0 + 4 * i + kr) * N + n0s + 4 * n4);
#pragma unroll
    for (int i = 0; i < 16; ++i) { const int kk = 4 * i + kr; float g = scale; if (gk) g *= gk[kk];
        LAS float* d = scr + kk * 65 + 4 * n4; d[0] = wv[i].x * g; d[1] = wv[i].y * g; d[2] = wv[i].z * g; d[3] = wv[i].w * g; }
    LDS_WAIT(); asm volatile("" ::: "memory");
    if constexpr (!F8) { const int c = lane & 7;
#pragma unroll
        for (int j = 0; j < 8; ++j) { const int n = (lane >> 3) + 8 * j; const LAS float* sp = scr + (8 * c) * 65 + n;
            v4u o; o.x = pk2(sp[0 * 65], sp[1 * 65]); o.y = pk2(sp[2 * 65], sp[3 * 65]); o.z = pk2(sp[4 * 65], sp[5 * 65]); o.w = pk2(sp[6 * 65], sp[7 * 65]);
            *(GAS v4u*)(WT + (size_t)(n0d + n) * ldt + (k0 + 8 * c) * 2) = o; }
    } else { const int c = lane & 3;
#pragma unroll
        for (int j = 0; j < 4; ++j) { const int n = (lane >> 2) + 16 * j; const LAS float* sp = scr + (16 * c) * 65 + n;
            v4u o; o.x = pg8::pk4_fp8(sp[0 * 65], sp[1 * 65], sp[2 * 65], sp[3 * 65]); o.y = pg8::pk4_fp8(sp[4 * 65], sp[5 * 65], sp[6 * 65], sp[7 * 65]);
            o.z = pg8::pk4_fp8(sp[8 * 65], sp[9 * 65], sp[10 * 65], sp[11 * 65]); o.w = pg8::pk4_fp8(sp[12 * 65], sp[13 * 65], sp[14 * 65], sp[15 * 65]);
            *(GAS v4u*)(WT + (size_t)(n0d + n) * ldt + k0 + 16 * c) = o; }
    }
    LDS_WAIT(); asm volatile("" ::: "memory");
}
constexpr int MOE_IT_GU = (D / 128) * (2 * DE / 32), MOE_IT_DN = (DE / 128) * (D / 32), MOE_ITEMS = NE * (MOE_IT_GU + MOE_IT_DN);
constexpr float W6SCALE = 64.0f;
constexpr size_t WGU6_E = (size_t)(2 * DE / 256) * pg8::B6_TILE, WDN6_E = (size_t)(D / 256) * pg8::B6_TILE;
__device__ __forceinline__ void p0_moe_decode(const Args& a, unsigned char* ws, int it, const float*& src, unsigned char*& dst, int& N) {
    if (it < NE * MOE_IT_GU) { const int e = it / MOE_IT_GU, q = it % MOE_IT_GU, kb = q / (2 * DE / 32), nb = q % (2 * DE / 32);
        const int n0d = 32 * nb, pn = n0d >> 8, hf = (n0d >> 7) & 1, jj = n0d & 127, n0s = hf * DE + 128 * pn + jj;
        N = 2 * DE; src = a.in[17] + (size_t)e * D * 2 * DE + (size_t)(128 * kb) * (2 * DE) + n0s; dst = ws + WS_WGUT + (size_t)e * WGU6_E + (size_t)pn * pg8::B6_TILE + (size_t)kb * pg8::B6_KT + (size_t)(n0d & 255) * 96; }
    else { it -= NE * MOE_IT_GU; const int e = it / MOE_IT_DN, q = it % MOE_IT_DN, kb = q / (D / 32), nb = q % (D / 32);
        N = D; src = a.in[19] + (size_t)e * DE * D + (size_t)(128 * kb) * D + 32 * nb; dst = ws + WS_WDT + (size_t)e * WDN6_E + (size_t)((32 * nb) >> 8) * pg8::B6_TILE + (size_t)kb * pg8::B6_KT + (size_t)((32 * nb) & 255) * 96; }
}
#define P0M_LOAD(wv, src, N) do { const unsigned _vo = (unsigned)(((lane >> 3) * (N) + 4 * (lane & 7)) * 4); _Pragma("unroll") for (int _i = 0; _i < 16; ++_i) \
        wv[_i] = __builtin_nontemporal_load((const GAS f32x4*)((const GAS char*)((src) + (size_t)(8 * _i) * (N)) + _vo)); } while (0)
#define P0M_PROC(wv, dst) do { _Pragma("unroll") for (int _i = 0; _i < 16; ++_i) { LAS float* _d = scr + (8 * _i + (lane >> 3)) * 33 + 4 * (lane & 7); _d[0] = wv[_i].x * WSCALE; _d[1] = wv[_i].y * WSCALE; _d[2] = wv[_i].z * WSCALE; _d[3] = wv[_i].w * WSCALE; } \
        LDS_WAIT(); asm volatile("" ::: "memory"); \
        _Pragma("unroll") for (int _j = 0; _j < 4; ++_j) { const int _n = (lane >> 3) + 8 * _j; const LAS float* _s = scr + (16 * (lane & 7)) * 33 + _n; \
            v4u _o; _o.x = pg8::pk4_fp8(_s[0 * 33], _s[1 * 33], _s[2 * 33], _s[3 * 33]); _o.y = pg8::pk4_fp8(_s[4 * 33], _s[5 * 33], _s[6 * 33], _s[7 * 33]); \
            _o.z = pg8::pk4_fp8(_s[8 * 33], _s[9 * 33], _s[10 * 33], _s[11 * 33]); _o.w = pg8::pk4_fp8(_s[12 * 33], _s[13 * 33], _s[14 * 33], _s[15 * 33]); \
            *(GAS v4u*)((dst) + (size_t)_n * D + 16 * (lane & 7)) = _o; } \
        LDS_WAIT(); asm volatile("" ::: "memory"); } while (0)
#define P0M_PROC6(wv, dst) do { _Pragma("unroll") for (int _i = 0; _i < 16; ++_i) { LAS float* _d = scr + (8 * _i + (lane >> 3)) * 33 + 4 * (lane & 7); _d[0] = wv[_i].x * W6SCALE; _d[1] = wv[_i].y * W6SCALE; _d[2] = wv[_i].z * W6SCALE; _d[3] = wv[_i].w * W6SCALE; } \
        LDS_WAIT(); asm volatile("" ::: "memory"); \
        _Pragma("unroll 1") for (int _j = 0; _j < 2; ++_j) { const int _g = (lane >> 2) + 16 * _j, _q = lane & 3; const LAS float* _s = scr + (32 * _q) * 33 + _g; pg8::f32x16_t _s0, _s1; \
            if (ilv) { _Pragma("unroll") for (int _e = 0; _e < 16; ++_e) { _s0[_e] = _s[(2 * _e) * 33]; _s1[_e] = _s[(2 * _e + 1) * 33]; } } \
            else { _Pragma("unroll") for (int _e = 0; _e < 16; ++_e) { _s0[_e] = _s[_e * 33]; _s1[_e] = _s[(16 + _e) * 33]; } } \
            const pg8::u32x6 _p = pg8::pk32_fp6(_s0, _s1); const int _r = 16 * ((_g >> 2) & 1) + 4 * (_g >> 3) + (_g & 3); unsigned char* _o = (dst) + (size_t)(_r * 96 + 24 * ((_q + 2 * (_r >> 3)) & 3)); \
            *(GAS v2u*)_o = (v2u){_p[0], _p[1]}; *(GAS v2u*)(_o + 8) = (v2u){_p[2], _p[3]}; *(GAS v2u*)(_o + 16) = (v2u){_p[4], _p[5]}; } \
        LDS_WAIT(); asm volatile("" ::: "memory"); } while (0)
__device__ __forceinline__ void p0_moe_stream(Frame& F, const Args& a, int lo, int hi, int gw, int NGW) {
    LAS float* scr = (LAS float*)(F.lds + F.wave * 16896); const int lane = F.lane(); unsigned char* ws = F.ws;
    f32x4 wA[16], wB[16]; const float* sA; const float* sB; unsigned char* dA; unsigned char* dB; int nA, nB;
    bool ilv; { pg8::f32x16_t t0 = {}, t1 = {}; float one = 1.0f, two = 2.0f; asm volatile("" : "+v"(one), "+v"(two)); t0[0] = one; t1[0] = two; const pg8::u32x6 tp = pg8::pk32_fp6(t0, t1);
                ilv = (((tp[0] >> 6) & 63u) == 16u) || (((tp[3] >> 0) & 63u) != 16u); }
    int it = lo + gw;
    if (it < hi) { p0_moe_decode(a, ws, it, sA, dA, nA); P0M_LOAD(wA, sA, nA); }
    for (; it < hi; it += 2 * NGW) {
        const int it2 = it + NGW, it3 = it + 2 * NGW;
        if (it2 < hi) { p0_moe_decode(a, ws, it2, sB, dB, nB); P0M_LOAD(wB, sB, nB); }
        P0M_PROC6(wA, dA);
        if (it3 < hi) { p0_moe_decode(a, ws, it3, sA, dA, nA); P0M_LOAD(wA, sA, nA); }
        if (it2 < hi) P0M_PROC6(wB, dB);
    }
}
__device__ __forceinline__ void rms_row_to_bf16(const float* xrow, const float* gain, bf16* orow, int lane) {
    const GAS f32x4* xr = (const GAS f32x4*)xrow + lane; const GAS f32x4* gr = (const GAS f32x4*)gain + lane;
    f32x4 v[4]; float s = 0.f;
#pragma unroll
    for (int j = 0; j < 4; ++j) { v[j] = xr[64 * j]; s += (v[j].x * v[j].x + v[j].y * v[j].y) + (v[j].z * v[j].z + v[j].w * v[j].w); }
    const float rs = 1.0f / sqrtf(wave_sum(s) * (1.f / D) + EPS);
    GAS unsigned long long* o8 = (GAS unsigned long long*)orow + lane;
#pragma unroll
    for (int j = 0; j < 4; ++j) { const f32x4 g = gr[64 * j]; o8[64 * j] = (unsigned long long)pk2(v[j].x * rs * g.x, v[j].y * rs * g.y) | ((unsigned long long)pk2(v[j].z * rs * g.z, v[j].w * rs * g.w) << 32); }
}
__device__ __forceinline__ void p0_prologue(Frame& F, const Args& a) {
    LAS float* scr = (LAS float*)(F.lds + F.wave * 16896);
    const int gw = F.vcu * NWAVES + F.wave, NGW = F.G * NWAVES;
    unsigned char* ws = F.ws;
    constexpr int I_WIN = (D / 64) * (NZ / 64);
    constexpr int I_SQ = (D / 64) * (D / 64);
    constexpr int NITEMS = I_WIN + 4 * I_SQ + 4 * D;
    for (int it = gw; it < NITEMS; it += NGW) {
        int r = it;
        if (r < I_WIN) { const int nb = r % (NZ / 64), kb = r / (NZ / 64); p0_item<false>(a.in[3], NZ, ws + WS_WINT, D * 2, 64 * kb, 64 * nb, 64 * nb, nullptr, 1.0f, scr, F.lane()); continue; } r -= I_WIN;
        if (r < 2 * I_SQ) { const int w = r / I_SQ, q = r % I_SQ, nb = q % (D / 64), kb = q / (D / 64), k0 = 64 * kb;
            if (w == 0) p0_item<false>(a.in[7], D, ws + WS_WOUTT, D * 2, k0, 64 * nb, 64 * nb, (k0 < CW) ? a.in[5] + k0 : a.in[6] + (k0 - CW), 1.0f, scr, F.lane());
            else p0_item<false>(a.in[13], D, ws + WS_WOT16, D * 2, k0, 64 * nb, 64 * nb, nullptr, 1.0f, scr, F.lane());
            continue; } r -= 2 * I_SQ;
        if (r < 2 * I_SQ) { const int w = r / I_SQ, q = r % I_SQ, nb = q % (D / 64), kb = q / (D / 64), k0 = 64 * kb;
            p0_item<true>(w == 0 ? a.in[11] : a.in[12], D, ws + (w == 0 ? WS_WKT : WS_WVT), D, k0, 64 * nb, 64 * nb, nullptr, WSCALE, scr, F.lane()); continue; } r -= 2 * I_SQ;
        { const int k = r >> 2, c0 = (r & 3) * 256 + 4 * F.lane(); const float g = a.in[8][k];
            const f32x4 v = *(const GAS f32x4*)(a.in[10] + (size_t)k * D + c0); v2u o; o.x = pk2(v.x * g, v.y * g); o.y = pk2(v.z * g, v.w * g);
            *(GAS v2u*)((bf16*)(ws + WS_WQN) + (size_t)k * D + c0) = o; }
    }
    for (int m = 2 * gw; m < M; m += 2 * NGW) {
        const GAS f32x4* x0 = (const GAS f32x4*)(a.in[0] + (size_t)m * D) + F.lane(); const GAS f32x4* x1 = x0 + D / 4; const GAS f32x4* gr = (const GAS f32x4*)a.in[2] + F.lane();
        f32x4 v0[4], v1[4]; float s0 = 0.f, s1 = 0.f;
#pragma unroll
        for (int j = 0; j < 4; ++j) { v0[j] = x0[64 * j]; v1[j] = x1[64 * j]; }
#pragma unroll
        for (int j = 0; j < 4; ++j) { s0 += (v0[j].x * v0[j].x + v0[j].y * v0[j].y) + (v0[j].z * v0[j].z + v0[j].w * v0[j].w); s1 += (v1[j].x * v1[j].x + v1[j].y * v1[j].y) + (v1[j].z * v1[j].z + v1[j].w * v1[j].w); }
        const float r0 = 1.0f / sqrtf(wave_sum(s0) * (1.f / D) + EPS), r1 = 1.0f / sqrtf(wave_sum(s1) * (1.f / D) + EPS);
        GAS unsigned long long* o0 = (GAS unsigned long long*)((bf16*)(ws + WS_XN) + (size_t)m * D) + F.lane(); GAS unsigned long long* o1 = o0 + D / 4;
#pragma unroll
        for (int j = 0; j < 4; ++j) { const f32x4 g = gr[64 * j];
            o0[64 * j] = (unsigned long long)pk2(v0[j].x * r0 * g.x, v0[j].y * r0 * g.y) | ((unsigned long long)pk2(v0[j].z * r0 * g.z, v0[j].w * r0 * g.w) << 32);
            o1[64 * j] = (unsigned long long)pk2(v1[j].x * r1 * g.x, v1[j].y * r1 * g.y) | ((unsigned long long)pk2(v1[j].z * r1 * g.z, v1[j].w * r1 * g.w) << 32); }
    }
    for (int m = gw; m < MKV; m += NGW) {
        const GAS f32x4* xr = (const GAS f32x4*)(a.in[1] + (size_t)m * D) + F.lane(); const GAS f32x4* gr = (const GAS f32x4*)a.in[9] + F.lane();
        f32x4 v[4]; float ss = 0.f;
#pragma unroll
        for (int j = 0; j < 4; ++j) { v[j] = xr[64 * j]; ss += (v[j].x * v[j].x + v[j].y * v[j].y) + (v[j].z * v[j].z + v[j].w * v[j].w); }
        const float rs = 1.0f / sqrtf(wave_sum(ss) * (1.f / D) + EPS);
        GAS unsigned* o4 = (GAS unsigned*)(ws + WS_MEMN + (size_t)m * D) + F.lane();
#pragma unroll
        for (int j = 0; j < 4; ++j) { const f32x4 g = gr[64 * j]; o4[64 * j] = pg8::pk4_fp8(v[j].x * rs * g.x, v[j].y * rs * g.y, v[j].z * rs * g.z, v[j].w * rs * g.w); }
    }
    const int gt = F.vcu * NTHR + F.tid(), NGT = F.G * NTHR;
    float* wrg = (float*)(ws + WS_WRG);
    for (int i = gt; i < D * NE; i += NGT) { const int e = i >> 10, k = i & 1023; wrg[i] = a.in[15][k * NE + e] * a.in[14][k]; }
    bf16* wa = (bf16*)(ws + WS_TAB + TAB_WA); bf16* mc = (bf16*)(ws + WS_MC); bf16* dch = (bf16*)(ws + WS_TAB + TAB_DCH);
    for (int i = gt; i < 256 * 128; i += NGT) { const int m = i >> 7, k = i & 127; float sn, cs; sincospif((float)((k * (m & 127)) & 127) * (2.0f / 128.0f), &sn, &cs); wa[i] = (bf16)f2bf(m < 128 ? cs : -sn); }
    for (int i = gt; i < 128 * 128 * 128; i += NGT) { const int s1p = i >> 14, mp = (i >> 7) & 127, k = i & 127, op = mp >> 6, s2q = mp & 63, s2 = k >> 1, part = k & 1;
        const int sp = s1p + 128 * s2q, r = (s2 * sp) & 8191; float sn, cs; sincospif((float)r * (2.0f / 8192.0f), &sn, &cs);
        mc[i] = (bf16)f2bf(op == 0 ? (part == 0 ? cs : sn) : (part == 0 ? -sn : cs)); }
    for (int i = gt; i < 8192; i += NGT) { const int p = i >> 12, hc = (i >> 11) & 1, cp = (i >> 5) & 63, q = (i >> 3) & 3, j = i & 7, c = 32 * hc + (j < 4 ? 4 * q + j : 16 + 4 * q + (j - 4));
        float sn, cs; sincospif((float)((c * cp) & 63) * (2.0f / 64.0f), &sn, &cs); dch[i] = (bf16)f2bf(p == 0 ? cs : sn); }
}

typedef short s16x4 __attribute__((ext_vector_type(4)));
typedef short bf16x8v __attribute__((ext_vector_type(8)));
__device__ __forceinline__ bf16x8v tr_pair(LAS unsigned char* p0, int delta) {
    const s16x4 lo = __builtin_amdgcn_ds_read_tr16_b64_v4i16((LAS s16x4*)p0); const s16x4 hi = __builtin_amdgcn_ds_read_tr16_b64_v4i16((LAS s16x4*)(p0 + delta));
    return __builtin_shufflevector(lo, hi, 0, 1, 2, 3, 4, 5, 6, 7);
}
constexpr int FA_P = 544;
constexpr int FC_P = 1056;
__device__ __forceinline__ void fftA_phase(Frame& F) {
    const bf16* Z = (const bf16*)(F.ws + WS_Z); bf16* G = (bf16*)(F.ws + WS_G); const bf16* WA = (const bf16*)(F.ws + WS_TAB + TAB_WA);
    const int tid = F.tid(), lane = F.lane(), w = F.wave, nb = w & 3, mh = w >> 2, g = lane >> 4, q = (lane & 15) >> 2, p = lane & 3;
    for (int unit = F.vcu; unit < BATCH * FN2 * 2; unit += F.G) {
        const int b = unit >> 7, s2 = (unit >> 1) & 63, ch = unit & 1;
        __syncthreads();
#pragma unroll
        for (int i = 0; i < 8; ++i) { const int row = 16 * i + (tid >> 5), piece = tid & 31;
            const v4u v = *(const GAS v4u*)(Z + ((size_t)b * SEQ + 64 * row + s2) * NZ + 1536 + 256 * ch + 8 * piece);
            *(LAS v4u*)(F.lds + row * FA_P + piece * 16) = v; }
        __syncthreads();
        bf16x8v af[4][4];
#pragma unroll
        for (int nt = 0; nt < 4; ++nt)
#pragma unroll
            for (int ks = 0; ks < 4; ++ks) af[nt][ks] = tr_pair(F.lds + (32 * ks + 8 * g + q) * FA_P + (64 * nb + 16 * nt) * 2 + 8 * p, 4 * FA_P);
#pragma unroll
        for (int mt = 0; mt < 8; ++mt) {
            const int m0 = 128 * mh + 16 * mt;
            bf16x8v bfr[4];
#pragma unroll
            for (int ks = 0; ks < 4; ++ks) bfr[ks] = *(const GAS bf16x8v*)(WA + (size_t)(m0 + (lane & 15)) * 128 + 32 * ks + 8 * (lane >> 4));
            const int s1p = 16 * mt + (lane & 15);
            bf16* gp = G + ((((size_t)b * FN1 + s1p) * FN2 + s2) * 2 + mh) * CW + 256 * ch + 64 * nb + 4 * (lane >> 4);
#pragma unroll
            for (int nt = 0; nt < 4; ++nt) { f32x4 acc = {0.f, 0.f, 0.f, 0.f};
#pragma unroll
                for (int ks = 0; ks < 4; ++ks) acc = __builtin_amdgcn_mfma_f32_16x16x32_bf16(af[nt][ks], bfr[ks], acc, 0, 0, 0);
                v2u o; o.x = pk2(acc[0], acc[1]); o.y = pk2(acc[2], acc[3]);
                *(GAS v2u*)(gp + 16 * nt) = o; }
        }
    }
}
__device__ __forceinline__ void conv_phase(Frame& F, const Args& a, int wgi, int nwg) {
    const bf16* Z = (const bf16*)(F.ws + WS_Z); bf16* Y = (bf16*)(F.ws + WS_Y);
    const int gw = wgi * NWAVES + F.wave, NGW = nwg * NWAVES, lane = F.lane();
    const float* cw = a.in[4];
    float w0[8], w1[8], w2[8];
#pragma unroll
    for (int j = 0; j < 8; ++j) { w0[j] = cw[8 * lane + j]; w1[j] = cw[CW + 8 * lane + j]; w2[j] = cw[2 * CW + 8 * lane + j]; }
    constexpr int CH = 8;
    for (int c = gw; c < M / CH; c += NGW) {
        const int t0 = c * CH, s0 = t0 & (SEQ - 1);
        v4u zc[CH + 2], zv[CH + 2], zb[CH];
#pragma unroll
        for (int i = 0; i < CH + 2; ++i) { const int t = t0 - 1 + i; const bool valid = (i == 0) ? (s0 > 0) : ((i == CH + 1) ? (s0 + CH < SEQ) : true);
            if (valid) { zc[i] = *(const GAS v4u*)(Z + (size_t)t * NZ + CW + 8 * lane); zv[i] = *(const GAS v4u*)(Z + (size_t)t * NZ + 2 * CW + 8 * lane); }
            else { zc[i] = (v4u){0u, 0u, 0u, 0u}; zv[i] = (v4u){0u, 0u, 0u, 0u}; } }
#pragma unroll
        for (int i = 0; i < CH; ++i) zb[i] = *(const GAS v4u*)(Z + (size_t)(t0 + i) * NZ + 8 * lane);
        float prev[8], cur[8], nxt[8];
#define CV_OF(dst, cc, vv) do { dst[0] = bflo(cc.x) * bflo(vv.x); dst[1] = bfhi(cc.x) * bfhi(vv.x); dst[2] = bflo(cc.y) * bflo(vv.y); dst[3] = bfhi(cc.y) * bfhi(vv.y); \
            dst[4] = bflo(cc.z) * bflo(vv.z); dst[5] = bfhi(cc.z) * bfhi(vv.z); dst[6] = bflo(cc.w) * bflo(vv.w); dst[7] = bfhi(cc.w) * bfhi(vv.w); } while (0)
        CV_OF(prev, zc[0], zv[0]);
        CV_OF(cur, zc[1], zv[1]);
#pragma unroll
        for (int i = 0; i < CH; ++i) {
            const int t = t0 + i;
            CV_OF(nxt, zc[i + 2], zv[i + 2]);
            const v4u bb = zb[i];
            float bg[8] = {bflo(bb.x), bfhi(bb.x), bflo(bb.y), bfhi(bb.y), bflo(bb.z), bfhi(bb.z), bflo(bb.w), bfhi(bb.w)};
            float y[8]; float ss = 0.f;
#pragma unroll
            for (int j = 0; j < 8; ++j) { y[j] = bg[j] * (w0[j] * prev[j] + w1[j] * cur[j] + w2[j] * nxt[j]); ss += y[j] * y[j]; }
            const float rs = 1.0f / sqrtf(wave_sum(ss) * (1.f / CW) + EPS);
            v4u o; o.x = pk2(y[0] * rs, y[1] * rs); o.y = pk2(y[2] * rs, y[3] * rs); o.z = pk2(y[4] * rs, y[5] * rs); o.w = pk2(y[6] * rs, y[7] * rs);
            *(GAS v4u*)(Y + (size_t)t * D + 8 * lane) = o;
#pragma unroll
            for (int j = 0; j < 8; ++j) { prev[j] = cur[j]; cur[j] = nxt[j]; }
        }
#undef CV_OF
    }
}
__device__ __forceinline__ void absorb_phase(Frame& F) {
    const bf16* KB = (const bf16*)(F.ws + WS_KB); const bf16* VB = (const bf16*)(F.ws + WS_VT); const bf16* WQN = (const bf16*)(F.ws + WS_WQN); const bf16* WOT = (const bf16*)(F.ws + WS_WOT16);
    const int lane = F.lane(), w = F.wave, li = lane & 15, q = lane >> 4;
    for (int unit = F.vcu; unit < 256; unit += F.G) {
        const int type = unit >> 7, bh = (unit >> 4) & 7, slab = unit & 15, b = bh >> 2, h = bh & 3;
        const bf16* Xp; const bf16* Yp; unsigned char* outp; int itf, jtf, dit, djt;
        if (type == 0) { Xp = WQN + (size_t)(64 * slab) * D + h * HD; Yp = KB + (size_t)(b * MEMLEN) * D + h * HD;
            outp = F.ws + WS_MK + (size_t)b * MiB + (size_t)(h * HD) * D + 64 * slab; itf = w & 3; dit = 0; jtf = (w >> 2) * 8; djt = 1; }
        else { Xp = VB + (size_t)(b * MEMLEN) * D + h * HD; Yp = WOT + (size_t)(64 * slab) * D + h * HD;
            outp = F.ws + WS_MV + (size_t)b * MiB + (size_t)(64 * slab) * D + h * HD; jtf = w & 3; djt = 0; itf = (w >> 2) * 8; dit = 1; }
#pragma unroll 2
        for (int t = 0; t < 8; ++t) { const int it = itf + dit * t, jt = jtf + djt * t;
            const bf16* xr = Xp + (size_t)(it * 16 + li) * D + 8 * q; const bf16* yr = Yp + (size_t)(jt * 16 + li) * D + 8 * q;
            bf16x8v xf[8], yf[8];
#pragma unroll
            for (int ks = 0; ks < 8; ++ks) { xf[ks] = *(const GAS bf16x8v*)(xr + 32 * ks); yf[ks] = *(const GAS bf16x8v*)(yr + 32 * ks); }
            f32x4 acc = {0.f, 0.f, 0.f, 0.f};
#pragma unroll
            for (int ks = 0; ks < 8; ++ks) acc = __builtin_amdgcn_mfma_f32_16x16x32_bf16(xf[ks], yf[ks], acc, 0, 0, 0);
            *(GAS unsigned*)(outp + (size_t)(jt * 16 + li) * D + it * 16 + 4 * q) = pg8::pk4_fp8(acc[0] * WSCALE, acc[1] * WSCALE, acc[2] * WSCALE, acc[3] * WSCALE); }
    }
}
__device__ __forceinline__ void fftC_phase(Frame& F) {
    const bf16* G = (const bf16*)(F.ws + WS_G); bf16* Y = (bf16*)(F.ws + WS_Y); const bf16* MC = (const bf16*)(F.ws + WS_MC); const bf16* DCH = (const bf16*)(F.ws + WS_TAB + TAB_DCH);
    const int tid = F.tid(), lane = F.lane(), w = F.wave, tt = w & 3, ch = w >> 2, g = lane >> 4, q = (lane & 15) >> 2, p = lane & 3;
    const float scale = 1.0f / sqrtf((float)SEQ * 64.0f);
    LAS float* ex = (LAS float*)(F.lds + 128 * FC_P);
    for (int unit = F.vcu; unit < BATCH * FN1; unit += F.G) {
        const int b = unit >> 7, s1p = unit & 127;
        __syncthreads();
        const bf16* Gt = G + (size_t)(b * FN1 + s1p) * (FN2 * 2) * CW;
#pragma unroll
        for (int i = 0; i < 16; ++i) { const int idx = i * NTHR + tid, row = idx >> 6, piece = idx & 63;
            const v4u v = *(const GAS v4u*)(Gt + (size_t)row * CW + 8 * piece);
            *(LAS v4u*)(F.lds + row * FC_P + piece * 16) = v; }
        __syncthreads();
        bf16x8v Bre[4], Bim[4];
#pragma unroll
        for (int ks = 0; ks < 4; ++ks) { const bf16* mp = MC + ((size_t)s1p * 128 + 16 * tt + (lane & 15)) * 128 + 32 * ks + 8 * (lane >> 4);
            Bre[ks] = *(const GAS bf16x8v*)mp; Bim[ks] = *(const GAS bf16x8v*)(mp + 64 * 128); }
        bf16x8v dfr[4][2][2];
#pragma unroll
        for (int ct = 0; ct < 4; ++ct)
#pragma unroll
            for (int pp = 0; pp < 2; ++pp)
#pragma unroll
                for (int hc = 0; hc < 2; ++hc) dfr[ct][pp][hc] = *(const GAS bf16x8v*)(DCH + ((((pp * 2 + hc) * 64 + 16 * ct + (lane & 15)) * 4 + (lane >> 4)) * 8));
        v2u y[4][4]; float ssq = 0.f;
#pragma unroll
        for (int g4 = 0; g4 < 4; ++g4) {
            f32x4 are[4], aim[4];
#pragma unroll
            for (int nt = 0; nt < 4; ++nt) { are[nt] = (f32x4){0.f, 0.f, 0.f, 0.f}; aim[nt] = (f32x4){0.f, 0.f, 0.f, 0.f};
#pragma unroll
                for (int ks = 0; ks < 4; ++ks) { const bf16x8v af = tr_pair(F.lds + (32 * ks + 8 * g + q) * FC_P + (256 * ch + 64 * g4 + 16 * nt) * 2 + 8 * p, 4 * FC_P);
                    are[nt] = __builtin_amdgcn_mfma_f32_16x16x32_bf16(af, Bre[ks], are[nt], 0, 0, 0);
                    aim[nt] = __builtin_amdgcn_mfma_f32_16x16x32_bf16(af, Bim[ks], aim[nt], 0, 0, 0); } }
            bf16x8v xf[2][2];
#pragma unroll
            for (int hc = 0; hc < 2; ++hc) {
                { v4u t; t.x = pk2(are[2 * hc][0], are[2 * hc][1]); t.y = pk2(are[2 * hc][2], are[2 * hc][3]); t.z = pk2(are[2 * hc + 1][0], are[2 * hc + 1][1]); t.w = pk2(are[2 * hc + 1][2], are[2 * hc + 1][3]); xf[0][hc] = __builtin_bit_cast(bf16x8v, t); }
                { v4u t; t.x = pk2(aim[2 * hc][0], aim[2 * hc][1]); t.y = pk2(aim[2 * hc][2], aim[2 * hc][3]); t.z = pk2(aim[2 * hc + 1][0], aim[2 * hc + 1][1]); t.w = pk2(aim[2 * hc + 1][2], aim[2 * hc + 1][3]); xf[1][hc] = __builtin_bit_cast(bf16x8v, t); }
            }
#pragma unroll
            for (int ct = 0; ct < 4; ++ct) { f32x4 ya = {0.f, 0.f, 0.f, 0.f};
#pragma unroll
                for (int pp = 0; pp < 2; ++pp)
#pragma unroll
                    for (int hc = 0; hc < 2; ++hc) ya = __builtin_amdgcn_mfma_f32_16x16x32_bf16(dfr[ct][pp][hc], xf[pp][hc], ya, 0, 0, 0);
                ya = ya * scale; y[g4][ct].x = pk2(ya[0], ya[1]); y[g4][ct].y = pk2(ya[2], ya[3]); ssq += (ya[0] * ya[0] + ya[1] * ya[1]) + (ya[2] * ya[2] + ya[3] * ya[3]); }
        }
        ssq += __shfl_xor(ssq, 16); ssq += __shfl_xor(ssq, 32);
        if (lane < 16) ex[w * 16 + lane] = ssq;
        __syncthreads();
        const float tot = ex[w * 16 + (lane & 15)] + ex[(w ^ 4) * 16 + (lane & 15)];
        const float rf = 1.0f / sqrtf(tot * (1.f / CW) + EPS);
        const int t = b * SEQ + s1p + 128 * (16 * tt + (lane & 15));
        bf16* yp = Y + (size_t)t * D + CW + 256 * ch + 4 * (lane >> 4);
#pragma unroll
        for (int g4 = 0; g4 < 4; ++g4)
#pragma unroll
            for (int ct = 0; ct < 4; ++ct) { const v2u p = y[g4][ct]; v2u o; o.x = pk2(bflo(p.x) * rf, bfhi(p.x) * rf); o.y = pk2(bflo(p.y) * rf, bfhi(p.y) * rf); *(GAS v2u*)(yp + 64 * g4 + 16 * ct) = o; }
    }
}
typedef float f32x16 __attribute__((ext_vector_type(16)));
constexpr int AT_P = 528;
__device__ __forceinline__ void attn_phase(Frame& F) {
    const bf16* Q = (const bf16*)(F.ws + WS_Q); const bf16* KB = (const bf16*)(F.ws + WS_KB); const bf16* VT = (const bf16*)(F.ws + WS_VT); unsigned char* O = F.ws + WS_O;
    const int tid = F.tid(), lane = F.lane(), w = F.wave, r = lane & 31, h = lane >> 5, pr = (r & ~12) | ((r & 4) << 1) | ((r & 8) >> 1);
    for (int unit = F.vcu; unit < BATCH * NH * (SEQ / 256); unit += F.G) {
        const int bh = unit >> 5, qt = unit & 31, b = bh >> 2, hh = bh & 3;
        const int t0 = b * SEQ + qt * 256 + 32 * w;
        bf16x8v qf[16];
#pragma unroll
        for (int ds = 0; ds < 16; ++ds) qf[ds] = *(const GAS bf16x8v*)(Q + (size_t)(t0 + r) * D + hh * HD + 16 * ds + 8 * h);
        __syncthreads();
#pragma unroll
        for (int i = 0; i < 16; ++i) { const int idx = i * NTHR + tid, row = idx >> 5, piece = idx & 31;
            const v4u v = *(const GAS v4u*)(KB + (size_t)(b * MEMLEN + row) * D + hh * HD + 8 * piece);
            *(LAS v4u*)(F.lds + row * AT_P + piece * 16) = v; }
        __syncthreads();
        f32x16 sacc[8];
#pragma unroll
        for (int kt = 0; kt < 8; ++kt) {
#pragma unroll
            for (int i = 0; i < 16; ++i) sacc[kt][i] = 0.f;
#pragma unroll
            for (int ds = 0; ds < 16; ++ds) { const bf16x8v kf = *(const LAS bf16x8v*)(F.lds + (32 * kt + pr) * AT_P + (16 * ds + 8 * h) * 2);
                sacc[kt] = __builtin_amdgcn_mfma_f32_32x32x16_bf16(kf, qf[ds], sacc[kt], 0, 0, 0); }
        }
        float mx = -INFINITY;
#pragma unroll
        for (int kt = 0; kt < 8; ++kt)
#pragma unroll
            for (int i = 0; i < 16; ++i) mx = fmaxf(mx, sacc[kt][i]);
        mx = fmaxf(mx, __shfl_xor(mx, 32));
        float sum = 0.f; bf16x8v pf[8][2];
#pragma unroll
        for (int kt = 0; kt < 8; ++kt)
#pragma unroll
            for (int s2 = 0; s2 < 2; ++s2) { float pv[8];
#pragma unroll
                for (int j = 0; j < 8; ++j) { pv[j] = __builtin_amdgcn_exp2f(sacc[kt][8 * s2 + j] - mx); sum += pv[j]; }
                v4u t; t.x = pk2(pv[0], pv[1]); t.y = pk2(pv[2], pv[3]); t.z = pk2(pv[4], pv[5]); t.w = pk2(pv[6], pv[7]); pf[kt][s2] = __builtin_bit_cast(bf16x8v, t); }
        sum += __shfl_xor(sum, 32);
        const float inv = 1.0f / sum;
        __syncthreads();
#pragma unroll
        for (int i = 0; i < 16; ++i) { const int idx = i * NTHR + tid, row = idx >> 5, piece = idx & 31;
            const v4u v = *(const GAS v4u*)(VT + (size_t)(hh * HD + row) * MKV + b * MEMLEN + 8 * piece);
            *(LAS v4u*)(F.lds + row * AT_P + piece * 16) = v; }
        __syncthreads();
        unsigned char* op = O + (size_t)(t0 + r) * D + hh * HD + 4 * h;
#pragma unroll
        for (int dt = 0; dt < 8; ++dt) { f32x16 oacc;
#pragma unroll
            for (int i = 0; i < 16; ++i) oacc[i] = 0.f;
#pragma unroll
            for (int kt = 0; kt < 8; ++kt)
#pragma unroll
                for (int s2 = 0; s2 < 2; ++s2) { const bf16x8v vf = *(const LAS bf16x8v*)(F.lds + (32 * dt + r) * AT_P + (32 * kt + 16 * s2 + 8 * h) * 2);
                    oacc = __builtin_amdgcn_mfma_f32_32x32x16_bf16(vf, pf[kt][s2], oacc, 0, 0, 0); }
#pragma unroll
            for (int i = 0; i < 4; ++i) *(GAS unsigned*)(op + 32 * dt + 8 * i) = pg8::pk4_fp8(oacc[4 * i] * inv, oacc[4 * i + 1] * inv, oacc[4 * i + 2] * inv, oacc[4 * i + 3] * inv);
        }
    }
}
constexpr int RT_P = 2064;
constexpr int RT_LO = 32 * RT_P, RT_PART = 2 * 32 * RT_P, RT_SQP = RT_PART + 8192, RT_RSB = RT_SQP + 256, RT_HIST = RT_RSB + 256, RT_BASE = RT_HIST + 128;
static_assert(RT_BASE + 128 <= MOE_TAB_OFF, "router LDS map");
__device__ __forceinline__ void router_phase(Frame& F, const Args& a, int blk0, unsigned long long* gs1) {
    const bf16* XR = (const bf16*)(F.ws + WS_XR); unsigned char* XN3 = F.ws + WS_XN3; const float* wrgT = (const float*)(F.ws + WS_WRG);
    int* tok_e = (int*)(F.ws + WS_TOK); float* tok_w = (float*)(F.ws + WS_TOK + 256 * 1024); int* tok_rank = (int*)(F.ws + WS_TOK + 512 * 1024);
    int* etok = (int*)(F.ws + WS_ETOK); unsigned* ctl = (unsigned*)(F.ws + WS_CTL);
    const int tid = F.tid(), lane = F.lane(), w = F.wave, tt = w & 3, kh = w >> 2, li = lane & 15, kq = lane >> 4;
    LAS float* part = (LAS float*)(F.lds + RT_PART); LAS float* sqp = (LAS float*)(F.lds + RT_SQP); LAS float* rsb = (LAS float*)(F.lds + RT_RSB);
    LAS unsigned* hist = (LAS unsigned*)(F.lds + RT_HIST); LAS unsigned* base = (LAS unsigned*)(F.lds + RT_BASE);
    const float* gain = a.in[14]; const float* brt = a.in[16];
    __syncthreads();
#pragma unroll
    for (int i = 0; i < 16; ++i) { const int idx = i * NTHR + tid, e = idx >> 8, piece = idx & 255;
        const f32x4 v = *(const GAS f32x4*)(wrgT + (size_t)e * D + 4 * piece);
        v2u hi; hi.x = pk2(v.x, v.y); hi.y = pk2(v.z, v.w);
        v2u lo; lo.x = pk2(v.x - bflo(hi.x), v.y - bfhi(hi.x)); lo.y = pk2(v.z - bflo(hi.y), v.w - bfhi(hi.y));
        *(LAS v2u*)(F.lds + e * RT_P + piece * 8) = hi; *(LAS v2u*)(F.lds + RT_LO + e * RT_P + piece * 8) = lo; }
    if (tid < NE) hist[tid] = 0u;
    if (gs1) group_sync(ctl + CW_BAR, gs1, (unsigned*)gs1 + 2, F.wave == 0 && lane_id() == 0);
    f32x4 gv[4];
#pragma unroll
    for (int j = 0; j < 4; ++j) gv[j] = ((const GAS f32x4*)gain + lane)[64 * j];
    for (int blk = blk0; blk < M / 64; blk += F.G) {
        __syncthreads();
        const int t = blk * 64 + 16 * tt + li;
        f32x4 acc[2]; acc[0] = (f32x4){0.f, 0.f, 0.f, 0.f}; acc[1] = (f32x4){0.f, 0.f, 0.f, 0.f}; float ssq = 0.f;
        const bf16* xp = XR + (size_t)t * D + 512 * kh + 8 * kq;
        bf16x8v xb[16];
#pragma unroll
        for (int ks = 0; ks < 16; ++ks) xb[ks] = *(const GAS bf16x8v*)(xp + 32 * ks);
        v2u xw[8][4];
#pragma unroll
        for (int i = 0; i < 8; ++i) { const GAS v2u* xr = (const GAS v2u*)(XR + (size_t)(blk * 64 + 8 * w + i) * D) + lane;
#pragma unroll
            for (int j = 0; j < 4; ++j) xw[i][j] = xr[64 * j]; }
#pragma unroll
        for (int ks = 0; ks < 16; ++ks) {
            { const v4u u4 = __builtin_bit_cast(v4u, xb[ks]); const float x0 = bflo(u4.x), x1 = bfhi(u4.x), x2 = bflo(u4.y), x3 = bfhi(u4.y), x4 = bflo(u4.z), x5 = bfhi(u4.z), x6 = bflo(u4.w), x7 = bfhi(u4.w);
              ssq += ((x0 * x0 + x1 * x1) + (x2 * x2 + x3 * x3)) + ((x4 * x4 + x5 * x5) + (x6 * x6 + x7 * x7)); }
#pragma unroll
            for (int mt = 0; mt < 2; ++mt) { const int off = (16 * mt + li) * RT_P + (512 * kh + 32 * ks + 8 * kq) * 2;
                const bf16x8v whi = *(const LAS bf16x8v*)(F.lds + off), wlo = *(const LAS bf16x8v*)(F.lds + RT_LO + off);
                acc[mt] = __builtin_amdgcn_mfma_f32_16x16x32_bf16(whi, xb[ks], acc[mt], 0, 0, 0);
                acc[mt] = __builtin_amdgcn_mfma_f32_16x16x32_bf16(wlo, xb[ks], acc[mt], 0, 0, 0); }
        }
        ssq += __shfl_xor(ssq, 16); ssq += __shfl_xor(ssq, 32);
        if (kh == 1) {
#pragma unroll
            for (int mt = 0; mt < 2; ++mt)
#pragma unroll
                for (int rg = 0; rg < 4; ++rg) part[(tt * 32 + 16 * mt + 4 * kq + rg) * 16 + li] = acc[mt][rg];
            if (lane < 16) sqp[tt * 16 + lane] = ssq;
        }
        __syncthreads();
        int my_e = 0; float my_w = 0.f; unsigned my_lr = 0u;
        if (kh == 0) {
            const float rs = 1.0f / sqrtf((ssq + sqp[tt * 16 + li]) * (1.f / D) + EPS);
            if (kq == 0) rsb[16 * tt + li] = rs;
            float val[8];
#pragma unroll
            for (int mt = 0; mt < 2; ++mt)
#pragma unroll
                for (int rg = 0; rg < 4; ++rg) { const int e = 16 * mt + 4 * kq + rg; val[4 * mt + rg] = (acc[mt][rg] + part[(tt * 32 + e) * 16 + li]) * rs + brt[e]; }
            float sv[4]; int se[4];
#pragma unroll
            for (int k = 0; k < TOPK; ++k) {
                float bv = val[0]; int be = 4 * kq;
#pragma unroll
                for (int i = 1; i < 8; ++i) { const int e = 16 * (i >> 2) + 4 * kq + (i & 3); if (val[i] > bv) { bv = val[i]; be = e; } }
#pragma unroll
                for (int o = 16; o < 64; o <<= 1) { const float ov = __shfl_xor(bv, o); const int oe = __shfl_xor(be, o); if (ov > bv || (ov == bv && oe < be)) { bv = ov; be = oe; } }
                sv[k] = bv; se[k] = be;
#pragma unroll
                for (int i = 0; i < 8; ++i) { const int e = 16 * (i >> 2) + 4 * kq + (i & 3); if (e == be) val[i] = -INFINITY; }
            }
            float wk[4]; float wsum = 0.f;
#pragma unroll
            for (int k = 0; k < TOPK; ++k) { wk[k] = __expf(sv[k] - sv[0]); wsum += wk[k]; }
            my_e = (kq == 0) ? se[0] : (kq == 1) ? se[1] : (kq == 2) ? se[2] : se[3];
            my_w = ((kq == 0) ? wk[0] : (kq == 1) ? wk[1] : (kq == 2) ? wk[2] : wk[3]) / wsum;
            my_lr = __hip_atomic_fetch_add(hist + my_e, 1u, __ATOMIC_RELAXED, __HIP_MEMORY_SCOPE_WORKGROUP);
        }
        __syncthreads();
        unsigned basev = 0u;
        if (tid < NE) { const unsigned c = hist[tid]; basev = c ? __hip_atomic_fetch_add(ctl + CW_CNT + 64 * tid, c, RLX_AGENT) : 0u; hist[tid] = 0u; }
#pragma unroll
        for (int i = 0; i < 8; ++i) { const int tk = blk * 64 + 8 * w + i; const float rs = rsb[8 * w + i]; GAS unsigned* o4 = (GAS unsigned*)(XN3 + (size_t)tk * D) + lane;
#pragma unroll
            for (int j = 0; j < 4; ++j) { const v2u x2 = xw[i][j]; const f32x4 g = gv[j];
                o4[64 * j] = pg8::pk4_fp8(bflo(x2.x) * rs * g.x, bfhi(x2.x) * rs * g.y, bflo(x2.y) * rs * g.z, bfhi(x2.y) * rs * g.w); } }
        if (tid < NE) base[tid] = basev;
        __syncthreads();
        if (kh == 0) { const unsigned rank = base[my_e] + my_lr;
            tok_e[t * 4 + kq] = my_e; tok_w[t * 4 + kq] = my_w; tok_rank[t * 4 + kq] = (int)rank; etok[(size_t)my_e * ECAP + rank] = t; }
    }
}
__device__ __forceinline__ int moe_tables(Frame& F) {
    LAS int* tile_e = (LAS int*)(F.lds + MOE_TAB_OFF); LAS int* tile0 = tile_e + 320; LAS int* cnt = tile0 + 40;
    const unsigned* ctl = (const unsigned*)(F.ws + WS_CTL);
    __syncthreads();
    if (F.tid() < NE) cnt[F.tid()] = (int)__hip_atomic_load(ctl + CW_CNT + 64 * F.tid(), RLX_AGENT);
    __syncthreads();
    if (F.tid() == 0) { int acc = 0; for (int e = 0; e < NE; ++e) { tile0[e] = acc; acc += (cnt[e] + 255) >> 8; } tile0[NE] = acc; }
    __syncthreads();
    const int R = tile0[NE];
    for (int rt = F.tid(); rt < R; rt += NTHR) { int e = 0; for (int q = 0; q < NE; ++q) if (rt >= tile0[q] && rt < tile0[q + 1]) e = q; tile_e[rt] = e; }
    __syncthreads();
    return R;
}
__device__ __forceinline__ void combine_phase(Frame& F, const Args& a) {
    const bf16* XR = (const bf16*)(F.ws + WS_XR); const unsigned char* CTR = F.ws + WS_CTR;
    const int* tok_e = (const int*)(F.ws + WS_TOK); const float* tok_w = (const float*)(F.ws + WS_TOK + 256 * 1024); const int* tok_rank = (const int*)(F.ws + WS_TOK + 512 * 1024);
    LAS int* tile0 = (LAS int*)(F.lds + MOE_TAB_OFF) + 320;
    const int gw = F.vcu * NWAVES + F.wave, NGW = F.G * NWAVES, lane = F.lane();
    const float* gain = a.in[21];
    constexpr int TPW = 8;
    const GAS f32x4* gr = (const GAS f32x4*)gain; const f32x4 gv[4] = {gr[2 * lane], gr[2 * lane + 1], gr[128 + 2 * lane], gr[128 + 2 * lane + 1]};
    for (int tb = gw * TPW; tb < M; tb += NGW * TPW) {
        int myslot = 0; float myw = 0.f;
        if (lane < 4 * TPW) { const int q = (tb + (lane >> 2)) * 4 + (lane & 3); const int e = tok_e[q]; myw = tok_w[q]; myslot = tile0[e] * 256 + tok_rank[q]; }
#pragma unroll 4
        for (int i = 0; i < TPW; ++i) {
            const int t = tb + i;
            const GAS v4u* xr = (const GAS v4u*)(XR + (size_t)t * D);
            v4u xw[2]; v2u cw[4][2]; float wk[4];
            xw[0] = xr[lane]; xw[1] = xr[64 + lane];
#pragma unroll
            for (int k = 0; k < TOPK; ++k) { const int slot = __builtin_amdgcn_readlane(myslot, 4 * i + k); wk[k] = __builtin_bit_cast(float, __builtin_amdgcn_readlane(__builtin_bit_cast(int, myw), 4 * i + k));
                const GAS v2u* cp = (const GAS v2u*)(CTR + (size_t)slot * D); cw[k][0] = cp[lane]; cw[k][1] = cp[64 + lane]; }
            f32x4 v[4]; float s = 0.f;
#pragma unroll
            for (int h = 0; h < 2; ++h) { v[2 * h] = (f32x4){bflo(xw[h].x), bfhi(xw[h].x), bflo(xw[h].y), bfhi(xw[h].y)}; v[2 * h + 1] = (f32x4){bflo(xw[h].z), bfhi(xw[h].z), bflo(xw[h].w), bfhi(xw[h].w)};
#pragma unroll
                for (int k = 0; k < TOPK; ++k) {
#pragma unroll
                    for (int u = 0; u < 2; ++u) { const int cwd = (int)(u ? cw[k][h].y : cw[k][h].x); const f32x2v lo = __builtin_amdgcn_cvt_pk_f32_fp8(cwd, false), hi = __builtin_amdgcn_cvt_pk_f32_fp8(cwd, true);
                        v[2 * h + u].x += wk[k] * lo.x; v[2 * h + u].y += wk[k] * lo.y; v[2 * h + u].z += wk[k] * hi.x; v[2 * h + u].w += wk[k] * hi.y; } }
#pragma unroll
                for (int u = 0; u < 2; ++u) s += (v[2 * h + u].x * v[2 * h + u].x + v[2 * h + u].y * v[2 * h + u].y) + (v[2 * h + u].z * v[2 * h + u].z + v[2 * h + u].w * v[2 * h + u].w); }
            const float rs = 1.0f / sqrtf(wave_sum(s) * (1.f / D) + EPS);
            GAS f32x4* op = (GAS f32x4*)(a.out + (size_t)t * D);
#pragma unroll
            for (int h = 0; h < 2; ++h)
#pragma unroll
                for (int u = 0; u < 2; ++u) { const f32x4 g = gv[2 * h + u], w4 = v[2 * h + u]; op[128 * h + 2 * lane + u] = (f32x4){w4.x * rs * g.x, w4.y * rs * g.y, w4.z * rs * g.z, w4.w * rs * g.w}; }
        }
    }
}

struct MoeSel { int nM, lo, start, stride, limit, xhas, xnM, xlo, xslot; };
__device__ __forceinline__ bool moe_plan(int R, int G, int y, int w, int which, MoeSel& s) {
    if (G != 256 || R <= 256 || R > 288) return false;
    int NI = 0, pre = 0; bool bad = false;
#pragma unroll
    for (int yy = 0; yy < 8; ++yy) { const int l0 = (yy * R) >> 3, nj = (((yy + 1) * R) >> 3) - l0, left = 8 * nj - 256;
        bad = bad || left < 0 || left > 32; NI += 32 - left; pre += (yy < y) ? 32 - left : 0; }
    if (bad || NI < 4 * R - 1024) return false;
    if (which < 0) return true;
    const int l0 = (y * R) >> 3, nj = (((y + 1) * R) >> 3) - l0, left = 8 * nj - 256;
    s.nM = nj; s.lo = l0; s.start = w; s.stride = 32; s.xhas = 0; s.xnM = 0; s.xlo = 0; s.xslot = 0;
    if (which == 0) { s.limit = 8 * nj; return true; }
    s.limit = 128;
    if (w >= left) { int e = pre + (w - left); bool found = false;
#pragma unroll
        for (int yy = 0; yy < 8; ++yy) { const int m0 = (yy * R) >> 3, mj = (((yy + 1) * R) >> 3) - m0, Ex = 4 * mj - 128;
            if (!found) { if (e < Ex) { found = true; s.xhas = 1; s.xnM = mj; s.xlo = m0; s.xslot = 128 + e; } else e -= Ex; } } }
    return true;
}

constexpr int NPHASE = 14;
__global__ void __launch_bounds__(NTHR, 2) mk_fwd(Args args) {
    extern __shared__ __attribute__((aligned(16))) unsigned char lds[];
    Frame F;
    F.lds = (LAS unsigned char*)lds; F.ws = args.ws;
    F.wave = __builtin_amdgcn_readfirstlane((int)threadIdx.x >> 6);
    F.G = gridDim.x; { const int bx = blockIdx.x; F.vcu = (F.G % 8 == 0) ? (bx % 8) * (F.G / 8) + bx / 8 : bx; }
    unsigned char* ws = args.ws;
    for (int u = F.tid(); u < (LDS_BYTES - LDSCTL_OFF) / 4; u += NTHR) ((LAS unsigned*)(F.lds + LDSCTL_OFF))[u] = 0u;
    __syncthreads();
    volatile LAS unsigned* MISC = (volatile LAS unsigned*)(F.lds + MISC_OFF);
    XcdBarrier bar; bar.bar = (unsigned*)(ws + WS_CTL) + CW_BAR; bar.x = 0; bar.st = nullptr;
#if MK_ONE_LAUNCH
    bar = xcd_barrier_post((unsigned*)(ws + WS_CTL) + CW_BAR, MISC + 8, F.wave == 0 && lane_id() == 0);
#define GRID_BAR() xcd_barrier(bar, F.wave == 0 && lane_id() == 0)
#else
#define GRID_BAR() do { } while (0)
#endif
    const int lo = args.ph_lo, hi = args.ph_hi;
#define IN(k) (lo <= (k) && (k) < hi)
#define REP(k) for (int _rep = 0; _rep < (((MK_DUP) >> (k)) & 1) + 1; ++_rep)
#define SEAM(k) do { if (IN(k) && IN((k) + 1)) GRID_BAR(); } while (0)
    int gpm = 0, gpn = 0; const bool lsync = MK_ONE_LAUNCH && (F.G == (M / 256) * (D / 256));
    if (lsync) { pg8::StaticOrder S0; S0.init(M, D, F.G, (int)blockIdx.x); pg8::Unit u0; (void)S0.next(0, u0); gpm = u0.pm; gpn = u0.pn; }
#define GSW(s) ((unsigned long long*)((unsigned*)(ws + WS_CTL) + CW_GRP + 64 * (64 * (s) + gpm)))
#define LSEAM(k, s) do { if (IN(k) && IN((k) + 1)) { if (lsync) group_sync((unsigned*)(ws + WS_CTL) + CW_BAR, GSW(s), (unsigned*)GSW(s) + 2, F.wave == 0 && lane_id() == 0); else GRID_BAR(); } } while (0)
    using pg8::Gemm; using pg8::StaticOrder; using pg8::GroupedOrder; using pg8::gemm_phase; using pg8::bf16_t; using pg8::EpiBf16; using pg8::EpiRowScaleBf16; using pg8::EpiResidIn; using pg8::EpiResidBf; using pg8::EpiSwiGLU; using pg8::EpiBiasF8; using pg8::EpiSoftmaxF8;
    if (IN(0)) REP(0) { p0_prologue(F, args); } SEAM(0);
    if (IN(1)) REP(1) { Gemm g{(const bf16_t*)(ws + WS_XN), (const bf16_t*)(ws + WS_WINT), D, 0}; StaticOrder S; S.init(M, NZ, F.G, (int)blockIdx.x);
        const bool split = (F.G % 16) == 0; const int grp = split ? (((int)blockIdx.x >> 3) & 1) : 0, ng = split ? F.G / 2 : F.G;
        const int gi = split ? (((int)blockIdx.x >> 4) * 8 + ((int)blockIdx.x & 7)) : (int)blockIdx.x, mlo = (split && grp) ? MOE_ITEMS / 2 : 0, mhi = (split && !grp) ? MOE_ITEMS / 2 : MOE_ITEMS;
        if (grp == 0) { p0_moe_stream(F, args, mlo, mhi, gi * NWAVES + F.wave, ng * NWAVES); __syncthreads(); }
        EpiBf16 E{(bf16_t*)(ws + WS_Z), NZ, 1.0f}; gemm_phase<EpiBf16, StaticOrder, true>(F.lds, g, S, E, F.wave);
        if (grp == 1) { __syncthreads(); p0_moe_stream(F, args, mlo, mhi, gi * NWAVES + F.wave, ng * NWAVES); } } SEAM(1);
    if (IN(3)) REP(3) {
        const bool split = F.G >= 64;
        if (!split || blockIdx.x < 16) {
            { Gemm g{(const bf16_t*)(ws + WS_MEMN), (const bf16_t*)(ws + WS_WKT), D / 2, 0}; StaticOrder S; S.init(MKV, D, F.G, (int)blockIdx.x);
              EpiBf16 E{(bf16_t*)(ws + WS_KB), D, 1.0f / WSCALE}; gemm_phase<EpiBf16, StaticOrder, true, true>(F.lds, g, S, E, F.wave); }
            { Gemm g{(const bf16_t*)(ws + WS_MEMN), (const bf16_t*)(ws + WS_WVT), D / 2, 0}; StaticOrder S; S.init(MKV, D, F.G, (int)((blockIdx.x + F.G - 8) % F.G));
              EpiBf16 E{(bf16_t*)(ws + WS_VT), D, 1.0f / WSCALE}; gemm_phase<EpiBf16, StaticOrder, true, true>(F.lds, g, S, E, F.wave); }
        }
        if (!split) conv_phase(F, args, F.vcu, F.G); else if (blockIdx.x >= 16) conv_phase(F, args, (int)blockIdx.x - 16, F.G - 16);
        fftA_phase(F); } SEAM(3);
    if (IN(4)) REP(4) { absorb_phase(F); fftC_phase(F); } SEAM(4);
    if (IN(6)) REP(6) { Gemm g{(const bf16_t*)(ws + WS_Y), (const bf16_t*)(ws + WS_WOUTT), D, 0}; StaticOrder S; S.init(M, D, F.G, (int)blockIdx.x);
        EpiResidIn E{args.in[0], (bf16_t*)(ws + WS_XR), ws + WS_XB, (float*)(ws + WS_CTL) + CW_ROWSQ, D}; gemm_phase<EpiResidIn, StaticOrder, false>(F.lds, g, S, E, F.wave); } LSEAM(6, 0);
    if (IN(7)) REP(7) { Gemm g{(const bf16_t*)(ws + WS_XB), (const bf16_t*)(ws + WS_MK), D / 2, MiB}; StaticOrder S; S.init(M, D, F.G, (int)blockIdx.x, 5);
        EpiSoftmaxF8 E{ws + WS_P, D, (const float*)(ws + WS_CTL) + CW_ROWSQ, 1.0f / D, EPS, QSCALE / WSCALE, (LAS float*)(F.lds + RING_BYTES)}; gemm_phase<EpiSoftmaxF8, StaticOrder, true, true>(F.lds, g, S, E, F.wave); } LSEAM(7, 1);
    if (IN(9)) REP(9) { Gemm g{(const bf16_t*)(ws + WS_P), (const bf16_t*)(ws + WS_MV), D / 2, MiB}; StaticOrder S; S.init(M, D, F.G, (int)blockIdx.x, 5);
        EpiResidBf E{(bf16_t*)(ws + WS_XR), D, 1.0f / (128.0f * WSCALE)}; gemm_phase<EpiResidBf, StaticOrder, false, true>(F.lds, g, S, E, F.wave); } if (!lsync) SEAM(9);
    if (IN(10)) REP(10) { router_phase(F, args, lsync ? 4 * gpm + gpn : F.vcu, (lsync && IN(9)) ? GSW(2) : nullptr); } SEAM(10);
    if (IN(11) || IN(12)) {
        const int R = moe_tables(F);
        LAS int* tile_e = (LAS int*)(F.lds + MOE_TAB_OFF);
        const int cy = (int)blockIdx.x & 7, cw = (int)blockIdx.x >> 3;
        bool df; { MoeSel m0; df = MK_ONE_LAUNCH && IN(11) && IN(12) && moe_plan(R, F.G, cy, cw, -1, m0); }
        unsigned* ctlw = (unsigned*)(ws + WS_CTL);
        if (IN(11)) { MoeSel ms = {0, 0, 0, 0, 0, 0, 0, 0, 0}; if (df) (void)moe_plan(R, F.G, cy, cw, 0, ms);
            GroupedOrder<true> S; S.nM = df ? ms.nM : R; S.nN = 2 * DE / 256; S.nwg = R * S.nN; S.G = F.G; S.c = (int)blockIdx.x; S.own = df ? 1 : 0; S.lo = ms.lo; S.start = ms.start; S.stride = ms.stride; S.limit = ms.limit;
            S.xhas = 0; S.xnM = 0; S.xlo = 0; S.xslot = 0; S.done = df ? ctlw + CW_DONE : nullptr; S.tmo = ctlw + CW_BAR + XB_TMO;
            S.tile_e = tile_e; S.tile0 = tile_e + 320; S.cnt = tile_e + 360; S.etok = (const int*)(ws + WS_ETOK); S.ecap = ECAP;
            { LAS int* rowtok = (LAS int*)(F.lds + RING_BYTES); pg8::Unit u;
              for (int ui = 0; ui < 12 && S.next(ui, u); ++ui) if (F.tid() < 256) { const int idx = (u.pm - S.tile0[u.e]) * 256 + F.tid(); rowtok[ui * 256 + F.tid()] = idx < S.cnt[u.e] ? S.etok[(size_t)u.e * ECAP + idx] : 0; }
              __syncthreads(); S.rowtok = rowtok; }
            Gemm g{(const bf16_t*)(ws + WS_XN3), (const bf16_t*)(ws + WS_WGUT), D / 2, WGU6_E};
            EpiSwiGLU E{ws + WS_ACT, args.in[18], 1.0f / W6SCALE}; gemm_phase<EpiSwiGLU, GroupedOrder<true>, true, 2>(F.lds, g, S, E, F.wave); }
        if (!df) SEAM(11);
        if (IN(12)) { MoeSel ms = {0, 0, 0, 0, 0, 0, 0, 0, 0}; if (df) (void)moe_plan(R, F.G, cy, cw, 1, ms);
            GroupedOrder<false> S; S.nM = df ? ms.nM : R; S.nN = D / 256; S.nwg = R * S.nN; S.G = F.G; S.c = (int)blockIdx.x; S.own = df ? 1 : 0; S.lo = ms.lo; S.start = ms.start; S.stride = ms.stride; S.limit = ms.limit;
            S.xhas = ms.xhas; S.xnM = ms.xnM; S.xlo = ms.xlo; S.xslot = ms.xslot; S.done = df ? ctlw + CW_DONE : nullptr; S.tmo = ctlw + CW_BAR + XB_TMO;
            S.tile_e = tile_e; S.tile0 = tile_e + 320; S.cnt = tile_e + 360; S.etok = nullptr; S.ecap = ECAP; S.rowtok = nullptr;
            Gemm g{(const bf16_t*)(ws + WS_ACT), (const bf16_t*)(ws + WS_WDT), DE / 2, WDN6_E};
            EpiBiasF8 E{ws + WS_CTR, args.in[20], 1.0f / W6SCALE}; gemm_phase<EpiBiasF8, GroupedOrder<false>, true, 2>(F.lds, g, S, E, F.wave); }
        SEAM(12);
    }
    if (IN(13)) REP(13) { (void)moe_tables(F); combine_phase(F, args); }
#undef IN
#undef SEAM
}

extern "C" void kernel_launch(void* const* d_in, const int* in_sizes, int n_in, void* d_out, int out_size, void* d_ws, size_t ws_size, hipStream_t stream) {
    static int grid = 0;
    if (grid == 0) {
        if (n_in != 22 || in_sizes[0] != M * D || out_size != M * D || ws_size < WS_END) { fprintf(stderr, "kernel_launch: unexpected problem (n_in %d, in0 %d, out %d, ws %zu)\n", n_in, n_in > 0 ? in_sizes[0] : -1, out_size, ws_size); grid = -1; return; }
        int dev = 0, cus = 0;
        if (hipGetDevice(&dev) != hipSuccess || hipDeviceGetAttribute(&cus, hipDeviceAttributeMultiprocessorCount, dev) != hipSuccess) { grid = -1; return; }
        if (hipFuncSetAttribute((const void*)mk_fwd, hipFuncAttributeMaxDynamicSharedMemorySize, LDS_BYTES) != hipSuccess) { fprintf(stderr, "kernel_launch: hipFuncSetAttribute failed\n"); grid = -1; return; }
        int per_cu = 0;
        if (hipOccupancyMaxActiveBlocksPerMultiprocessor(&per_cu, (const void*)mk_fwd, NTHR, LDS_BYTES) != hipSuccess || per_cu < 1) fprintf(stderr, "kernel_launch: occupancy query reports %d\n", per_cu);
        (void)hipGetLastError();
        grid = cus;
    }
    if (grid < 0) return;
    if (hipMemsetAsync((char*)d_ws + WS_CTL, 0, CTL_ZERO_BYTES, stream) != hipSuccess) return;
    Args a{};
    for (int i = 0; i < 22; ++i) a.in[i] = (const float*)d_in[i];
    a.out = (float*)d_out; a.ws = (unsigned char*)d_ws;
#if MK_ONE_LAUNCH
    a.ph_lo = 0; a.ph_hi = NPHASE;
    hipLaunchKernelGGL(mk_fwd, dim3(grid), dim3(NTHR), LDS_BYTES, stream, a);
#else
    for (int p = 0; p < NPHASE; ++p) { a.ph_lo = p; a.ph_hi = p + 1; hipLaunchKernelGGL(mk_fwd, dim3(grid), dim3(NTHR), LDS_BYTES, stream, a); }
#endif
}
```

```cpp
#include <hip/hip_runtime.h>
#include <cstdio>
#include <cstdint>

#ifndef MK_ONE_LAUNCH
#define MK_ONE_LAUNCH 1
#endif
#ifndef MK_DUP
#define MK_DUP 0
#endif

__device__ __forceinline__ int lane_id() { return (int)__builtin_amdgcn_mbcnt_hi(~0u, __builtin_amdgcn_mbcnt_lo(~0u, 0u)) & 63; }
namespace pg8 {
#define PG8_LAS __attribute__((address_space(3)))
typedef unsigned short bf16_t;
typedef short bf16x8 __attribute__((ext_vector_type(8)));
typedef float f32x4 __attribute__((ext_vector_type(4)));
typedef unsigned u32x4 __attribute__((ext_vector_type(4)));
typedef unsigned u32x2 __attribute__((ext_vector_type(2)));
constexpr int BM = 256, BK = 64, HALF = 128, HTB = HALF * BK * 2, STAGE_BYTES = 8 * HTB, NXCD = 8, WGM = 8;

__host__ __device__ __forceinline__ int lds_byte(int r, int c) { const int st = (r >> 4) * 2 + (c >> 5), rr = r & 15, cc = c & 31, ob = rr * 64 + cc * 2; return st * 1024 + (ob ^ (((ob >> 9) & 1) << 5)); }
__host__ __device__ __forceinline__ void stage_rc(int b, int& R, int& C) { const int st = b / 1024, sb = b % 1024, swz = sb ^ (((sb >> 9) & 1) << 5); R = (st >> 1) * 16 + swz / 64; C = (st & 1) * 32 + (swz % 64) / 2; }
__host__ __device__ __forceinline__ int perm32(int rho) { const int n = rho >> 4, i = rho & 15; return 8 * (i >> 2) + 4 * n + (i & 3); }

struct Unit { int pm, pn, e; };
struct Gemm { const bf16_t* A; const bf16_t* Bt; int K; size_t bstride; };

struct StaticOrder {
    static constexpr bool GATHER = false;
    int nM, nN, nwg, G, c, eshift;
    __device__ __forceinline__ void init(int M, int N, int G_, int c_, int eshift_ = -1) { nM = M / BM; nN = N / BM; nwg = nM * nN; G = G_; c = c_; eshift = eshift_; }
    __device__ __forceinline__ bool next(int i, Unit& u) const {
        const long L = (long)i * G + c; if (L >= nwg) return false;
        int wgid = (int)L; { const int q = nwg / NXCD, r = nwg % NXCD, xcd = wgid % NXCD, off = wgid / NXCD; wgid = (xcd < r ? xcd * (q + 1) : r * (q + 1) + (xcd - r) * q) + off; }
        const int nig = WGM * nN, gid = wgid / nig, fm = gid * WGM, gsz = (nM - fm) < WGM ? (nM - fm) : WGM;
        u.pm = fm + ((wgid % nig) % gsz); u.pn = (wgid % nig) / gsz; u.e = eshift >= 0 ? (u.pm >> eshift) : 0; return true;
    }
    __device__ __forceinline__ int arow(int, int) const { return 0; }
};
template <bool GATHER_>
struct GroupedOrder {
    static constexpr bool GATHER = GATHER_;
    int nM, nN, nwg, G, c;
    int own, lo, start, stride, limit, xhas, xnM, xlo, xslot;
    unsigned* done; unsigned* tmo;
    const PG8_LAS int* tile_e;
    const PG8_LAS int* tile0;
    const PG8_LAS int* cnt;
    const int* etok;
    int ecap;
    __device__ __forceinline__ bool next(int i, Unit& u) const {
        int wgid, nMl = nM, lol = 0;
        if (own) { const int s = start + i * stride;
            if (s < limit) { wgid = s; lol = lo; }
            else { const int nmain = start < limit ? (limit - start + stride - 1) / stride : 0; if (!xhas || i != nmain) return false; wgid = xslot; nMl = xnM; lol = xlo; } }
        else { const long L = (long)i * G + c; if (L >= nwg) return false;
            wgid = (int)L; { const int q = nwg / NXCD, r = nwg % NXCD, xcd = wgid % NXCD, off = wgid / NXCD; wgid = (xcd < r ? xcd * (q + 1) : r * (q + 1) + (xcd - r) * q) + off; } }
        const int nig = WGM * nN, gid = wgid / nig, fm = gid * WGM, gsz = (nMl - fm) < WGM ? (nMl - fm) : WGM;
        u.pm = lol + fm + ((wgid % nig) % gsz); u.pn = (wgid % nig) / gsz; u.e = tile_e[u.pm];
        if constexpr (!GATHER_) { if (done) { const unsigned* dp = done + 64 * u.pm; unsigned sp = 0;
            while (__hip_atomic_load(dp, __ATOMIC_RELAXED, __HIP_MEMORY_SCOPE_AGENT) < 8u) { __builtin_amdgcn_s_sleep(2); if ((++sp & 255u) == 0u && (__hip_atomic_load(tmo, __ATOMIC_RELAXED, __HIP_MEMORY_SCOPE_AGENT) || sp > (1u << 18))) break; } } }
        return true;
    }
    const PG8_LAS int* rowtok;
    __device__ __forceinline__ int arow(int ui, int r) const { return rowtok[ui * BM + r]; }
};

typedef float f32x2_t __attribute__((ext_vector_type(2)));
typedef float f32x16_t __attribute__((ext_vector_type(16)));
typedef unsigned u32x6 __attribute__((ext_vector_type(6)));
__device__ __forceinline__ u32x6 pk32_fp6(const f32x16_t s0, const f32x16_t s1) { return __builtin_amdgcn_cvt_scalef32_2xpk16_fp6_f32(s0, s1, 1.0f); }
typedef __bf16 bf16x2_t __attribute__((ext_vector_type(2)));
__device__ __forceinline__ unsigned cvt_pk_bf16(float lo, float hi) { const f32x2_t v = {lo, hi}; return __builtin_bit_cast(unsigned, __builtin_convertvector(v, bf16x2_t)); }

__device__ __forceinline__ unsigned pk4_fp8(float a, float b, float c, float d) { int v = __builtin_amdgcn_cvt_pk_fp8_f32(a, b, 0, false); v = __builtin_amdgcn_cvt_pk_fp8_f32(c, d, v, true); return (unsigned)v; }
struct EpiBf16 {
    struct Pre {}; __device__ __forceinline__ Pre pre(const Unit&, int, int, int, int) const { return Pre{}; }
    static constexpr bool PERM = true;
    bf16_t* O; int ldc; float scale;
    __device__ __forceinline__ void operator()(const f32x4 (&acc)[2][2][4][2], const Unit& u, int wr, int wc, int fr, int fq, const Pre& P) const {
        const int row0 = u.pm * BM + wr * 64 + fr, col0 = u.pn * BM + wc * 32 + 8 * fq;
#pragma unroll
        for (int ai = 0; ai < 2; ++ai)
#pragma unroll
            for (int m = 0; m < 4; ++m) { bf16_t* rowp = O + (size_t)(row0 + ai * HALF + m * 16) * ldc + col0;
#pragma unroll
                for (int bj = 0; bj < 2; ++bj) { const f32x4 v0 = acc[ai][bj][m][0] * scale, v1 = acc[ai][bj][m][1] * scale;
                    u32x4 w; w.x = cvt_pk_bf16(v0[0], v0[1]); w.y = cvt_pk_bf16(v0[2], v0[3]); w.z = cvt_pk_bf16(v1[0], v1[1]); w.w = cvt_pk_bf16(v1[2], v1[3]);
                    *(u32x4*)(rowp + bj * HALF) = w; } }
    }
};
struct EpiRowScaleBf16 {
    struct Pre { float rq[2][4]; };
    __device__ __forceinline__ Pre pre(const Unit& u, int wr, int, int fr, int) const { Pre p; const int row0 = u.pm * BM + wr * 64 + fr;
        _Pragma("unroll") for (int ai = 0; ai < 2; ++ai) _Pragma("unroll") for (int m = 0; m < 4; ++m) p.rq[ai][m] = rowsq[row0 + ai * HALF + m * 16]; return p; }
    static constexpr bool PERM = true;
    bf16_t* O; int ldc; const float* rowsq; float inv_n, eps, scale;
    __device__ __forceinline__ void operator()(const f32x4 (&acc)[2][2][4][2], const Unit& u, int wr, int wc, int fr, int fq, const Pre& P) const {
        const int row0 = u.pm * BM + wr * 64 + fr, col0 = u.pn * BM + wc * 32 + 8 * fq;
#pragma unroll
        for (int ai = 0; ai < 2; ++ai)
#pragma unroll
            for (int m = 0; m < 4; ++m) { const int r = row0 + ai * HALF + m * 16; const float s = __builtin_amdgcn_rsqf(P.rq[ai][m] * inv_n + eps) * scale;
                bf16_t* rowp = O + (size_t)r * ldc + col0;
#pragma unroll
                for (int bj = 0; bj < 2; ++bj) { const f32x4 v0 = acc[ai][bj][m][0] * s, v1 = acc[ai][bj][m][1] * s;
                    u32x4 w; w.x = cvt_pk_bf16(v0[0], v0[1]); w.y = cvt_pk_bf16(v0[2], v0[3]); w.z = cvt_pk_bf16(v1[0], v1[1]); w.w = cvt_pk_bf16(v1[2], v1[3]);
                    *(u32x4*)(rowp + bj * HALF) = w; } }
    }
};
struct EpiResidIn {
    struct Pre {}; __device__ __forceinline__ Pre pre(const Unit&, int, int, int, int) const { return Pre{}; }
    static constexpr bool PERM = true;
    const float* base; bf16_t* xo; unsigned char* x8; float* rowsq; int ldc;
    __device__ __forceinline__ void operator()(const f32x4 (&acc)[2][2][4][2], const Unit& u, int wr, int wc, int fr, int fq, const Pre& P) const {
        const int row0 = u.pm * BM + wr * 64 + fr, col0 = u.pn * BM + wc * 32 + 8 * fq;
#pragma unroll
        for (int ai = 0; ai < 2; ++ai) {
            f32x4 b[4][2][2];
#pragma unroll
            for (int m = 0; m < 4; ++m)
#pragma unroll
                for (int bj = 0; bj < 2; ++bj)
#pragma unroll
                    for (int n = 0; n < 2; ++n) b[m][bj][n] = *(const f32x4*)(base + (size_t)(row0 + ai * HALF + m * 16) * ldc + col0 + bj * HALF + 4 * n);
#pragma unroll
            for (int m = 0; m < 4; ++m) { const int r = row0 + ai * HALF + m * 16; const size_t off = (size_t)r * ldc + col0; float ss = 0.f;
#pragma unroll
                for (int bj = 0; bj < 2; ++bj) { const f32x4 v0 = b[m][bj][0] + acc[ai][bj][m][0], v1 = b[m][bj][1] + acc[ai][bj][m][1];
                    u32x4 w; w.x = cvt_pk_bf16(v0[0], v0[1]); w.y = cvt_pk_bf16(v0[2], v0[3]); w.z = cvt_pk_bf16(v1[0], v1[1]); w.w = cvt_pk_bf16(v1[2], v1[3]);
                    *(u32x4*)(xo + off + bj * HALF) = w;
                    u32x2 q; q.x = pk4_fp8(v0[0], v0[1], v0[2], v0[3]); q.y = pk4_fp8(v1[0], v1[1], v1[2], v1[3]); *(u32x2*)(x8 + off + bj * HALF) = q;
                    ss += ((v0[0] * v0[0] + v0[1] * v0[1]) + (v0[2] * v0[2] + v0[3] * v0[3])) + ((v1[0] * v1[0] + v1[1] * v1[1]) + (v1[2] * v1[2] + v1[3] * v1[3])); }
                ss += __shfl_xor(ss, 16); ss += __shfl_xor(ss, 32); if (fq == 0) atomicAdd(rowsq + r, ss); }
            asm volatile("" ::: "memory"); }
    }
};
struct EpiResidBf {
    struct Pre {}; __device__ __forceinline__ Pre pre(const Unit&, int, int, int, int) const { return Pre{}; }
    static constexpr bool PERM = true;
    bf16_t* x; int ldc; float ascale;
    __device__ __forceinline__ void operator()(const f32x4 (&acc)[2][2][4][2], const Unit& u, int wr, int wc, int fr, int fq, const Pre& P) const {
        const int row0 = u.pm * BM + wr * 64 + fr, col0 = u.pn * BM + wc * 32 + 8 * fq;
        u32x4 b[2][4][2];
#pragma unroll
        for (int ai = 0; ai < 2; ++ai)
#pragma unroll
            for (int m = 0; m < 4; ++m)
#pragma unroll
                for (int bj = 0; bj < 2; ++bj) b[ai][m][bj] = *(const u32x4*)(x + (size_t)(row0 + ai * HALF + m * 16) * ldc + col0 + bj * HALF);
#pragma unroll
        for (int ai = 0; ai < 2; ++ai)
#pragma unroll
            for (int m = 0; m < 4; ++m) { const size_t off = (size_t)(row0 + ai * HALF + m * 16) * ldc + col0;
#pragma unroll
                for (int bj = 0; bj < 2; ++bj) { const f32x4 a0 = acc[ai][bj][m][0] * ascale, a1 = acc[ai][bj][m][1] * ascale; const u32x4 p = b[ai][m][bj];
                    u32x4 w; w.x = cvt_pk_bf16(__builtin_bit_cast(float, p.x << 16) + a0[0], __builtin_bit_cast(float, p.x & 0xffff0000u) + a0[1]);
                    w.y = cvt_pk_bf16(__builtin_bit_cast(float, p.y << 16) + a0[2], __builtin_bit_cast(float, p.y & 0xffff0000u) + a0[3]);
                    w.z = cvt_pk_bf16(__builtin_bit_cast(float, p.z << 16) + a1[0], __builtin_bit_cast(float, p.z & 0xffff0000u) + a1[1]);
                    w.w = cvt_pk_bf16(__builtin_bit_cast(float, p.w << 16) + a1[2], __builtin_bit_cast(float, p.w & 0xffff0000u) + a1[3]);
                    *(u32x4*)(x + off + bj * HALF) = w; } }
    }
};
struct EpiSoftmaxF8 {
    static constexpr bool PERM = true;
    struct Pre { float rq[2][4]; };
    __device__ __forceinline__ Pre pre(const Unit& u, int wr, int, int fr, int) const { Pre p; const int row0 = u.pm * BM + wr * 64 + fr;
        _Pragma("unroll") for (int ai = 0; ai < 2; ++ai) _Pragma("unroll") for (int m = 0; m < 4; ++m) p.rq[ai][m] = rowsq[row0 + ai * HALF + m * 16]; return p; }
    unsigned char* O; int ldc; const float* rowsq; float inv_n, eps, sscale; PG8_LAS float* xch;
    __device__ __forceinline__ void operator()(f32x4 (&acc)[2][2][4][2], const Unit& u, int wr, int wc, int fr, int fq, const Pre& P) const {
        const int row0 = u.pm * BM + wr * 64 + fr, col0 = u.pn * BM + wc * 32 + 8 * fq, rl0 = wr * 64 + fr;
        float f[2][4];
#pragma unroll
        for (int ai = 0; ai < 2; ++ai)
#pragma unroll
            for (int m = 0; m < 4; ++m) { f[ai][m] = __builtin_amdgcn_rsqf(P.rq[ai][m] * inv_n + eps) * sscale; float mx = -INFINITY;
#pragma unroll
                for (int bj = 0; bj < 2; ++bj)
#pragma unroll
                    for (int n = 0; n < 2; ++n) { const f32x4 v = acc[ai][bj][m][n]; mx = fmaxf(mx, fmaxf(fmaxf(v[0], v[1]), fmaxf(v[2], v[3]))); }
                mx = fmaxf(mx, __shfl_xor(mx, 16)); mx = fmaxf(mx, __shfl_xor(mx, 32));
                if (fq == 0) xch[(rl0 + ai * HALF + m * 16) * 4 + wc] = mx * f[ai][m]; }
        asm volatile("s_waitcnt lgkmcnt(0)" ::: "memory"); __builtin_amdgcn_s_barrier(); asm volatile("" ::: "memory");
#pragma unroll
        for (int ai = 0; ai < 2; ++ai)
#pragma unroll
            for (int m = 0; m < 4; ++m) { const f32x4 x4 = *(const PG8_LAS f32x4*)(xch + (rl0 + ai * HALF + m * 16) * 4); const float M = fmaxf(fmaxf(x4[0], x4[1]), fmaxf(x4[2], x4[3])); float sm = 0.f;
#pragma unroll
                for (int bj = 0; bj < 2; ++bj)
#pragma unroll
                    for (int n = 0; n < 2; ++n) { f32x4 v = acc[ai][bj][m][n];
#pragma unroll
                        for (int i = 0; i < 4; ++i) { v[i] = __builtin_amdgcn_exp2f(v[i] * f[ai][m] - M); sm += v[i]; }
                        acc[ai][bj][m][n] = v; }
                sm += __shfl_xor(sm, 16); sm += __shfl_xor(sm, 32);
                if (fq == 0) xch[1024 + (rl0 + ai * HALF + m * 16) * 4 + wc] = sm; }
        asm volatile("s_waitcnt lgkmcnt(0)" ::: "memory"); __builtin_amdgcn_s_barrier(); asm volatile("" ::: "memory");
#pragma unroll
        for (int ai = 0; ai < 2; ++ai)
#pragma unroll
            for (int m = 0; m < 4; ++m) { const f32x4 s4 = *(const PG8_LAS f32x4*)(xch + 1024 + (rl0 + ai * HALF + m * 16) * 4); const float sc = 128.0f * __builtin_amdgcn_rcpf((s4[0] + s4[1]) + (s4[2] + s4[3]));
                unsigned char* rowp = O + (size_t)(row0 + ai * HALF + m * 16) * ldc + col0;
#pragma unroll
                for (int bj = 0; bj < 2; ++bj) { const f32x4 v0 = acc[ai][bj][m][0] * sc, v1 = acc[ai][bj][m][1] * sc;
                    u32x2 w; w.x = pk4_fp8(v0[0], v0[1], v0[2], v0[3]); w.y = pk4_fp8(v1[0], v1[1], v1[2], v1[3]); *(u32x2*)(rowp + bj * HALF) = w; } }
    }
};
struct EpiSwiGLU {
    struct Pre { f32x4 bgv[2], buv[2]; };
    __device__ __forceinline__ Pre pre(const Unit& u, int, int wc, int, int fq) const { Pre p; const float* bg = bias + (size_t)u.e * 2048 + u.pn * HALF + wc * 32 + 8 * fq;
        _Pragma("unroll") for (int n = 0; n < 2; ++n) { p.bgv[n] = *(const f32x4*)(bg + 4 * n); p.buv[n] = *(const f32x4*)(bg + 1024 + 4 * n); } return p; }
    static constexpr bool PERM = true;
    unsigned char* O; const float* bias; float wscale;
    bool wt;
    __device__ __forceinline__ void operator()(const f32x4 (&acc)[2][2][4][2], const Unit& u, int wr, int wc, int fr, int fq, const Pre& P) const {
        const int row0 = u.pm * BM + wr * 64 + fr, colj = u.pn * HALF + wc * 32 + 8 * fq;
#pragma unroll
        for (int ai = 0; ai < 2; ++ai)
#pragma unroll
            for (int m = 0; m < 4; ++m) { unsigned char* rowp = O + (size_t)(row0 + ai * HALF + m * 16) * 1024 + colj; float o[8];
#pragma unroll
                for (int n = 0; n < 2; ++n) { const f32x4 g4 = acc[ai][0][m][n] * wscale + P.bgv[n], u4 = acc[ai][1][m][n] * wscale + P.buv[n];
#pragma unroll
                    for (int i = 0; i < 4; ++i) { const float g = fminf(g4[i], 7.0f), up = fminf(fmaxf(u4[i], -7.0f), 7.0f);
                        const float sg = __builtin_amdgcn_rcpf(1.0f + __builtin_amdgcn_exp2f(g * (-1.702f * 1.44269504f)));
                        o[4 * n + i] = (up + 1.0f) * (g * sg); } }
                u32x2 w; w.x = pk4_fp8(o[0], o[1], o[2], o[3]); w.y = pk4_fp8(o[4], o[5], o[6], o[7]);
                if (wt) __hip_atomic_store((unsigned long long*)rowp, (unsigned long long)w.x | ((unsigned long long)w.y << 32), __ATOMIC_RELAXED, __HIP_MEMORY_SCOPE_AGENT);
                else *(u32x2*)rowp = w; }
    }
};
struct EpiBiasF8 {
    static constexpr bool PERM = true;
    struct Pre { f32x4 bv[2][2]; };
    __device__ __forceinline__ Pre pre(const Unit& u, int, int wc, int, int fq) const { Pre p; const float* bp = bias + (size_t)u.e * 1024 + u.pn * BM + wc * 32 + 8 * fq;
        _Pragma("unroll") for (int bj = 0; bj < 2; ++bj) _Pragma("unroll") for (int n = 0; n < 2; ++n) p.bv[bj][n] = *(const f32x4*)(bp + bj * HALF + 4 * n); return p; }
    unsigned char* O; const float* bias; float wscale;
    __device__ __forceinline__ void operator()(const f32x4 (&acc)[2][2][4][2], const Unit& u, int wr, int wc, int fr, int fq, const Pre& P) const {
        const int row0 = u.pm * BM + wr * 64 + fr, col0 = u.pn * BM + wc * 32 + 8 * fq;
#pragma unroll
        for (int ai = 0; ai < 2; ++ai)
#pragma unroll
            for (int m = 0; m < 4; ++m) { unsigned char* rowp = O + (size_t)(row0 + ai * HALF + m * 16) * 1024 + col0;
#pragma unroll
                for (int bj = 0; bj < 2; ++bj) { const f32x4 v0 = acc[ai][bj][m][0] * wscale + P.bv[bj][0], v1 = acc[ai][bj][m][1] * wscale + P.bv[bj][1];
                    u32x2 w; w.x = pk4_fp8(v0[0], v0[1], v0[2], v0[3]); w.y = pk4_fp8(v1[0], v1[1], v1[2], v1[3]);
                    *(u32x2*)(rowp + bj * HALF) = w; } }
    }
};

typedef int i32x4 __attribute__((ext_vector_type(4)));
typedef int i32x8 __attribute__((ext_vector_type(8)));
__device__ __forceinline__ i32x8 cat16(bf16x8 a, bf16x8 b) { return __builtin_shufflevector(__builtin_bit_cast(i32x4, a), __builtin_bit_cast(i32x4, b), 0, 1, 2, 3, 4, 5, 6, 7); }
typedef int i32x6 __attribute__((ext_vector_type(6)));
typedef bf16x8 __attribute__((aligned(8))) bf16x8_a8;
__device__ __forceinline__ i32x6 cat6(bf16x8 a, bf16x8 b) { return __builtin_shufflevector(__builtin_bit_cast(i32x4, a), __builtin_bit_cast(i32x4, b), 0, 1, 2, 3, 4, 5); }
constexpr int B6_KT = 256 * 96, B6_TILE = 8 * B6_KT;
template <class Epi, class Sched, bool ALIGN_EPI, int FP8 = 0>
__device__ __forceinline__ void gemm_phase(PG8_LAS unsigned char* lds, const Gemm g, const Sched& S, const Epi& E, int wid) {
    const int lane = lane_id(), tid = wid * 64 + lane, wr = wid >> 2, wc = wid & 3, fr = lane & 15, fq = lane >> 4;
    const int K = g.K, nt = K / BK, kmask = nt - 1, krot = nt >> 3;
#define PG8_KOFF(u) (((u).pm + (u).pn) * krot & kmask)
    unsigned voffA[2], voffB[2]; int RA[2], CA[2];
#pragma unroll
    for (int i = 0; i < 2; ++i) { int R, C; stage_rc(tid * 16 + i * 8192, R, C); const int Rb = Epi::PERM ? ((R & ~31) + perm32(R & 31)) : R;
        RA[i] = R; CA[i] = C; voffA[i] = (unsigned)(R * K + C) * 2u; voffB[i] = (unsigned)(Rb * K + C) * 2u; }
    const size_t kstep = (size_t)(BK * 2);
    const size_t hstep = (size_t)HALF * K * 2;
    const size_t tstep = 2 * hstep;
    const unsigned ldsw = (unsigned)wid * 1024u;
    const int aoff = lds_byte(wr * 64 + fr, fq * 8), boff = (FP8 == 2) ? (wc * 32 + fr) * 96 + ((fq + 2 * (fr >> 3)) & 3) * 24 : lds_byte(wc * 32 + fr, fq * 8);
    const unsigned voffB6 = (unsigned)tid * 16u;
#define PG8_SA(b, h) (((b) * 2 + (h)) * HTB)
#define PG8_SB(b, h) ((4 + (b) * 2 + (h)) * HTB)
#define PG8_STAGEB6(b, gbase) do { _Pragma("unroll") for (int _i = 0; _i < 3; ++_i) \
        __builtin_amdgcn_global_load_lds((const unsigned*)((const char*)(gbase) + voffB6 + _i * 8192), (PG8_LAS unsigned*)(lds + PG8_SB(b, 0) + ldsw + _i * 8192), 16, 0, 0); } while (0)
#define PG8_STB(b, pb, p6) do { if constexpr (FP8 == 2) { PG8_STAGEB6(b, p6); } else { PG8_STAGE(PG8_SB(b, 0), pb, voffB); PG8_STAGE(PG8_SB(b, 1), (pb) + hstep, voffB); } } while (0)
#define PG8_STAGE(bufoff, gbase, voff) do { _Pragma("unroll") for (int _i = 0; _i < 2; ++_i) \
        __builtin_amdgcn_global_load_lds((const unsigned*)((const char*)(gbase) + (voff)[_i]), (PG8_LAS unsigned*)(lds + (bufoff) + ldsw + _i * 8192), 16, 0, 0); } while (0)
#define PG8_STAGE2(bufoff, gbase, v0, v1) do { \
        __builtin_amdgcn_global_load_lds((const unsigned*)((const char*)(gbase) + (v0)), (PG8_LAS unsigned*)(lds + (bufoff) + ldsw), 16, 0, 0); \
        __builtin_amdgcn_global_load_lds((const unsigned*)((const char*)(gbase) + (v1)), (PG8_LAS unsigned*)(lds + (bufoff) + ldsw + 8192), 16, 0, 0); } while (0)
#define PG8_STA(bufoff, h, pNG, pG, nx) do { if constexpr (Sched::GATHER) { const unsigned _v0 = (nx) ? nv[h][0] : cv[h][0], _v1 = (nx) ? nv[h][1] : cv[h][1]; PG8_STAGE2(bufoff, pG, _v0, _v1); } \
        else { PG8_STAGE(bufoff, (pNG) + (h) * hstep, voffA); } } while (0)
#define PG8_LDA(dst, b, h) do { _Pragma("unroll") for (int m = 0; m < 4; ++m) _Pragma("unroll") for (int k = 0; k < 2; ++k) dst[m][k] = *(const PG8_LAS bf16x8*)(lds + PG8_SA(b, h) + aoff + m * 2048 + k * 1024); } while (0)
#define PG8_LDB(dst, b, h) do { if constexpr (FP8 == 2) { _Pragma("unroll") for (int n = 0; n < 2; ++n) { const PG8_LAS unsigned char* _p = lds + PG8_SB(b, 0) + boff + (h) * 12288 + n * 1536; \
            const u32x2 _t0 = *(const volatile PG8_LAS u32x2*)_p, _t1 = *(const volatile PG8_LAS u32x2*)(_p + 8), _t2 = *(const volatile PG8_LAS u32x2*)(_p + 16); \
            dst[n][0] = __builtin_bit_cast(bf16x8, __builtin_shufflevector(_t0, _t1, 0, 1, 2, 3)); dst[n][1] = __builtin_bit_cast(bf16x8, __builtin_shufflevector(_t2, _t2, 0, 1, -1, -1)); } } \
        else { _Pragma("unroll") for (int n = 0; n < 2; ++n) _Pragma("unroll") for (int k = 0; k < 2; ++k) dst[n][k] = *(const PG8_LAS bf16x8*)(lds + PG8_SB(b, h) + boff + n * 2048 + k * 1024); } } while (0)
#define PG8_MMA(ai, bj, At, Bt) do { __builtin_amdgcn_s_setprio(1); \
        if constexpr (FP8 == 2) { _Pragma("unroll") for (int m = 0; m < 4; ++m) _Pragma("unroll") for (int n = 0; n < 2; ++n) \
            asm volatile("s_nop 1\n\tv_mfma_scale_f32_16x16x128_f8f6f4 %0, %1, %2, %0, %3, %3 op_sel_hi:[0,0,0] cbsz:2" : "+v"(acc[ai][bj][m][n]) : "v"(cat6(Bt[n][0], Bt[n][1])), "v"(cat16(At[m][0], At[m][1])), "v"(mxs)); } \
        else if constexpr (FP8 == 1) { _Pragma("unroll") for (int m = 0; m < 4; ++m) _Pragma("unroll") for (int n = 0; n < 2; ++n) \
            asm volatile("v_mfma_scale_f32_16x16x128_f8f6f4 %0, %1, %2, %0, %3, %3 op_sel_hi:[0,0,0]" : "+v"(acc[ai][bj][m][n]) : "v"(cat16(Bt[n][0], Bt[n][1])), "v"(cat16(At[m][0], At[m][1])), "v"(mxs)); } \
        else { _Pragma("unroll") for (int m = 0; m < 4; ++m) _Pragma("unroll") for (int n = 0; n < 2; ++n) _Pragma("unroll") for (int k = 0; k < 2; ++k) \
            acc[ai][bj][m][n] = __builtin_amdgcn_mfma_f32_16x16x32_bf16(Bt[n][k], At[m][k], acc[ai][bj][m][n], 0, 0, 0); } \
        __builtin_amdgcn_s_setprio(0); } while (0)
#define PG8_WAIT_V(n) asm volatile("s_waitcnt vmcnt(" #n ")" ::: "memory")
#define PG8_WAIT_L(n) asm volatile("s_waitcnt lgkmcnt(" #n ")" ::: "memory")
#define PG8_WAIT_VK do { if constexpr (FP8 == 2) PG8_WAIT_V(7); else PG8_WAIT_V(8); } while (0)
#define PG8_BAR __builtin_amdgcn_s_barrier()
#define PG8_SCHED __builtin_amdgcn_sched_barrier(0)
    Unit cur, nxt; int ui = 0;
    if (!S.next(0, cur)) return;
    int sig_pm = -1;
    const int mxs = 0x7f7f7f7f;
    f32x4 acc[2][2][4][2];
#pragma unroll
    for (int a = 0; a < 2; ++a)
#pragma unroll
        for (int b = 0; b < 2; ++b)
#pragma unroll
            for (int m = 0; m < 4; ++m)
#pragma unroll
                for (int n = 0; n < 2; ++n) acc[a][b][m][n] = (f32x4){0.f, 0.f, 0.f, 0.f};
    bf16x8 At[4][2], B0[2][2], B1[2][2];
    const char* gA0 = (const char*)g.A;
    const size_t btstep = (FP8 == 2) ? (size_t)B6_TILE : tstep, kmulB = (FP8 == 2) ? (size_t)(B6_KT / (BK * 2)) : (size_t)1;
    const char* cA = gA0 + (size_t)cur.pm * tstep; const char* cB = (const char*)g.Bt + (size_t)cur.e * g.bstride + (size_t)cur.pn * btstep;
    unsigned cv[2][2], nv[2][2];
#pragma unroll
    for (int h = 0; h < 2; ++h)
#pragma unroll
        for (int i = 0; i < 2; ++i) { cv[h][i] = 0u; nv[h][i] = 0u; }
    if constexpr (Sched::GATHER) {
#pragma unroll
        for (int h = 0; h < 2; ++h)
#pragma unroll
            for (int i = 0; i < 2; ++i) cv[h][i] = ((unsigned)S.arow(0, h * HALF + RA[i]) * (unsigned)K + (unsigned)CA[i]) * 2u;
    }
    int coff = PG8_KOFF(cur);
    { const size_t k0 = (size_t)coff * kstep, k1 = (size_t)((coff + 1) & kmask) * kstep;
    PG8_STB(0, cB + k0 * kmulB, cB + k0 * kmulB); PG8_STA(PG8_SA(0, 0), 0, cA + k0, gA0 + k0, false); PG8_STA(PG8_SA(0, 1), 1, cA + k0, gA0 + k0, false);
    if (wr == 1) PG8_BAR;
    PG8_WAIT_V(2); PG8_BAR;
    if constexpr (FP8 == 2) { PG8_STB(1, cB + k1 * kmulB, cB + k1 * kmulB); PG8_STA(PG8_SA(1, 0), 0, cA + k1, gA0 + k1, false); }
    else { PG8_STAGE(PG8_SB(1, 0), cB + k1, voffB); PG8_STA(PG8_SA(1, 0), 0, cA + k1, gA0 + k1, false); PG8_STAGE(PG8_SB(1, 1), cB + hstep + k1, voffB); } }
    if constexpr (FP8 == 2) PG8_WAIT_V(5); else PG8_WAIT_V(6);
    PG8_BAR;
    for (;;) {
        const bool has_next = S.next(ui + 1, nxt);
        const typename Epi::Pre epre = E.pre(cur, wr, wc, fr, fq);
        const int noff = has_next ? PG8_KOFF(nxt) : coff;
        const char* nA = has_next ? gA0 + (size_t)nxt.pm * tstep : cA; const char* nB = has_next ? (const char*)g.Bt + (size_t)nxt.e * g.bstride + (size_t)nxt.pn * btstep : cB;
        if constexpr (Sched::GATHER) {
#pragma unroll
            for (int h = 0; h < 2; ++h)
#pragma unroll
                for (int i = 0; i < 2; ++i) nv[h][i] = has_next ? ((unsigned)S.arow(ui + 1, h * HALF + RA[i]) * (unsigned)K + (unsigned)CA[i]) * 2u : cv[h][i];
        }
#pragma unroll 1
        for (int t = 0; t < nt; t += 2) {
            const bool last = (t == nt - 2);
            if constexpr (Sched::GATHER) { if (t == 2 && sig_pm >= 0) {
                if (S.done && tid == 0) (void)__hip_atomic_fetch_add(S.done + 64 * sig_pm, 1u, __ATOMIC_RELAXED, __HIP_MEMORY_SCOPE_AGENT); sig_pm = -1; } }
            const size_t k1 = (size_t)((t + 1 + coff) & kmask) * kstep, k2 = (size_t)((last ? noff : t + 2 + coff) & kmask) * kstep, k3 = (size_t)((last ? noff + 1 : t + 3 + coff) & kmask) * kstep;
            const char* pa = last ? nA : cA; const char* pb = last ? nB : cB;
            const char* a1 = cA + k1; const char* a1g = gA0 + k1;
            const char* a2 = pa + k2; const char* b2 = pb + k2 * kmulB; const char* a2g = gA0 + k2;
            const char* a3 = pa + k3; const char* b3 = pb + k3 * kmulB; const char* a3g = gA0 + k3;
            PG8_LDB(B0, 0, 0); PG8_LDB(B1, 0, 1); PG8_SCHED; PG8_LDA(At, 0, 0); PG8_STA(PG8_SA(1, 1), 1, a1, a1g, false);
            PG8_WAIT_VK; PG8_WAIT_L(0); PG8_BAR; PG8_MMA(0, 0, At, B0); PG8_MMA(0, 1, At, B1); PG8_BAR; PG8_SCHED;
            PG8_LDA(At, 0, 1); PG8_STB(0, b2, b2); PG8_STA(PG8_SA(0, 0), 0, a2, a2g, last);
            PG8_WAIT_VK; PG8_WAIT_L(0); PG8_BAR; PG8_MMA(1, 0, At, B0); PG8_MMA(1, 1, At, B1); PG8_BAR; PG8_SCHED;
            PG8_LDB(B0, 1, 0); PG8_LDB(B1, 1, 1); PG8_SCHED; PG8_LDA(At, 1, 0); PG8_STA(PG8_SA(0, 1), 1, a2, a2g, last);
            PG8_WAIT_VK; PG8_WAIT_L(0); PG8_BAR; PG8_MMA(0, 0, At, B0); PG8_MMA(0, 1, At, B1); PG8_BAR; PG8_SCHED;
            PG8_LDA(At, 1, 1); PG8_STB(1, b3, b3); PG8_STA(PG8_SA(1, 0), 0, a3, a3g, last);
            PG8_WAIT_VK; PG8_WAIT_L(0); PG8_BAR; PG8_MMA(1, 0, At, B0); PG8_MMA(1, 1, At, B1); PG8_BAR; PG8_SCHED;
        }
        if constexpr (ALIGN_EPI) { if (wr == 0) PG8_BAR; }
        if constexpr (FP8) asm volatile("s_nop 15\n\ts_nop 3" ::: "memory");
        { int le = lane; asm volatile("" : "+v"(le));
          E(acc, cur, wr, wc, le & 15, le >> 4, epre); }
        if (!has_next) break;
#pragma unroll
        for (int a = 0; a < 2; ++a)
#pragma unroll
            for (int b = 0; b < 2; ++b)
#pragma unroll
                for (int m = 0; m < 4; ++m)
#pragma unroll
                    for (int n = 0; n < 2; ++n) acc[a][b][m][n] = (f32x4){0.f, 0.f, 0.f, 0.f};
        if constexpr (Sched::GATHER) sig_pm = cur.pm;
        cur = nxt; cA = nA; cB = nB; coff = noff; ++ui;
        if constexpr (Sched::GATHER) {
#pragma unroll
            for (int h = 0; h < 2; ++h)
#pragma unroll
                for (int i = 0; i < 2; ++i) cv[h][i] = nv[h][i];
        }
        if constexpr (ALIGN_EPI) { if (wr == 1) PG8_BAR; }
    }
    PG8_WAIT_V(0);
    if constexpr (!ALIGN_EPI) { if (wr == 0) PG8_BAR; }
    PG8_BAR;
    if constexpr (Sched::GATHER) { if (S.done && tid == 0) { if (sig_pm >= 0) (void)__hip_atomic_fetch_add(S.done + 64 * sig_pm, 1u, __ATOMIC_RELAXED, __HIP_MEMORY_SCOPE_AGENT);
            (void)__hip_atomic_fetch_add(S.done + 64 * cur.pm, 1u, __ATOMIC_RELAXED, __HIP_MEMORY_SCOPE_AGENT); } }
#undef PG8_KOFF
#undef PG8_SA
#undef PG8_SB
#undef PG8_STAGE
#undef PG8_STAGE2
#undef PG8_STA
#undef PG8_LDA
#undef PG8_LDB
#undef PG8_MMA
#undef PG8_WAIT_V
#undef PG8_WAIT_L
#undef PG8_WAIT_VK
#undef PG8_STB
#undef PG8_STAGEB6
#undef PG8_BAR
#undef PG8_SCHED
}
}

constexpr int NWAVES = 8, NTHR = NWAVES * 64;
constexpr int BATCH = 2, SEQ = 8192, D = 1024, M = BATCH * SEQ;
constexpr int NZ = 2048;
constexpr int CW = 512;
constexpr int MEMLEN = 256, NH = 4, HD = 256, MKV = BATCH * MEMLEN;
constexpr int NE = 32, TOPK = 4, DE = 1024, ECAP = 16384;
constexpr int MAXTILES = (M * TOPK) / 256 + NE;
constexpr float EPS = 1e-5f;
constexpr float WSCALE = 32.0f;
constexpr float QSCALE = 0.0625f * 1.44269504f;
constexpr int FN1 = 128, FN2 = 64;

constexpr size_t MiB = 1u << 20;
constexpr size_t WS_CTL = 0, CTL_ZERO_BYTES = 1 * MiB;
constexpr size_t WS_WINT = 2 * MiB, WS_WOUTT = 6 * MiB, WS_WQT = 8 * MiB, WS_WKT = 10 * MiB, WS_WVT = 12 * MiB, WS_WOT = 14 * MiB;
constexpr size_t WS_WRG = 16 * MiB;
constexpr size_t WS_TAB = 17 * MiB;
constexpr size_t WS_MC = 18 * MiB;
constexpr size_t WS_MEMN = 22 * MiB, WS_KB = 23 * MiB, WS_VT = 24 * MiB;
constexpr size_t WS_TOK = 25 * MiB;
constexpr size_t WS_ETOK = 26 * MiB;
constexpr size_t WS_WGUT = 32 * MiB, WS_WDT = 160 * MiB;
constexpr size_t WS_XR = 224 * MiB;
constexpr size_t WS_XN3 = 288 * MiB;
constexpr size_t WS_CTR = 320 * MiB;
constexpr size_t WS_XN = 464 * MiB, WS_Z = 496 * MiB, WS_G = 560 * MiB, WS_Y = 592 * MiB, WS_XB = 624 * MiB, WS_Q = 656 * MiB, WS_O = 688 * MiB;
constexpr size_t WS_ACT = 464 * MiB;
constexpr size_t WS_WQN = 28 * MiB, WS_WOT16 = 30 * MiB;
constexpr size_t WS_MK = WS_Q, WS_MV = WS_Q + 2 * MiB;
constexpr size_t WS_P = WS_O;
constexpr size_t WS_END = 720 * MiB;
constexpr size_t TAB_WA = 128 * 1024;
constexpr size_t TAB_DCH = 256 * 1024;
constexpr int CW_BAR = 4096;
constexpr int CW_CNT = 8192;
constexpr int CW_ROWSQ = 16384;
constexpr int CW_DONE = 131072;
static_assert((CW_DONE + 64 * 320) * 4 <= (int)CTL_ZERO_BYTES, "ctl");
constexpr int CW_GRP = 65536;
static_assert((CW_GRP + 64 * 64 * 3) * 4 <= (int)CTL_ZERO_BYTES, "ctl");
static_assert((CW_ROWSQ + M) * 4 <= (int)CTL_ZERO_BYTES, "ctl");

constexpr int LDS_BYTES = 147456;
constexpr int RING_BYTES = 131072, LDSCTL_OFF = LDS_BYTES - 512, MISC_OFF = LDSCTL_OFF + 320;
constexpr int MOE_TAB_OFF = 143360;

#define GAS __attribute__((address_space(1)))
#define LAS __attribute__((address_space(3)))
typedef unsigned short bf16;
typedef unsigned v4u __attribute__((ext_vector_type(4)));
typedef unsigned v2u __attribute__((ext_vector_type(2)));
typedef float f32x4 __attribute__((ext_vector_type(4)));
typedef GAS unsigned gu32;
typedef float f32x2v __attribute__((ext_vector_type(2)));
#define RLX_AGENT __ATOMIC_RELAXED, __HIP_MEMORY_SCOPE_AGENT
#define LDS_WAIT() asm volatile("s_waitcnt lgkmcnt(0)" ::: "memory")
__device__ __forceinline__ unsigned pk2(float lo, float hi) { return pg8::cvt_pk_bf16(lo, hi); }
__device__ __forceinline__ unsigned f2bf(float f) { return pg8::cvt_pk_bf16(f, 0.f) & 0xffffu; }
__device__ __forceinline__ float bf2f(unsigned short b) { return __builtin_bit_cast(float, (unsigned)b << 16); }
__device__ __forceinline__ float bflo(unsigned w) { return __builtin_bit_cast(float, w << 16); }
__device__ __forceinline__ float bfhi(unsigned w) { return __builtin_bit_cast(float, w & 0xffff0000u); }

#define XB_TMO      128
#define XB_XCNT(j)  (256  + 64 * (j))
#define XB_XSUB(j)  (1280 + 64 * (j))
#define XB_XGEN(j)  (2304 + 64 * (j))
#define XB_TOP      3328
#define XB_TOPGEN   3392
#define XCD_BAR_WORDS 3456
#define XB_SPIN_CAP (1u << 18)
__device__ __forceinline__ unsigned xb_ld(unsigned* p)              { return __hip_atomic_load(p, __ATOMIC_RELAXED, __HIP_MEMORY_SCOPE_AGENT); }
__device__ __forceinline__ unsigned xb_add(unsigned* p, unsigned v) { return __hip_atomic_fetch_add(p, v, __ATOMIC_RELAXED, __HIP_MEMORY_SCOPE_AGENT); }
__device__ __forceinline__ unsigned xb_xcc_id() { return (unsigned)__builtin_amdgcn_s_getreg((3 << 11) | 20) & 0xFu; }
#define XB_SPIN(cond, bar) do { unsigned _sp = 0; while (cond) { __builtin_amdgcn_s_sleep(1); \
    if ((++_sp & 255u) == 0u) { if (xb_ld(&(bar)[XB_TMO])) break; if (_sp > XB_SPIN_CAP) { atomicAdd(&(bar)[XB_TMO], 1u); break; } } } } while (0)
struct XcdBarrier { unsigned* bar; unsigned x; volatile LAS unsigned* st; };
__device__ __forceinline__ XcdBarrier xcd_barrier_post(unsigned* bar, volatile LAS unsigned* st, bool leader) {
    XcdBarrier b; b.bar = bar; b.x = xb_xcc_id(); b.st = st;
    if (leader) (void)xb_add(&bar[XB_XCNT(b.x)], 1u);
    return b;
}
__device__ __forceinline__ void xcd_barrier_complete(unsigned* bar, unsigned x, unsigned& nloc, unsigned& nx) {
    const unsigned G = gridDim.x * gridDim.y * gridDim.z;
    unsigned sum, cnt, mine, sp = 0u;
    for (;;) {
        sum = 0u; cnt = 0u; mine = 0u;
#pragma unroll
        for (unsigned j = 0; j < 16; ++j) { const unsigned c = xb_ld(&bar[XB_XCNT(j)]); sum += c; cnt += (c > 0u) ? 1u : 0u; mine = (j == x) ? c : mine; }
        if (sum == G) break;
        __builtin_amdgcn_s_sleep(1);
        if ((++sp & 255u) == 0u) { if (xb_ld(&bar[XB_TMO])) break; if (sp > XB_SPIN_CAP) { atomicAdd(&bar[XB_TMO], 1u); break; } }
    }
    nloc = mine > 0u ? mine : 1u; nx = cnt > 0u ? cnt : 1u;
}
__device__ __forceinline__ void xcd_barrier(const XcdBarrier& b, bool leader) {
    asm volatile("s_waitcnt vmcnt(0)" ::: "memory");
    __syncthreads();
    if (leader) {
        unsigned* bar = b.bar;
        __builtin_amdgcn_s_waitcnt(0);
        unsigned nloc = b.st[0], nx = b.st[1];
        if (nloc == 0u) { xcd_barrier_complete(bar, b.x, nloc, nx); b.st[0] = nloc; b.st[1] = nx; }
        const unsigned old = xb_add(&bar[XB_XSUB(b.x)], 1u);
        const unsigned gen = old / nloc;
        if (old + 1u == (gen + 1u) * nloc) {
            __builtin_amdgcn_fence(__ATOMIC_RELEASE, "agent");
            asm volatile("s_waitcnt vmcnt(0)" ::: "memory");
            const unsigned og = xb_add(&bar[XB_TOP], 1u);
            const unsigned tg = og / nx;
            if (og + 1u == (tg + 1u) * nx) xb_add(&bar[XB_TOPGEN], 1u);
            else XB_SPIN(xb_ld(&bar[XB_TOPGEN]) == tg, bar);
            __builtin_amdgcn_fence(__ATOMIC_ACQUIRE, "agent");
            xb_add(&bar[XB_XGEN(b.x)], 1u);
            asm volatile("s_waitcnt vmcnt(0)" ::: "memory");
        } else {
            XB_SPIN(xb_ld(&bar[XB_XGEN(b.x)]) == gen, bar);
            __builtin_amdgcn_fence(__ATOMIC_ACQUIRE, "agent");
            asm volatile("s_waitcnt vmcnt(0)" ::: "memory");
        }
    }
    __syncthreads();
}

constexpr unsigned NGRP = 4;
__device__ __forceinline__ void group_sync(unsigned* bar, unsigned long long* c1, unsigned* c2, bool leader) {
    asm volatile("s_waitcnt vmcnt(0)" ::: "memory");
    __syncthreads();
    if (leader) {
        __builtin_amdgcn_s_waitcnt(0);
        const unsigned x = xb_xcc_id();
        (void)__hip_atomic_fetch_add(c1, 1ull | (1ull << (8 + 3 * x)), __ATOMIC_RELAXED, __HIP_MEMORY_SCOPE_AGENT);
        unsigned long long v = 0ull;
        XB_SPIN(((v = __hip_atomic_load(c1, __ATOMIC_RELAXED, __HIP_MEMORY_SCOPE_AGENT)) & 0xffull) < NGRP, bar);
        if (((v >> (8 + 3 * x)) & 7ull) != NGRP) {
            __builtin_amdgcn_fence(__ATOMIC_RELEASE, "agent");
            asm volatile("s_waitcnt vmcnt(0)" ::: "memory");
            (void)xb_add(c2, 1u);
            XB_SPIN(xb_ld(c2) < NGRP, bar);
        }
        __builtin_amdgcn_fence(__ATOMIC_ACQUIRE, "agent");
        asm volatile("s_waitcnt vmcnt(0)" ::: "memory");
    }
    __syncthreads();
}

struct Args { const float* in[22]; float* out; unsigned char* ws; int ph_lo, ph_hi; };
struct Frame {
    LAS unsigned char* lds;
    unsigned char* ws;
    int wave, vcu, G;
    __device__ __forceinline__ int lane() const { return lane_id(); }
    __device__ __forceinline__ int tid() const { return wave * 64 + lane_id(); }
};
__device__ __forceinline__ float wave_sum(float v) {
#pragma unroll
    for (int o = 1; o < 64; o <<= 1) v += __shfl_xor(v, o);
    return v;
}
__device__ __forceinline__ float wave_max(float v) {
#pragma unroll
    for (int o = 1; o < 64; o <<= 1) v = fmaxf(v, __shfl_xor(v, o));
    return v;
}

template <bool F8>
__device__ __forceinline__ void p0_item(const float* W, int N, unsigned char* WT, int ldt, int k0, int n0s, int n0d, const float* gk, float scale, LAS float* scr, int lane) {
    const int n4 = lane & 15, kr = lane >> 4;
    f32x4 wv[16];
#pragma unroll
    for (int i = 0; i < 16; ++i) wv[i] = *(const GAS f32x4*)(W + (size_t)(k0 + 4 * i + kr) * N + n0s + 4 * n4);
#pragma unroll
    for (int i = 0; i < 16; ++i) { const int kk = 4 * i + kr; float g = scale; if (gk) g *= gk[kk];
        LAS float* d = scr + kk * 65 + 4 * n4; d[0] = wv[i].x * g; d[1] = wv[i].y * g; d[2] = wv[i].z * g; d[3] = wv[i].w * g; }
    LDS_WAIT(); asm volatile("" ::: "memory");
    if constexpr (!F8) { const int c = lane & 7;
#pragma unroll
        for (int j = 0; j < 8; ++j) { const int n = (lane >> 3) + 8 * j; const LAS float* sp = scr + (8 * c) * 65 + n;
            v4u o; o.x = pk2(sp[0 * 65], sp[1 * 65]); o.y = pk2(sp[2 * 65], sp[3 * 65]); o.z = pk2(sp[4 * 65], sp[5 * 65]); o.w = pk2(sp[6 * 65], sp[7 * 65]);
            *(GAS v4u*)(WT + (size_t)(n0d + n) * ldt + (k0 + 8 * c) * 2) = o; }
    } else { const int c = lane & 3;
#pragma unroll
        for (int j = 0; j < 4; ++j) { const int n = (lane >> 2) + 16 * j; const LAS float* sp = scr + (16 * c) * 65 + n;
            v4u o; o.x = pg8::pk4_fp8(sp[0 * 65], sp[1 * 65], sp[2 * 65], sp[3 * 65]); o.y = pg8::pk4_fp8(sp[4 * 65], sp[5 * 65], sp[6 * 65], sp[7 * 65]);
            o.z = pg8::pk4_fp8(sp[8 * 65], sp[9 * 65], sp[10 * 65], sp[11 * 65]); o.w = pg8::pk4_fp8(sp[12 * 65], sp[13 * 65], sp[14 * 65], sp[15 * 65]);
            *(GAS v4u*)(WT + (size_t)(n0d + n) * ldt + k0 + 16 * c) = o; }
    }
    LDS_WAIT(); asm volatile("" ::: "memory");
}
constexpr int MOE_IT_GU = (D / 128) * (2 * DE / 32), MOE_IT_DN = (DE / 128) * (D / 32), MOE_ITEMS = NE * (MOE_IT_GU + MOE_IT_DN);
constexpr float W6SCALE = 64.0f;
constexpr size_t WGU6_E = (size_t)(2 * DE / 256) * pg8::B6_TILE, WDN6_E = (size_t)(D / 256) * pg8::B6_TILE;
__device__ __forceinline__ void p0_moe_decode(const Args& a, unsigned char* ws, int it, const float*& src, unsigned char*& dst, int& N) {
    if (it < NE * MOE_IT_GU) { const int e = it / MOE_IT_GU, q = it % MOE_IT_GU, kb = q / (2 * DE / 32), nb = q % (2 * DE / 32);
        const int n0d = 32 * nb, pn = n0d >> 8, hf = (n0d >> 7) & 1, jj = n0d & 127, n0s = hf * DE + 128 * pn + jj;
        N = 2 * DE; src = a.in[17] + (size_t)e * D * 2 * DE + (size_t)(128 * kb) * (2 * DE) + n0s; dst = ws + WS_WGUT + (size_t)e * WGU6_E + (size_t)pn * pg8::B6_TILE + (size_t)kb * pg8::B6_KT + (size_t)(n0d & 255) * 96; }
    else { it -= NE * MOE_IT_GU; const int e = it / MOE_IT_DN, q = it % MOE_IT_DN, kb = q / (D / 32), nb = q % (D / 32);
        N = D; src = a.in[19] + (size_t)e * DE * D + (size_t)(128 * kb) * D + 32 * nb; dst = ws + WS_WDT + (size_t)e * WDN6_E + (size_t)((32 * nb) >> 8) * pg8::B6_TILE + (size_t)kb * pg8::B6_KT + (size_t)((32 * nb) & 255) * 96; }
}
#define P0M_LOAD(wv, src, N) do { const unsigned _vo = (unsigned)(((lane >> 3) * (N) + 4 * (lane & 7)) * 4); _Pragma("unroll") for (int _i = 0; _i < 16; ++_i) \
        wv[_i] = __builtin_nontemporal_load((const GAS f32x4*)((const GAS char*)((src) + (size_t)(8 * _i) * (N)) + _vo)); } while (0)
#define P0M_PROC(wv, dst) do { _Pragma("unroll") for (int _i = 0; _i < 16; ++_i) { LAS float* _d = scr + (8 * _i + (lane >> 3)) * 33 + 4 * (lane & 7); _d[0] = wv[_i].x * WSCALE; _d[1] = wv[_i].y * WSCALE; _d[2] = wv[_i].z * WSCALE; _d[3] = wv[_i].w * WSCALE; } \
        LDS_WAIT(); asm volatile("" ::: "memory"); \
        _Pragma("unroll") for (int _j = 0; _j < 4; ++_j) { const int _n = (lane >> 3) + 8 * _j; const LAS float* _s = scr + (16 * (lane & 7)) * 33 + _n; \
            v4u _o; _o.x = pg8::pk4_fp8(_s[0 * 33], _s[1 * 33], _s[2 * 33], _s[3 * 33]); _o.y = pg8::pk4_fp8(_s[4 * 33], _s[5 * 33], _s[6 * 33], _s[7 * 33]); \
            _o.z = pg8::pk4_fp8(_s[8 * 33], _s[9 * 33], _s[10 * 33], _s[11 * 33]); _o.w = pg8::pk4_fp8(_s[12 * 33], _s[13 * 33], _s[14 * 33], _s[15 * 33]); \
            *(GAS v4u*)((dst) + (size_t)_n * D + 16 * (lane & 7)) = _o; } \
        LDS_WAIT(); asm volatile("" ::: "memory"); } while (0)
#define P0M_PROC6(wv, dst) do { _Pragma("unroll") for (int _i = 0; _i < 16; ++_i) { LAS float* _d = scr + (8 * _i + (lane >> 3)) * 33 + 4 * (lane & 7); _d[0] = wv[_i].x * W6SCALE; _d[1] = wv[_i].y * W6SCALE; _d[2] = wv[_i].z * W6SCALE; _d[3] = wv[_i].w * W6SCALE; } \
        LDS_WAIT(); asm volatile("" ::: "memory"); \
        _Pragma("unroll 1") for (int _j = 0; _j < 2; ++_j) { const int _g = (lane >> 2) + 16 * _j, _q = lane & 3; const LAS float* _s = scr + (32 * _q) * 33 + _g; pg8::f32x16_t _s0, _s1; \
            if (ilv) { _Pragma("unroll") for (int _e = 0; _e < 16; ++_e) { _s0[_e] = _s[(2 * _e) * 33]; _s1[_e] = _s[(2 * _e + 1) * 33]; } } \
            else { _Pragma("unroll") for (int _e = 0; _e < 16; ++_e) { _s0[_e] = _s[_e * 33]; _s1[_e] = _s[(16 + _e) * 33]; } } \
            const pg8::u32x6 _p = pg8::pk32_fp6(_s0, _s1); const int _r = 16 * ((_g >> 2) & 1) + 4 * (_g >> 3) + (_g & 3); unsigned char* _o = (dst) + (size_t)(_r * 96 + 24 * ((_q + 2 * (_r >> 3)) & 3)); \
            *(GAS v2u*)_o = (v2u){_p[0], _p[1]}; *(GAS v2u*)(_o + 8) = (v2u){_p[2], _p[3]}; *(GAS v2u*)(_o + 16) = (v2u){_p[4], _p[5]}; } \
        LDS_WAIT(); asm volatile("" ::: "memory"); } while (0)
__device__ __forceinline__ void p0_moe_stream(Frame& F, const Args& a, int lo, int hi, int gw, int NGW) {
    LAS float* scr = (LAS float*)(F.lds + F.wave * 16896); const int lane = F.lane(); unsigned char* ws = F.ws;
    f32x4 wA[16], wB[16]; const float* sA; const float* sB; unsigned char* dA; unsigned char* dB; int nA, nB;
    bool ilv; { pg8::f32x16_t t0 = {}, t1 = {}; float one = 1.0f, two = 2.0f; asm volatile("" : "+v"(one), "+v"(two)); t0[0] = one; t1[0] = two; const pg8::u32x6 tp = pg8::pk32_fp6(t0, t1);
                ilv = (((tp[0] >> 6) & 63u) == 16u) || (((tp[3] >> 0) & 63u) != 16u); }
    int it = lo + gw;
    if (it < hi) { p0_moe_decode(a, ws, it, sA, dA, nA); P0M_LOAD(wA, sA, nA); }
    for (; it < hi; it += 2 * NGW) {
        const int it2 = it + NGW, it3 = it + 2 * NGW;
        if (it2 < hi) { p0_moe_decode(a, ws, it2, sB, dB, nB); P0M_LOAD(wB, sB, nB); }
        P0M_PROC6(wA, dA);
        if (it3 < hi) { p0_moe_decode(a, ws, it3, sA, dA, nA); P0M_LOAD(wA, sA, nA); }
        if (it2 < hi) P0M_PROC6(wB, dB);
    }
}
__device__ __forceinline__ void rms_row_to_bf16(const float* xrow, const float* gain, bf16* orow, int lane) {
    const GAS f32x4* xr = (const GAS f32x4*)xrow + lane; const GAS f32x4* gr = (const GAS f32x4*)gain + lane;
    f32x4 v[4]; float s = 0.f;
#pragma unroll
    for (int j = 0; j < 4; ++j) { v[j] = xr[64 * j]; s += (v[j].x * v[j].x + v[j].y * v[j].y) + (v[j].z * v[j].z + v[j].w * v[j].w); }
    const float rs = 1.0f / sqrtf(wave_sum(s) * (1.f / D) + EPS);
    GAS unsigned long long* o8 = (GAS unsigned long long*)orow + lane;
#pragma unroll
    for (int j = 0; j < 4; ++j) { const f32x4 g = gr[64 * j]; o8[64 * j] = (unsigned long long)pk2(v[j].x * rs * g.x, v[j].y * rs * g.y) | ((unsigned long long)pk2(v[j].z * rs * g.z, v[j].w * rs * g.w) << 32); }
}
__device__ __forceinline__ void p0_prologue(Frame& F, const Args& a) {
    LAS float* scr = (LAS float*)(F.lds + F.wave * 16896);
    const int gw = F.vcu * NWAVES + F.wave, NGW = F.G * NWAVES;
    unsigned char* ws = F.ws;
    constexpr int I_WIN = (D / 64) * (NZ / 64);
    constexpr int I_SQ = (D / 64) * (D / 64);
    constexpr int NITEMS = I_WIN + 4 * I_SQ + 4 * D;
    for (int it = gw; it < NITEMS; it += NGW) {
        int r = it;
        if (r < I_WIN) { const int nb = r % (NZ / 64), kb = r / (NZ / 64); p0_item<false>(a.in[3], NZ, ws + WS_WINT, D * 2, 64 * kb, 64 * nb, 64 * nb, nullptr, 1.0f, scr, F.lane()); continue; } r -= I_WIN;
        if (r < 2 * I_SQ) { const int w = r / I_SQ, q = r % I_SQ, nb = q % (D / 64), kb = q / (D / 64), k0 = 64 * kb;
            if (w == 0) p0_item<false>(a.in[7], D, ws + WS_WOUTT, D * 2, k0, 64 * nb, 64 * nb, (k0 < CW) ? a.in[5] + k0 : a.in[6] + (k0 - CW), 1.0f, scr, F.lane());
            else p0_item<false>(a.in[13], D, ws + WS_WOT16, D * 2, k0, 64 * nb, 64 * nb, nullptr, 1.0f, scr, F.lane());
            continue; } r -= 2 * I_SQ;
        if (r < 2 * I_SQ) { const int w = r / I_SQ, q = r % I_SQ, nb = q % (D / 64), kb = q / (D / 64), k0 = 64 * kb;
            p0_item<true>(w == 0 ? a.in[11] : a.in[12], D, ws + (w == 0 ? WS_WKT : WS_WVT), D, k0, 64 * nb, 64 * nb, nullptr, WSCALE, scr, F.lane()); continue; } r -= 2 * I_SQ;
        { const int k = r >> 2, c0 = (r & 3) * 256 + 4 * F.lane(); const float g = a.in[8][k];
            const f32x4 v = *(const GAS f32x4*)(a.in[10] + (size_t)k * D + c0); v2u o; o.x = pk2(v.x * g, v.y * g); o.y = pk2(v.z * g, v.w * g);
            *(GAS v2u*)((bf16*)(ws + WS_WQN) + (size_t)k * D + c0) = o; }
    }
    for (int m = 2 * gw; m < M; m += 2 * NGW) {
        const GAS f32x4* x0 = (const GAS f32x4*)(a.in[0] + (size_t)m * D) + F.lane(); const GAS f32x4* x1 = x0 + D / 4; const GAS f32x4* gr = (const GAS f32x4*)a.in[2] + F.lane();
        f32x4 v0[4], v1[4]; float s0 = 0.f, s1 = 0.f;
#pragma unroll
        for (int j = 0; j < 4; ++j) { v0[j] = x0[64 * j]; v1[j] = x1[64 * j]; }
#pragma unroll
        for (int j = 0; j < 4; ++j) { s0 += (v0[j].x * v0[j].x + v0[j].y * v0[j].y) + (v0[j].z * v0[j].z + v0[j].w * v0[j].w); s1 += (v1[j].x * v1[j].x + v1[j].y * v1[j].y) + (v1[j].z * v1[j].z + v1[j].w * v1[j].w); }
        const float r0 = 1.0f / sqrtf(wave_sum(s0) * (1.f / D) + EPS), r1 = 1.0f / sqrtf(wave_sum(s1) * (1.f / D) + EPS);
        GAS unsigned long long* o0 = (GAS unsigned long long*)((bf16*)(ws + WS_XN) + (size_t)m * D) + F.lane(); GAS unsigned long long* o1 = o0 + D / 4;
#pragma unroll
        for (int j = 0; j < 4; ++j) { const f32x4 g = gr[64 * j];
            o0[64 * j] = (unsigned long long)pk2(v0[j].x * r0 * g.x, v0[j].y * r0 * g.y) | ((unsigned long long)pk2(v0[j].z * r0 * g.z, v0[j].w * r0 * g.w) << 32);
            o1[64 * j] = (unsigned long long)pk2(v1[j].x * r1 * g.x, v1[j].y * r1 * g.y) | ((unsigned long long)pk2(v1[j].z * r1 * g.z, v1[j].w * r1 * g.w) << 32); }
    }
    for (int m = gw; m < MKV; m += NGW) {
        const GAS f32x4* xr = (const GAS f32x4*)(a.in[1] + (size_t)m * D) + F.lane(); const GAS f32x4* gr = (const GAS f32x4*)a.in[9] + F.lane();
        f32x4 v[4]; float ss = 0.f;
#pragma unroll
        for (int j = 0; j < 4; ++j) { v[j] = xr[64 * j]; ss += (v[j].x * v[j].x + v[j].y * v[j].y) + (v[j].z * v[j].z + v[j].w * v[j].w); }
        const float rs = 1.0f / sqrtf(wave_sum(ss) * (1.f / D) + EPS);
        GAS unsigned* o4 = (GAS unsigned*)(ws + WS_MEMN + (size_t)m * D) + F.lane();
#pragma unroll
        for (int j = 0; j < 4; ++j) { const f32x4 g = gr[64 * j]; o4[64 * j] = pg8::pk4_fp8(v[j].x * rs * g.x, v[j].y * rs * g.y, v[j].z * rs * g.z, v[j].w * rs * g.w); }
    }
    const int gt = F.vcu * NTHR + F.tid(), NGT = F.G * NTHR;
    float* wrg = (float*)(ws + WS_WRG);
    for (int i = gt; i < D * NE; i += NGT) { const int e = i >> 10, k = i & 1023; wrg[i] = a.in[15][k * NE + e] * a.in[14][k]; }
    bf16* wa = (bf16*)(ws + WS_TAB + TAB_WA); bf16* mc = (bf16*)(ws + WS_MC); bf16* dch = (bf16*)(ws + WS_TAB + TAB_DCH);
    for (int i = gt; i < 256 * 128; i += NGT) { const int m = i >> 7, k = i & 127; float sn, cs; sincospif((float)((k * (m & 127)) & 127) * (2.0f / 128.0f), &sn, &cs); wa[i] = (bf16)f2bf(m < 128 ? cs : -sn); }
    for (int i = gt; i < 128 * 128 * 128; i += NGT) { const int s1p = i >> 14, mp = (i >> 7) & 127, k = i & 127, op = mp >> 6, s2q = mp & 63, s2 = k >> 1, part = k & 1;
        const int sp = s1p + 128 * s2q, r = (s2 * sp) & 8191; float sn, cs; sincospif((float)r * (2.0f / 8192.0f), &sn, &cs);
        mc[i] = (bf16)f2bf(op == 0 ? (part == 0 ? cs : sn) : (part == 0 ? -sn : cs)); }
    for (int i = gt; i < 8192; i += NGT) { const int p = i >> 12, hc = (i >> 11) & 1, cp = (i >> 5) & 63, q = (i >> 3) & 3, j = i & 7, c = 32 * hc + (j < 4 ? 4 * q + j : 16 + 4 * q + (j - 4));
        float sn, cs; sincospif((float)((c * cp) & 63) * (2.0f / 64.0f), &sn, &cs); dch[i] = (bf16)f2bf(p == 0 ? cs : sn); }
}

typedef short s16x4 __attribute__((ext_vector_type(4)));
typedef short bf16x8v __attribute__((ext_vector_type(8)));
__device__ __forceinline__ bf16x8v tr_pair(LAS unsigned char* p0, int delta) {
    const s16x4 lo = __builtin_amdgcn_ds_read_tr16_b64_v4i16((LAS s16x4*)p0); const s16x4 hi = __builtin_amdgcn_ds_read_tr16_b64_v4i16((LAS s16x4*)(p0 + delta));
    return __builtin_shufflevector(lo, hi, 0, 1, 2, 3, 4, 5, 6, 7);
}
constexpr int FA_P = 544;
constexpr int FC_P = 1056;
__device__ __forceinline__ void fftA_phase(Frame& F) {
    const bf16* Z = (const bf16*)(F.ws + WS_Z); bf16* G = (bf16*)(F.ws + WS_G); const bf16* WA = (const bf16*)(F.ws + WS_TAB + TAB_WA);
    const int tid = F.tid(), lane = F.lane(), w = F.wave, nb = w & 3, mh = w >> 2, g = lane >> 4, q = (lane & 15) >> 2, p = lane & 3;
    for (int unit = F.vcu; unit < BATCH * FN2 * 2; unit += F.G) {
        const int b = unit >> 7, s2 = (unit >> 1) & 63, ch = unit & 1;
        __syncthreads();
#pragma unroll
        for (int i = 0; i < 8; ++i) { const int row = 16 * i + (tid >> 5), piece = tid & 31;
            const v4u v = *(const GAS v4u*)(Z + ((size_t)b * SEQ + 64 * row + s2) * NZ + 1536 + 256 * ch + 8 * piece);
            *(LAS v4u*)(F.lds + row * FA_P + piece * 16) = v; }
        __syncthreads();
        bf16x8v af[4][4];
#pragma unroll
        for (int nt = 0; nt < 4; ++nt)
#pragma unroll
            for (int ks = 0; ks < 4; ++ks) af[nt][ks] = tr_pair(F.lds + (32 * ks + 8 * g + q) * FA_P + (64 * nb + 16 * nt) * 2 + 8 * p, 4 * FA_P);
#pragma unroll
        for (int mt = 0; mt < 8; ++mt) {
            const int m0 = 128 * mh + 16 * mt;
            bf16x8v bfr[4];
#pragma unroll
            for (int ks = 0; ks < 4; ++ks) bfr[ks] = *(const GAS bf16x8v*)(WA + (size_t)(m0 + (lane & 15)) * 128 + 32 * ks + 8 * (lane >> 4));
            const int s1p = 16 * mt + (lane & 15);
            bf16* gp = G + ((((size_t)b * FN1 + s1p) * FN2 + s2) * 2 + mh) * CW + 256 * ch + 64 * nb + 4 * (lane >> 4);
#pragma unroll
            for (int nt = 0; nt < 4; ++nt) { f32x4 acc = {0.f, 0.f, 0.f, 0.f};
#pragma unroll
                for (int ks = 0; ks < 4; ++ks) acc = __builtin_amdgcn_mfma_f32_16x16x32_bf16(af[nt][ks], bfr[ks], acc, 0, 0, 0);
                v2u o; o.x = pk2(acc[0], acc[1]); o.y = pk2(acc[2], acc[3]);
                *(GAS v2u*)(gp + 16 * nt) = o; }
        }
    }
}
__device__ __forceinline__ void conv_phase(Frame& F, const Args& a, int wgi, int nwg) {
    const bf16* Z = (const bf16*)(F.ws + WS_Z); bf16* Y = (bf16*)(F.ws + WS_Y);
    const int gw = wgi * NWAVES + F.wave, NGW = nwg * NWAVES, lane = F.lane();
    const float* cw = a.in[4];
    float w0[8], w1[8], w2[8];
#pragma unroll
    for (int j = 0; j < 8; ++j) { w0[j] = cw[8 * lane + j]; w1[j] = cw[CW + 8 * lane + j]; w2[j] = cw[2 * CW + 8 * lane + j]; }
    constexpr int CH = 8;
    for (int c = gw; c < M / CH; c += NGW) {
        const int t0 = c * CH, s0 = t0 & (SEQ - 1);
        v4u zc[CH + 2], zv[CH + 2], zb[CH];
#pragma unroll
        for (int i = 0; i < CH + 2; ++i) { const int t = t0 - 1 + i; const bool valid = (i == 0) ? (s0 > 0) : ((i == CH + 1) ? (s0 + CH < SEQ) : true);
            if (valid) { zc[i] = *(const GAS v4u*)(Z + (size_t)t * NZ + CW + 8 * lane); zv[i] = *(const GAS v4u*)(Z + (size_t)t * NZ + 2 * CW + 8 * lane); }
            else { zc[i] = (v4u){0u, 0u, 0u, 0u}; zv[i] = (v4u){0u, 0u, 0u, 0u}; } }
#pragma unroll
        for (int i = 0; i < CH; ++i) zb[i] = *(const GAS v4u*)(Z + (size_t)(t0 + i) * NZ + 8 * lane);
        float prev[8], cur[8], nxt[8];
#define CV_OF(dst, cc, vv) do { dst[0] = bflo(cc.x) * bflo(vv.x); dst[1] = bfhi(cc.x) * bfhi(vv.x); dst[2] = bflo(cc.y) * bflo(vv.y); dst[3] = bfhi(cc.y) * bfhi(vv.y); \
            dst[4] = bflo(cc.z) * bflo(vv.z); dst[5] = bfhi(cc.z) * bfhi(vv.z); dst[6] = bflo(cc.w) * bflo(vv.w); dst[7] = bfhi(cc.w) * bfhi(vv.w); } while (0)
        CV_OF(prev, zc[0], zv[0]);
        CV_OF(cur, zc[1], zv[1]);
#pragma unroll
        for (int i = 0; i < CH; ++i) {
            const int t = t0 + i;
            CV_OF(nxt, zc[i + 2], zv[i + 2]);
            const v4u bb = zb[i];
            float bg[8] = {bflo(bb.x), bfhi(bb.x), bflo(bb.y), bfhi(bb.y), bflo(bb.z), bfhi(bb.z), bflo(bb.w), bfhi(bb.w)};
            float y[8]; float ss = 0.f;
#pragma unroll
            for (int j = 0; j < 8; ++j) { y[j] = bg[j] * (w0[j] * prev[j] + w1[j] * cur[j] + w2[j] * nxt[j]); ss += y[j] * y[j]; }
            const float rs = 1.0f / sqrtf(wave_sum(ss) * (1.f / CW) + EPS);
            v4u o; o.x = pk2(y[0] * rs, y[1] * rs); o.y = pk2(y[2] * rs, y[3] * rs); o.z = pk2(y[4] * rs, y[5] * rs); o.w = pk2(y[6] * rs, y[7] * rs);
            *(GAS v4u*)(Y + (size_t)t * D + 8 * lane) = o;
#pragma unroll
            for (int j = 0; j < 8; ++j) { prev[j] = cur[j]; cur[j] = nxt[j]; }
        }
#undef CV_OF
    }
}
__device__ __forceinline__ void absorb_phase(Frame& F) {
    const bf16* KB = (const bf16*)(F.ws + WS_KB); const bf16* VB = (const bf16*)(F.ws + WS_VT); const bf16* WQN = (const bf16*)(F.ws + WS_WQN); const bf16* WOT = (const bf16*)(F.ws + WS_WOT16);
    const int lane = F.lane(), w = F.wave, li = lane & 15, q = lane >> 4;
    for (int unit = F.vcu; unit < 256; unit += F.G) {
        const int type = unit >> 7, bh = (unit >> 4) & 7, slab = unit & 15, b = bh >> 2, h = bh & 3;
        const bf16* Xp; const bf16* Yp; unsigned char* outp; int itf, jtf, dit, djt;
        if (type == 0) { Xp = WQN + (size_t)(64 * slab) * D + h * HD; Yp = KB + (size_t)(b * MEMLEN) * D + h * HD;
            outp = F.ws + WS_MK + (size_t)b * MiB + (size_t)(h * HD) * D + 64 * slab; itf = w & 3; dit = 0; jtf = (w >> 2) * 8; djt = 1; }
        else { Xp = VB + (size_t)(b * MEMLEN) * D + h * HD; Yp = WOT + (size_t)(64 * slab) * D + h * HD;
            outp = F.ws + WS_MV + (size_t)b * MiB + (size_t)(64 * slab) * D + h * HD; jtf = w & 3; djt = 0; itf = (w >> 2) * 8; dit = 1; }
#pragma unroll 2
        for (int t = 0; t < 8; ++t) { const int it = itf + dit * t, jt = jtf + djt * t;
            const bf16* xr = Xp + (size_t)(it * 16 + li) * D + 8 * q; const bf16* yr = Yp + (size_t)(jt * 16 + li) * D + 8 * q;
            bf16x8v xf[8], yf[8];
#pragma unroll
            for (int ks = 0; ks < 8; ++ks) { xf[ks] = *(const GAS bf16x8v*)(xr + 32 * ks); yf[ks] = *(const GAS bf16x8v*)(yr + 32 * ks); }
            f32x4 acc = {0.f, 0.f, 0.f, 0.f};
#pragma unroll
            for (int ks = 0; ks < 8; ++ks) acc = __builtin_amdgcn_mfma_f32_16x16x32_bf16(xf[ks], yf[ks], acc, 0, 0, 0);
            *(GAS unsigned*)(outp + (size_t)(jt * 16 + li) * D + it * 16 + 4 * q) = pg8::pk4_fp8(acc[0] * WSCALE, acc[1] * WSCALE, acc[2] * WSCALE, acc[3] * WSCALE); }
    }
}
__device__ __forceinline__ void fftC_phase(Frame& F) {
    const bf16* G = (const bf16*)(F.ws + WS_G); bf16* Y = (bf16*)(F.ws + WS_Y); const bf16* MC = (const bf16*)(F.ws + WS_MC); const bf16* DCH = (const bf16*)(F.ws + WS_TAB + TAB_DCH);
    const int tid = F.tid(), lane = F.lane(), w = F.wave, tt = w & 3, ch = w >> 2, g = lane >> 4, q = (lane & 15) >> 2, p = lane & 3;
    const float scale = 1.0f / sqrtf((float)SEQ * 64.0f);
    LAS float* ex = (LAS float*)(F.lds + 128 * FC_P);
    for (int unit = F.vcu; unit < BATCH * FN1; unit += F.G) {
        const int b = unit >> 7, s1p = unit & 127;
        __syncthreads();
        const bf16* Gt = G + (size_t)(b * FN1 + s1p) * (FN2 * 2) * CW;
#pragma unroll
        for (int i = 0; i < 16; ++i) { const int idx = i * NTHR + tid, row = idx >> 6, piece = idx & 63;
            const v4u v = *(const GAS v4u*)(Gt + (size_t)row * CW + 8 * piece);
            *(LAS v4u*)(F.lds + row * FC_P + piece * 16) = v; }
        __syncthreads();
        bf16x8v Bre[4], Bim[4];
#pragma unroll
        for (int ks = 0; ks < 4; ++ks) { const bf16* mp = MC + ((size_t)s1p * 128 + 16 * tt + (lane & 15)) * 128 + 32 * ks + 8 * (lane >> 4);
            Bre[ks] = *(const GAS bf16x8v*)mp; Bim[ks] = *(const GAS bf16x8v*)(mp + 64 * 128); }
        bf16x8v dfr[4][2][2];
#pragma unroll
        for (int ct = 0; ct < 4; ++ct)
#pragma unroll
            for (int pp = 0; pp < 2; ++pp)
#pragma unroll
                for (int hc = 0; hc < 2; ++hc) dfr[ct][pp][hc] = *(const GAS bf16x8v*)(DCH + ((((pp * 2 + hc) * 64 + 16 * ct + (lane & 15)) * 4 + (lane >> 4)) * 8));
        v2u y[4][4]; float ssq = 0.f;
#pragma unroll
        for (int g4 = 0; g4 < 4; ++g4) {
            f32x4 are[4], aim[4];
#pragma unroll
            for (int nt = 0; nt < 4; ++nt) { are[nt] = (f32x4){0.f, 0.f, 0.f, 0.f}; aim[nt] = (f32x4){0.f, 0.f, 0.f, 0.f};
#pragma unroll
                for (int ks = 0; ks < 4; ++ks) { const bf16x8v af = tr_pair(F.lds + (32 * ks + 8 * g + q) * FC_P + (256 * ch + 64 * g4 + 16 * nt) * 2 + 8 * p, 4 * FC_P);
                    are[nt] = __builtin_amdgcn_mfma_f32_16x16x32_bf16(af, Bre[ks], are[nt], 0, 0, 0);
                    aim[nt] = __builtin_amdgcn_mfma_f32_16x16x32_bf16(af, Bim[ks], aim[nt], 0, 0, 0); } }
            bf16x8v xf[2][2];
#pragma unroll
            for (int hc = 0; hc < 2; ++hc) {
                { v4u t; t.x = pk2(are[2 * hc][0], are[2 * hc][1]); t.y = pk2(are[2 * hc][2], are[2 * hc][3]); t.z = pk2(are[2 * hc + 1][0], are[2 * hc + 1][1]); t.w = pk2(are[2 * hc + 1][2], are[2 * hc + 1][3]); xf[0][hc] = __builtin_bit_cast(bf16x8v, t); }
                { v4u t; t.x = pk2(aim[2 * hc][0], aim[2 * hc][1]); t.y = pk2(aim[2 * hc][2], aim[2 * hc][3]); t.z = pk2(aim[2 * hc + 1][0], aim[2 * hc + 1][1]); t.w = pk2(aim[2 * hc + 1][2], aim[2 * hc + 1][3]); xf[1][hc] = __builtin_bit_cast(bf16x8v, t); }
            }
#pragma unroll
            for (int ct = 0; ct < 4; ++ct) { f32x4 ya = {0.f, 0.f, 0.f, 0.f};
#pragma unroll
                for (int pp = 0; pp < 2; ++pp)
#pragma unroll
                    for (int hc = 0; hc < 2; ++hc) ya = __builtin_amdgcn_mfma_f32_16x16x32_bf16(dfr[ct][pp][hc], xf[pp][hc], ya, 0, 0, 0);
                ya = ya * scale; y[g4][ct].x = pk2(ya[0], ya[1]); y[g4][ct].y = pk2(ya[2], ya[3]); ssq += (ya[0] * ya[0] + ya[1] * ya[1]) + (ya[2] * ya[2] + ya[3] * ya[3]); }
        }
        ssq += __shfl_xor(ssq, 16); ssq += __shfl_xor(ssq, 32);
        if (lane < 16) ex[w * 16 + lane] = ssq;
        __syncthreads();
        const float tot = ex[w * 16 + (lane & 15)] + ex[(w ^ 4) * 16 + (lane & 15)];
        const float rf = 1.0f / sqrtf(tot * (1.f / CW) + EPS);
        const int t = b * SEQ + s1p + 128 * (16 * tt + (lane & 15));
        bf16* yp = Y + (size_t)t * D + CW + 256 * ch + 4 * (lane >> 4);
#pragma unroll
        for (int g4 = 0; g4 < 4; ++g4)
#pragma unroll
            for (int ct = 0; ct < 4; ++ct) { const v2u p = y[g4][ct]; v2u o; o.x = pk2(bflo(p.x) * rf, bfhi(p.x) * rf); o.y = pk2(bflo(p.y) * rf, bfhi(p.y) * rf); *(GAS v2u*)(yp + 64 * g4 + 16 * ct) = o; }
    }
}
typedef float f32x16 __attribute__((ext_vector_type(16)));
constexpr int AT_P = 528;
__device__ __forceinline__ void attn_phase(Frame& F) {
    const bf16* Q = (const bf16*)(F.ws + WS_Q); const bf16* KB = (const bf16*)(F.ws + WS_KB); const bf16* VT = (const bf16*)(F.ws + WS_VT); unsigned char* O = F.ws + WS_O;
    const int tid = F.tid(), lane = F.lane(), w = F.wave, r = lane & 31, h = lane >> 5, pr = (r & ~12) | ((r & 4) << 1) | ((r & 8) >> 1);
    for (int unit = F.vcu; unit < BATCH * NH * (SEQ / 256); unit += F.G) {
        const int bh = unit >> 5, qt = unit & 31, b = bh >> 2, hh = bh & 3;
        const int t0 = b * SEQ + qt * 256 + 32 * w;
        bf16x8v qf[16];
#pragma unroll
        for (int ds = 0; ds < 16; ++ds) qf[ds] = *(const GAS bf16x8v*)(Q + (size_t)(t0 + r) * D + hh * HD + 16 * ds + 8 * h);
        __syncthreads();
#pragma unroll
        for (int i = 0; i < 16; ++i) { const int idx = i * NTHR + tid, row = idx >> 5, piece = idx & 31;
            const v4u v = *(const GAS v4u*)(KB + (size_t)(b * MEMLEN + row) * D + hh * HD + 8 * piece);
            *(LAS v4u*)(F.lds + row * AT_P + piece * 16) = v; }
        __syncthreads();
        f32x16 sacc[8];
#pragma unroll
        for (int kt = 0; kt < 8; ++kt) {
#pragma unroll
            for (int i = 0; i < 16; ++i) sacc[kt][i] = 0.f;
#pragma unroll
            for (int ds = 0; ds < 16; ++ds) { const bf16x8v kf = *(const LAS bf16x8v*)(F.lds + (32 * kt + pr) * AT_P + (16 * ds + 8 * h) * 2);
                sacc[kt] = __builtin_amdgcn_mfma_f32_32x32x16_bf16(kf, qf[ds], sacc[kt], 0, 0, 0); }
        }
        float mx = -INFINITY;
#pragma unroll
        for (int kt = 0; kt < 8; ++kt)
#pragma unroll
            for (int i = 0; i < 16; ++i) mx = fmaxf(mx, sacc[kt][i]);
        mx = fmaxf(mx, __shfl_xor(mx, 32));
        float sum = 0.f; bf16x8v pf[8][2];
#pragma unroll
        for (int kt = 0; kt < 8; ++kt)
#pragma unroll
            for (int s2 = 0; s2 < 2; ++s2) { float pv[8];
#pragma unroll
                for (int j = 0; j < 8; ++j) { pv[j] = __builtin_amdgcn_exp2f(sacc[kt][8 * s2 + j] - mx); sum += pv[j]; }
                v4u t; t.x = pk2(pv[0], pv[1]); t.y = pk2(pv[2], pv[3]); t.z = pk2(pv[4], pv[5]); t.w = pk2(pv[6], pv[7]); pf[kt][s2] = __builtin_bit_cast(bf16x8v, t); }
        sum += __shfl_xor(sum, 32);
        const float inv = 1.0f / sum;
        __syncthreads();
#pragma unroll
        for (int i = 0; i < 16; ++i) { const int idx = i * NTHR + tid, row = idx >> 5, piece = idx & 31;
            const v4u v = *(const GAS v4u*)(VT + (size_t)(hh * HD + row) * MKV + b * MEMLEN + 8 * piece);
            *(LAS v4u*)(F.lds + row * AT_P + piece * 16) = v; }
        __syncthreads();
        unsigned char* op = O + (size_t)(t0 + r) * D + hh * HD + 4 * h;
#pragma unroll
        for (int dt = 0; dt < 8; ++dt) { f32x16 oacc;
#pragma unroll
            for (int i = 0; i < 16; ++i) oacc[i] = 0.f;
#pragma unroll
            for (int kt = 0; kt < 8; ++kt)
#pragma unroll
                for (int s2 = 0; s2 < 2; ++s2) { const bf16x8v vf = *(const LAS bf16x8v*)(F.lds + (32 * dt + r) * AT_P + (32 * kt + 16 * s2 + 8 * h) * 2);
                    oacc = __builtin_amdgcn_mfma_f32_32x32x16_bf16(vf, pf[kt][s2], oacc, 0, 0, 0); }
#pragma unroll
            for (int i = 0; i < 4; ++i) *(GAS unsigned*)(op + 32 * dt + 8 * i) = pg8::pk4_fp8(oacc[4 * i] * inv, oacc[4 * i + 1] * inv, oacc[4 * i + 2] * inv, oacc[4 * i + 3] * inv);
        }
    }
}
constexpr int RT_P = 2064;
constexpr int RT_LO = 32 * RT_P, RT_PART = 2 * 32 * RT_P, RT_SQP = RT_PART + 8192, RT_RSB = RT_SQP + 256, RT_HIST = RT_RSB + 256, RT_BASE = RT_HIST + 128;
static_assert(RT_BASE + 128 <= MOE_TAB_OFF, "router LDS map");
__device__ __forceinline__ void router_phase(Frame& F, const Args& a, int blk0, unsigned long long* gs1) {
    const bf16* XR = (const bf16*)(F.ws + WS_XR); unsigned char* XN3 = F.ws + WS_XN3; const float* wrgT = (const float*)(F.ws + WS_WRG);
    int* tok_e = (int*)(F.ws + WS_TOK); float* tok_w = (float*)(F.ws + WS_TOK + 256 * 1024); int* tok_rank = (int*)(F.ws + WS_TOK + 512 * 1024);
    int* etok = (int*)(F.ws + WS_ETOK); unsigned* ctl = (unsigned*)(F.ws + WS_CTL);
    const int tid = F.tid(), lane = F.lane(), w = F.wave, tt = w & 3, kh = w >> 2, li = lane & 15, kq = lane >> 4;
    LAS float* part = (LAS float*)(F.lds + RT_PART); LAS float* sqp = (LAS float*)(F.lds + RT_SQP); LAS float* rsb = (LAS float*)(F.lds + RT_RSB);
    LAS unsigned* hist = (LAS unsigned*)(F.lds + RT_HIST); LAS unsigned* base = (LAS unsigned*)(F.lds + RT_BASE);
    const float* gain = a.in[14]; const float* brt = a.in[16];
    __syncthreads();
#pragma unroll
    for (int i = 0; i < 16; ++i) { const int idx = i * NTHR + tid, e = idx >> 8, piece = idx & 255;
        const f32x4 v = *(const GAS f32x4*)(wrgT + (size_t)e * D + 4 * piece);
        v2u hi; hi.x = pk2(v.x, v.y); hi.y = pk2(v.z, v.w);
        v2u lo; lo.x = pk2(v.x - bflo(hi.x), v.y - bfhi(hi.x)); lo.y = pk2(v.z - bflo(hi.y), v.w - bfhi(hi.y));
        *(LAS v2u*)(F.lds + e * RT_P + piece * 8) = hi; *(LAS v2u*)(F.lds + RT_LO + e * RT_P + piece * 8) = lo; }
    if (tid < NE) hist[tid] = 0u;
    if (gs1) group_sync(ctl + CW_BAR, gs1, (unsigned*)gs1 + 2, F.wave == 0 && lane_id() == 0);
    f32x4 gv[4];
#pragma unroll
    for (int j = 0; j < 4; ++j) gv[j] = ((const GAS f32x4*)gain + lane)[64 * j];
    for (int blk = blk0; blk < M / 64; blk += F.G) {
        __syncthreads();
        const int t = blk * 64 + 16 * tt + li;
        f32x4 acc[2]; acc[0] = (f32x4){0.f, 0.f, 0.f, 0.f}; acc[1] = (f32x4){0.f, 0.f, 0.f, 0.f}; float ssq = 0.f;
        const bf16* xp = XR + (size_t)t * D + 512 * kh + 8 * kq;
        bf16x8v xb[16];
#pragma unroll
        for (int ks = 0; ks < 16; ++ks) xb[ks] = *(const GAS bf16x8v*)(xp + 32 * ks);
        v2u xw[8][4];
#pragma unroll
        for (int i = 0; i < 8; ++i) { const GAS v2u* xr = (const GAS v2u*)(XR + (size_t)(blk * 64 + 8 * w + i) * D) + lane;
#pragma unroll
            for (int j = 0; j < 4; ++j) xw[i][j] = xr[64 * j]; }
#pragma unroll
        for (int ks = 0; ks < 16; ++ks) {
            { const v4u u4 = __builtin_bit_cast(v4u, xb[ks]); const float x0 = bflo(u4.x), x1 = bfhi(u4.x), x2 = bflo(u4.y), x3 = bfhi(u4.y), x4 = bflo(u4.z), x5 = bfhi(u4.z), x6 = bflo(u4.w), x7 = bfhi(u4.w);
              ssq += ((x0 * x0 + x1 * x1) + (x2 * x2 + x3 * x3)) + ((x4 * x4 + x5 * x5) + (x6 * x6 + x7 * x7)); }
#pragma unroll
            for (int mt = 0; mt < 2; ++mt) { const int off = (16 * mt + li) * RT_P + (512 * kh + 32 * ks + 8 * kq) * 2;
                const bf16x8v whi = *(const LAS bf16x8v*)(F.lds + off), wlo = *(const LAS bf16x8v*)(F.lds + RT_LO + off);
                acc[mt] = __builtin_amdgcn_mfma_f32_16x16x32_bf16(whi, xb[ks], acc[mt], 0, 0, 0);
                acc[mt] = __builtin_amdgcn_mfma_f32_16x16x32_bf16(wlo, xb[ks], acc[mt], 0, 0, 0); }
        }
        ssq += __shfl_xor(ssq, 16); ssq += __shfl_xor(ssq, 32);
        if (kh == 1) {
#pragma unroll
            for (int mt = 0; mt < 2; ++mt)
#pragma unroll
                for (int rg = 0; rg < 4; ++rg) part[(tt * 32 + 16 * mt + 4 * kq + rg) * 16 + li] = acc[mt][rg];
            if (lane < 16) sqp[tt * 16 + lane] = ssq;
        }
        __syncthreads();
        int my_e = 0; float my_w = 0.f; unsigned my_lr = 0u;
        if (kh == 0) {
            const float rs = 1.0f / sqrtf((ssq + sqp[tt * 16 + li]) * (1.f / D) + EPS);
            if (kq == 0) rsb[16 * tt + li] = rs;
            float val[8];
#pragma unroll
            for (int mt = 0; mt < 2; ++mt)
#pragma unroll
                for (int rg = 0; rg < 4; ++rg) { const int e = 16 * mt + 4 * kq + rg; val[4 * mt + rg] = (acc[mt][rg] + part[(tt * 32 + e) * 16 + li]) * rs + brt[e]; }
            float sv[4]; int se[4];
#pragma unroll
            for (int k = 0; k < TOPK; ++k) {
                float bv = val[0]; int be = 4 * kq;
#pragma unroll
                for (int i = 1; i < 8; ++i) { const int e = 16 * (i >> 2) + 4 * kq + (i & 3); if (val[i] > bv) { bv = val[i]; be = e; } }
#pragma unroll
                for (int o = 16; o < 64; o <<= 1) { const float ov = __shfl_xor(bv, o); const int oe = __shfl_xor(be, o); if (ov > bv || (ov == bv && oe < be)) { bv = ov; be = oe; } }
                sv[k] = bv; se[k] = be;
#pragma unroll
                for (int i = 0; i < 8; ++i) { const int e = 16 * (i >> 2) + 4 * kq + (i & 3); if (e == be) val[i] = -INFINITY; }
            }
            float wk[4]; float wsum = 0.f;
#pragma unroll
            for (int k = 0; k < TOPK; ++k) { wk[k] = __expf(sv[k] - sv[0]); wsum += wk[k]; }
            my_e = (kq == 0) ? se[0] : (kq == 1) ? se[1] : (kq == 2) ? se[2] : se[3];
            my_w = ((kq == 0) ? wk[0] : (kq == 1) ? wk[1] : (kq == 2) ? wk[2] : wk[3]) / wsum;
            my_lr = __hip_atomic_fetch_add(hist + my_e, 1u, __ATOMIC_RELAXED, __HIP_MEMORY_SCOPE_WORKGROUP);
        }
        __syncthreads();
        unsigned basev = 0u;
        if (tid < NE) { const unsigned c = hist[tid]; basev = c ? __hip_atomic_fetch_add(ctl + CW_CNT + 64 * tid, c, RLX_AGENT) : 0u; hist[tid] = 0u; }
#pragma unroll
        for (int i = 0; i < 8; ++i) { const int tk = blk * 64 + 8 * w + i; const float rs = rsb[8 * w + i]; GAS unsigned* o4 = (GAS unsigned*)(XN3 + (size_t)tk * D) + lane;
#pragma unroll
            for (int j = 0; j < 4; ++j) { const v2u x2 = xw[i][j]; const f32x4 g = gv[j];
                o4[64 * j] = pg8::pk4_fp8(bflo(x2.x) * rs * g.x, bfhi(x2.x) * rs * g.y, bflo(x2.y) * rs * g.z, bfhi(x2.y) * rs * g.w); } }
        if (tid < NE) base[tid] = basev;
        __syncthreads();
        if (kh == 0) { const unsigned rank = base[my_e] + my_lr;
            tok_e[t * 4 + kq] = my_e; tok_w[t * 4 + kq] = my_w; tok_rank[t * 4 + kq] = (int)rank; etok[(size_t)my_e * ECAP + rank] = t; }
    }
}
__device__ __forceinline__ int moe_tables(Frame& F) {
    LAS int* tile_e = (LAS int*)(F.lds + MOE_TAB_OFF); LAS int* tile0 = tile_e + 320; LAS int* cnt = tile0 + 40;
    const unsigned* ctl = (const unsigned*)(F.ws + WS_CTL);
    __syncthreads();
    if (F.tid() < NE) cnt[F.tid()] = (int)__hip_atomic_load(ctl + CW_CNT + 64 * F.tid(), RLX_AGENT);
    __syncthreads();
    if (F.tid() == 0) { int acc = 0; for (int e = 0; e < NE; ++e) { tile0[e] = acc; acc += (cnt[e] + 255) >> 8; } tile0[NE] = acc; }
    __syncthreads();
    const int R = tile0[NE];
    for (int rt = F.tid(); rt < R; rt += NTHR) { int e = 0; for (int q = 0; q < NE; ++q) if (rt >= tile0[q] && rt < tile0[q + 1]) e = q; tile_e[rt] = e; }
    __syncthreads();
    return R;
}
__device__ __forceinline__ void combine_phase(Frame& F, const Args& a) {
    const bf16* XR = (const bf16*)(F.ws + WS_XR); const unsigned char* CTR = F.ws + WS_CTR;
    const int* tok_e = (const int*)(F.ws + WS_TOK); const float* tok_w = (const float*)(F.ws + WS_TOK + 256 * 1024); const int* tok_rank = (const int*)(F.ws + WS_TOK + 512 * 1024);
    LAS int* tile0 = (LAS int*)(F.lds + MOE_TAB_OFF) + 320;
    const int gw = F.vcu * NWAVES + F.wave, NGW = F.G * NWAVES, lane = F.lane();
    const float* gain = a.in[21];
    constexpr int TPW = 8;
    const GAS f32x4* gr = (const GAS f32x4*)gain; const f32x4 gv[4] = {gr[2 * lane], gr[2 * lane + 1], gr[128 + 2 * lane], gr[128 + 2 * lane + 1]};
    for (int tb = gw * TPW; tb < M; tb += NGW * TPW) {
        int myslot = 0; float myw = 0.f;
        if (lane < 4 * TPW) { const int q = (tb + (lane >> 2)) * 4 + (lane & 3); const int e = tok_e[q]; myw = tok_w[q]; myslot = tile0[e] * 256 + tok_rank[q]; }
#pragma unroll 4
        for (int i = 0; i < TPW; ++i) {
            const int t = tb + i;
            const GAS v4u* xr = (const GAS v4u*)(XR + (size_t)t * D);
            v4u xw[2]; v2u cw[4][2]; float wk[4];
            xw[0] = xr[lane]; xw[1] = xr[64 + lane];
#pragma unroll
            for (int k = 0; k < TOPK; ++k) { const int slot = __builtin_amdgcn_readlane(myslot, 4 * i + k); wk[k] = __builtin_bit_cast(float, __builtin_amdgcn_readlane(__builtin_bit_cast(int, myw), 4 * i + k));
                const GAS v2u* cp = (const GAS v2u*)(CTR + (size_t)slot * D); cw[k][0] = cp[lane]; cw[k][1] = cp[64 + lane]; }
            f32x4 v[4]; float s = 0.f;
#pragma unroll
            for (int h = 0; h < 2; ++h) { v[2 * h] = (f32x4){bflo(xw[h].x), bfhi(xw[h].x), bflo(xw[h].y), bfhi(xw[h].y)}; v[2 * h + 1] = (f32x4){bflo(xw[h].z), bfhi(xw[h].z), bflo(xw[h].w), bfhi(xw[h].w)};
#pragma unroll
                for (int k = 0; k < TOPK; ++k) {
#pragma unroll
                    for (int u = 0; u < 2; ++u) { const int cwd = (int)(u ? cw[k][h].y : cw[k][h].x); const f32x2v lo = __builtin_amdgcn_cvt_pk_f32_fp8(cwd, false), hi = __builtin_amdgcn_cvt_pk_f32_fp8(cwd, true);
                        v[2 * h + u].x += wk[k] * lo.x; v[2 * h + u].y += wk[k] * lo.y; v[2 * h + u].z += wk[k] * hi.x; v[2 * h + u].w += wk[k] * hi.y; } }
#pragma unroll
                for (int u = 0; u < 2; ++u) s += (v[2 * h + u].x * v[2 * h + u].x + v[2 * h + u].y * v[2 * h + u].y) + (v[2 * h + u].z * v[2 * h + u].z + v[2 * h + u].w * v[2 * h + u].w); }
            const float rs = 1.0f / sqrtf(wave_sum(s) * (1.f / D) + EPS);
            GAS f32x4* op = (GAS f32x4*)(a.out + (size_t)t * D);
#pragma unroll
            for (int h = 0; h < 2; ++h)
#pragma unroll
                for (int u = 0; u < 2; ++u) { const f32x4 g = gv[2 * h + u], w4 = v[2 * h + u]; op[128 * h + 2 * lane + u] = (f32x4){w4.x * rs * g.x, w4.y * rs * g.y, w4.z * rs * g.z, w4.w * rs * g.w}; }
        }
    }
}

struct MoeSel { int nM, lo, start, stride, limit, xhas, xnM, xlo, xslot; };
__device__ __forceinline__ bool moe_plan(int R, int G, int y, int w, int which, MoeSel& s) {
    if (G != 256 || R <= 256 || R > 288) return false;
    int NI = 0, pre = 0; bool bad = false;
#pragma unroll
    for (int yy = 0; yy < 8; ++yy) { const int l0 = (yy * R) >> 3, nj = (((yy + 1) * R) >> 3) - l0, left = 8 * nj - 256;
        bad = bad || left < 0 || left > 32; NI += 32 - left; pre += (yy < y) ? 32 - left : 0; }
    if (bad || NI < 4 * R - 1024) return false;
    if (which < 0) return true;
    const int l0 = (y * R) >> 3, nj = (((y + 1) * R) >> 3) - l0, left = 8 * nj - 256;
    s.nM = nj; s.lo = l0; s.start = w; s.stride = 32; s.xhas = 0; s.xnM = 0; s.xlo = 0; s.xslot = 0;
    if (which == 0) { s.limit = 8 * nj; return true; }
    s.limit = 128;
    if (w >= left) { int e = pre + (w - left); bool found = false;
#pragma unroll
        for (int yy = 0; yy < 8; ++yy) { const int m0 = (yy * R) >> 3, mj = (((yy + 1) * R) >> 3) - m0, Ex = 4 * mj - 128;
            if (!found) { if (e < Ex) { found = true; s.xhas = 1; s.xnM = mj; s.xlo = m0; s.xslot = 128 + e; } else e -= Ex; } } }
    return true;
}

constexpr int NPHASE = 14;
__global__ void __launch_bounds__(NTHR, 2) mk_fwd(Args args) {
    extern __shared__ __attribute__((aligned(16))) unsigned char lds[];
    Frame F;
    F.lds = (LAS unsigned char*)lds; F.ws = args.ws;
    F.wave = __builtin_amdgcn_readfirstlane((int)threadIdx.x >> 6);
    F.G = gridDim.x; { const int bx = blockIdx.x; F.vcu = (F.G % 8 == 0) ? (bx % 8) * (F.G / 8) + bx / 8 : bx; }
    unsigned char* ws = args.ws;
    for (int u = F.tid(); u < (LDS_BYTES - LDSCTL_OFF) / 4; u += NTHR) ((LAS unsigned*)(F.lds + LDSCTL_OFF))[u] = 0u;
    __syncthreads();
    volatile LAS unsigned* MISC = (volatile LAS unsigned*)(F.lds + MISC_OFF);
    XcdBarrier bar; bar.bar = (unsigned*)(ws + WS_CTL) + CW_BAR; bar.x = 0; bar.st = nullptr;
#if MK_ONE_LAUNCH
    bar = xcd_barrier_post((unsigned*)(ws + WS_CTL) + CW_BAR, MISC + 8, F.wave == 0 && lane_id() == 0);
#define GRID_BAR() xcd_barrier(bar, F.wave == 0 && lane_id() == 0)
#else
#define GRID_BAR() do { } while (0)
#endif
    const int lo = args.ph_lo, hi = args.ph_hi;
#define IN(k) (lo <= (k) && (k) < hi)
#define REP(k) for (int _rep = 0; _rep < (((MK_DUP) >> (k)) & 1) + 1; ++_rep)
#define SEAM(k) do { if (IN(k) && IN((k) + 1)) GRID_BAR(); } while (0)
    int gpm = 0, gpn = 0; const bool lsync = MK_ONE_LAUNCH && (F.G == (M / 256) * (D / 256));
    if (lsync) { pg8::StaticOrder S0; S0.init(M, D, F.G, (int)blockIdx.x); pg8::Unit u0; (void)S0.next(0, u0); gpm = u0.pm; gpn = u0.pn; }
#define GSW(s) ((unsigned long long*)((unsigned*)(ws + WS_CTL) + CW_GRP + 64 * (64 * (s) + gpm)))
#define LSEAM(k, s) do { if (IN(k) && IN((k) + 1)) { if (lsync) group_sync((unsigned*)(ws + WS_CTL) + CW_BAR, GSW(s), (unsigned*)GSW(s) + 2, F.wave == 0 && lane_id() == 0); else GRID_BAR(); } } while (0)
    using pg8::Gemm; using pg8::StaticOrder; using pg8::GroupedOrder; using pg8::gemm_phase; using pg8::bf16_t; using pg8::EpiBf16; using pg8::EpiRowScaleBf16; using pg8::EpiResidIn; using pg8::EpiResidBf; using pg8::EpiSwiGLU; using pg8::EpiBiasF8; using pg8::EpiSoftmaxF8;
    if (IN(0)) REP(0) { p0_prologue(F, args); } SEAM(0);
    if (IN(1)) REP(1) { Gemm g{(const bf16_t*)(ws + WS_XN), (const bf16_t*)(ws + WS_WINT), D, 0}; StaticOrder S; S.init(M, NZ, F.G, (int)blockIdx.x);
        const bool split = (F.G % 16) == 0; const int grp = split ? (((int)blockIdx.x >> 3) & 1) : 0, ng = split ? F.G / 2 : F.G;
        const int gi = split ? (((int)blockIdx.x >> 4) * 8 + ((int)blockIdx.x & 7)) : (int)blockIdx.x, mlo = (split && grp) ? MOE_ITEMS / 2 : 0, mhi = (split && !grp) ? MOE_ITEMS / 2 : MOE_ITEMS;
        if (grp == 0) { p0_moe_stream(F, args, mlo, mhi, gi * NWAVES + F.wave, ng * NWAVES); __syncthreads(); }
        EpiBf16 E{(bf16_t*)(ws + WS_Z), NZ, 1.0f}; gemm_phase<EpiBf16, StaticOrder, true>(F.lds, g, S, E, F.wave);
        if (grp == 1) { __syncthreads(); p0_moe_stream(F, args, mlo, mhi, gi * NWAVES + F.wave, ng * NWAVES); } } SEAM(1);
    if (IN(3)) REP(3) {
        const bool split = F.G >= 64;
        if (!split || blockIdx.x < 16) {
            { Gemm g{(const bf16_t*)(ws + WS_MEMN), (const bf16_t*)(ws + WS_WKT), D / 2, 0}; StaticOrder S; S.init(MKV, D, F.G, (int)blockIdx.x);
              EpiBf16 E{(bf16_t*)(ws + WS_KB), D, 1.0f / WSCALE}; gemm_phase<EpiBf16, StaticOrder, true, true>(F.lds, g, S, E, F.wave); }
            { Gemm g{(const bf16_t*)(ws + WS_MEMN), (const bf16_t*)(ws + WS_WVT), D / 2, 0}; StaticOrder S; S.init(MKV, D, F.G, (int)((blockIdx.x + F.G - 8) % F.G));
              EpiBf16 E{(bf16_t*)(ws + WS_VT), D, 1.0f / WSCALE}; gemm_phase<EpiBf16, StaticOrder, true, true>(F.lds, g, S, E, F.wave); }
        }
        if (!split) conv_phase(F, args, F.vcu, F.G); else if (blockIdx.x >= 16) conv_phase(F, args, (int)blockIdx.x - 16, F.G - 16);
        fftA_phase(F); } SEAM(3);
    if (IN(4)) REP(4) { absorb_phase(F); fftC_phase(F); } SEAM(4);
    if (IN(6)) REP(6) { Gemm g{(const bf16_t*)(ws + WS_Y), (const bf16_t*)(ws + WS_WOUTT), D, 0}; StaticOrder S; S.init(M, D, F.G, (int)blockIdx.x);
        EpiResidIn E{args.in[0], (bf16_t*)(ws + WS_XR), ws + WS_XB, (float*)(ws + WS_CTL) + CW_ROWSQ, D}; gemm_phase<EpiResidIn, StaticOrder, false>(F.lds, g, S, E, F.wave); } LSEAM(6, 0);
    if (IN(7)) REP(7) { Gemm g{(const bf16_t*)(ws + WS_XB), (const bf16_t*)(ws + WS_MK), D / 2, MiB}; StaticOrder S; S.init(M, D, F.G, (int)blockIdx.x, 5);
        EpiSoftmaxF8 E{ws + WS_P, D, (const float*)(ws + WS_CTL) + CW_ROWSQ, 1.0f / D, EPS, QSCALE / WSCALE, (LAS float*)(F.lds + RING_BYTES)}; gemm_phase<EpiSoftmaxF8, StaticOrder, true, true>(F.lds, g, S, E, F.wave); } LSEAM(7, 1);
    if (IN(9)) REP(9) { Gemm g{(const bf16_t*)(ws + WS_P), (const bf16_t*)(ws + WS_MV), D / 2, MiB}; StaticOrder S; S.init(M, D, F.G, (int)blockIdx.x, 5);
        EpiResidBf E{(bf16_t*)(ws + WS_XR), D, 1.0f / (128.0f * WSCALE)}; gemm_phase<EpiResidBf, StaticOrder, false, true>(F.lds, g, S, E, F.wave); } if (!lsync) SEAM(9);
    if (IN(10)) REP(10) { router_phase(F, args, lsync ? 4 * gpm + gpn : F.vcu, (lsync && IN(9)) ? GSW(2) : nullptr); } SEAM(10);
    if (IN(11) || IN(12)) {
        const int R = moe_tables(F);
        LAS int* tile_e = (LAS int*)(F.lds + MOE_TAB_OFF);
        const int cy = (int)blockIdx.x & 7, cw = (int)blockIdx.x >> 3;
        bool df; { MoeSel m0; df = MK_ONE_LAUNCH && IN(11) && IN(12) && moe_plan(R, F.G, cy, cw, -1, m0); }
        unsigned* ctlw = (unsigned*)(ws + WS_CTL);
        if (IN(11)) { MoeSel ms = {0, 0, 0, 0, 0, 0, 0, 0, 0}; if (df) (void)moe_plan(R, F.G, cy, cw, 0, ms);
            GroupedOrder<true> S; S.nM = df ? ms.nM : R; S.nN = 2 * DE / 256; S.nwg = R * S.nN; S.G = F.G; S.c = (int)blockIdx.x; S.own = df ? 1 : 0; S.lo = ms.lo; S.start = ms.start; S.stride = ms.stride; S.limit = ms.limit;
            S.xhas = 0; S.xnM = 0; S.xlo = 0; S.xslot = 0; S.done = df ? ctlw + CW_DONE : nullptr; S.tmo = ctlw + CW_BAR + XB_TMO;
            S.tile_e = tile_e; S.tile0 = tile_e + 320; S.cnt = tile_e + 360; S.etok = (const int*)(ws + WS_ETOK); S.ecap = ECAP;
            { LAS int* rowtok = (LAS int*)(F.lds + RING_BYTES); pg8::Unit u;
              for (int ui = 0; ui < 12 && S.next(ui, u); ++ui) if (F.tid() < 256) { const int idx = (u.pm - S.tile0[u.e]) * 256 + F.tid(); rowtok[ui * 256 + F.tid()] = idx < S.cnt[u.e] ? S.etok[(size_t)u.e * ECAP + idx] : 0; }
              __syncthreads(); S.rowtok = rowtok; }
            Gemm g{(const bf16_t*)(ws + WS_XN3), (const bf16_t*)(ws + WS_WGUT), D / 2, WGU6_E};
            EpiSwiGLU E{ws + WS_ACT, args.in[18], 1.0f / W6SCALE, df}; gemm_phase<EpiSwiGLU, GroupedOrder<true>, true, 2>(F.lds, g, S, E, F.wave); }
        if (!df) SEAM(11);
        if (IN(12)) { MoeSel ms = {0, 0, 0, 0, 0, 0, 0, 0, 0}; if (df) (void)moe_plan(R, F.G, cy, cw, 1, ms);
            GroupedOrder<false> S; S.nM = df ? ms.nM : R; S.nN = D / 256; S.nwg = R * S.nN; S.G = F.G; S.c = (int)blockIdx.x; S.own = df ? 1 : 0; S.lo = ms.lo; S.start = ms.start; S.stride = ms.stride; S.limit = ms.limit;
            S.xhas = ms.xhas; S.xnM = ms.xnM; S.xlo = ms.xlo; S.xslot = ms.xslot; S.done = df ? ctlw + CW_DONE : nullptr; S.tmo = ctlw + CW_BAR + XB_TMO;
            S.tile_e = tile_e; S.tile0 = tile_e + 320; S.cnt = tile_e + 360; S.etok = nullptr; S.ecap = ECAP; S.rowtok = nullptr;
            Gemm g{(const bf16_t*)(ws + WS_ACT), (const bf16_t*)(ws + WS_WDT), DE / 2, WDN6_E};
            EpiBiasF8 E{ws + WS_CTR, args.in[20], 1.0f / W6SCALE}; gemm_phase<EpiBiasF8, GroupedOrder<false>, true, 2>(F.lds, g, S, E, F.wave); }
        SEAM(12);
    }
    if (IN(13)) REP(13) { (void)moe_tables(F); combine_phase(F, args); }
#undef IN
#undef SEAM
}

extern "C" void kernel_launch(void* const* d_in, const int* in_sizes, int n_in, void* d_out, int out_size, void* d_ws, size_t ws_size, hipStream_t stream) {
    static int grid = 0;
    if (grid == 0) {
        if (n_in != 22 || in_sizes[0] != M * D || out_size != M * D || ws_size < WS_END) { fprintf(stderr, "kernel_launch: unexpected problem (n_in %d, in0 %d, out %d, ws %zu)\n", n_in, n_in > 0 ? in_sizes[0] : -1, out_size, ws_size); grid = -1; return; }
        int dev = 0, cus = 0;
        if (hipGetDevice(&dev) != hipSuccess || hipDeviceGetAttribute(&cus, hipDeviceAttributeMultiprocessorCount, dev) != hipSuccess) { grid = -1; return; }
        if (hipFuncSetAttribute((const void*)mk_fwd, hipFuncAttributeMaxDynamicSharedMemorySize, LDS_BYTES) != hipSuccess) { fprintf(stderr, "kernel_launch: hipFuncSetAttribute failed\n"); grid = -1; return; }
        int per_cu = 0;
        if (hipOccupancyMaxActiveBlocksPerMultiprocessor(&per_cu, (const void*)mk_fwd, NTHR, LDS_BYTES) != hipSuccess || per_cu < 1) fprintf(stderr, "kernel_launch: occupancy query reports %d\n", per_cu);
        (void)hipGetLastError();
        grid = cus;
    }
    if (grid < 0) return;
    if (hipMemsetAsync((char*)d_ws + WS_CTL, 0, CTL_ZERO_BYTES, stream) != hipSuccess) return;
    Args a{};
    for (int i = 0; i < 22; ++i) a.in[i] = (const float*)d_in[i];
    a.out = (float*)d_out; a.ws = (unsigned char*)d_ws;
#if MK_ONE_LAUNCH
    a.ph_lo = 0; a.ph_hi = NPHASE;
    hipLaunchKernelGGL(mk_fwd, dim3(grid), dim3(NTHR), LDS_BYTES, stream, a);
#else
    for (int p = 0; p < NPHASE; ++p) { a.ph_lo = p; a.ph_hi = p + 1; hipLaunchKernelGGL(mk_fwd, dim3(grid), dim3(NTHR), LDS_BYTES, stream, a); }
#endif
}
```

```cpp
#include <hip/hip_runtime.h>
#include <cstdio>
#include <cstdint>

#ifndef MK_ONE_LAUNCH
#define MK_ONE_LAUNCH 1
#endif
#ifndef MK_DUP
#define MK_DUP 0
#endif

__device__ __forceinline__ int lane_id() { return (int)__builtin_amdgcn_mbcnt_hi(~0u, __builtin_amdgcn_mbcnt_lo(~0u, 0u)) & 63; }
namespace pg8 {
#define PG8_LAS __attribute__((address_space(3)))
typedef unsigned short bf16_t;
typedef short bf16x8 __attribute__((ext_vector_type(8)));
typedef float f32x4 __attribute__((ext_vector_type(4)));
typedef unsigned u32x4 __attribute__((ext_vector_type(4)));
typedef unsigned u32x2 __attribute__((ext_vector_type(2)));
constexpr int BM = 256, BK = 64, HALF = 128, HTB = HALF * BK * 2, STAGE_BYTES = 8 * HTB, NXCD = 8, WGM = 8;

__host__ __device__ __forceinline__ int lds_byte(int r, int c) { const int st = (r >> 4) * 2 + (c >> 5), rr = r & 15, cc = c & 31, ob = rr * 64 + cc * 2; return st * 1024 + (ob ^ (((ob >> 9) & 1) << 5)); }
__host__ __device__ __forceinline__ void stage_rc(int b, int& R, int& C) { const int st = b / 1024, sb = b % 1024, swz = sb ^ (((sb >> 9) & 1) << 5); R = (st >> 1) * 16 + swz / 64; C = (st & 1) * 32 + (swz % 64) / 2; }
__host__ __device__ __forceinline__ int perm32(int rho) { const int n = rho >> 4, i = rho & 15; return 8 * (i >> 2) + 4 * n + (i & 3); }

struct Unit { int pm, pn, e; };
struct Gemm { const bf16_t* A; const bf16_t* Bt; int K; size_t bstride; };

struct StaticOrder {
    static constexpr bool GATHER = false;
    int nM, nN, nwg, G, c, eshift;
    __device__ __forceinline__ void init(int M, int N, int G_, int c_, int eshift_ = -1) { nM = M / BM; nN = N / BM; nwg = nM * nN; G = G_; c = c_; eshift = eshift_; }
    __device__ __forceinline__ bool next(int i, Unit& u) const {
        const long L = (long)i * G + c; if (L >= nwg) return false;
        int wgid = (int)L; { const int q = nwg / NXCD, r = nwg % NXCD, xcd = wgid % NXCD, off = wgid / NXCD; wgid = (xcd < r ? xcd * (q + 1) : r * (q + 1) + (xcd - r) * q) + off; }
        const int nig = WGM * nN, gid = wgid / nig, fm = gid * WGM, gsz = (nM - fm) < WGM ? (nM - fm) : WGM;
        u.pm = fm + ((wgid % nig) % gsz); u.pn = (wgid % nig) / gsz; u.e = eshift >= 0 ? (u.pm >> eshift) : 0; return true;
    }
    __device__ __forceinline__ int arow(int, int) const { return 0; }
};
template <bool GATHER_>
struct GroupedOrder {
    static constexpr bool GATHER = GATHER_;
    int nM, nN, nwg, G, c;
    int own, lo, start, stride, limit, xhas, xnM, xlo, xslot;
    unsigned* done; unsigned* tmo;
    const PG8_LAS int* tile_e;
    const PG8_LAS int* tile0;
    const PG8_LAS int* cnt;
    const int* etok;
    int ecap;
    __device__ __forceinline__ bool next(int i, Unit& u) const {
        int wgid, nMl = nM, lol = 0;
        if (own) { const int s = start + i * stride;
            if (s < limit) { wgid = s; lol = lo; }
            else { const int nmain = start < limit ? (limit - start + stride - 1) / stride : 0; if (!xhas || i != nmain) return false; wgid = xslot; nMl = xnM; lol = xlo; } }
        else { const long L = (long)i * G + c; if (L >= nwg) return false;
            wgid = (int)L; { const int q = nwg / NXCD, r = nwg % NXCD, xcd = wgid % NXCD, off = wgid / NXCD; wgid = (xcd < r ? xcd * (q + 1) : r * (q + 1) + (xcd - r) * q) + off; } }
        const int nig = WGM * nN, gid = wgid / nig, fm = gid * WGM, gsz = (nMl - fm) < WGM ? (nMl - fm) : WGM;
        u.pm = lol + fm + ((wgid % nig) % gsz); u.pn = (wgid % nig) / gsz; u.e = tile_e[u.pm];
        if constexpr (!GATHER_) { if (done) { const unsigned* dp = done + 64 * u.pm; unsigned sp = 0;
            while (__hip_atomic_load(dp, __ATOMIC_RELAXED, __HIP_MEMORY_SCOPE_AGENT) < 8u) { __builtin_amdgcn_s_sleep(2); if ((++sp & 255u) == 0u && (__hip_atomic_load(tmo, __ATOMIC_RELAXED, __HIP_MEMORY_SCOPE_AGENT) || sp > (1u << 18))) break; } } }
        return true;
    }
    const PG8_LAS int* rowtok;
    __device__ __forceinline__ int arow(int ui, int r) const { return rowtok[ui * BM + r]; }
};

typedef float f32x2_t __attribute__((ext_vector_type(2)));
typedef float f32x16_t __attribute__((ext_vector_type(16)));
typedef unsigned u32x6 __attribute__((ext_vector_type(6)));
__device__ __forceinline__ u32x6 pk32_fp6(const f32x16_t s0, const f32x16_t s1) { return __builtin_amdgcn_cvt_scalef32_2xpk16_fp6_f32(s0, s1, 1.0f); }
typedef __bf16 bf16x2_t __attribute__((ext_vector_type(2)));
__device__ __forceinline__ unsigned cvt_pk_bf16(float lo, float hi) { const f32x2_t v = {lo, hi}; return __builtin_bit_cast(unsigned, __builtin_convertvector(v, bf16x2_t)); }

__device__ __forceinline__ unsigned pk4_fp8(float a, float b, float c, float d) { int v = __builtin_amdgcn_cvt_pk_fp8_f32(a, b, 0, false); v = __builtin_amdgcn_cvt_pk_fp8_f32(c, d, v, true); return (unsigned)v; }
struct EpiBf16 {
    struct Pre {}; __device__ __forceinline__ Pre pre(const Unit&, int, int, int, int) const { return Pre{}; }
    static constexpr bool PERM = true;
    bf16_t* O; int ldc; float scale;
    __device__ __forceinline__ void operator()(const f32x4 (&acc)[2][2][4][2], const Unit& u, int wr, int wc, int fr, int fq, const Pre& P) const {
        const int row0 = u.pm * BM + wr * 64 + fr, col0 = u.pn * BM + wc * 32 + 8 * fq;
#pragma unroll
        for (int ai = 0; ai < 2; ++ai)
#pragma unroll
            for (int m = 0; m < 4; ++m) { bf16_t* rowp = O + (size_t)(row0 + ai * HALF + m * 16) * ldc + col0;
#pragma unroll
                for (int bj = 0; bj < 2; ++bj) { const f32x4 v0 = acc[ai][bj][m][0] * scale, v1 = acc[ai][bj][m][1] * scale;
                    u32x4 w; w.x = cvt_pk_bf16(v0[0], v0[1]); w.y = cvt_pk_bf16(v0[2], v0[3]); w.z = cvt_pk_bf16(v1[0], v1[1]); w.w = cvt_pk_bf16(v1[2], v1[3]);
                    *(u32x4*)(rowp + bj * HALF) = w; } }
    }
};
struct EpiRowScaleBf16 {
    struct Pre { float rq[2][4]; };
    __device__ __forceinline__ Pre pre(const Unit& u, int wr, int, int fr, int) const { Pre p; const int row0 = u.pm * BM + wr * 64 + fr;
        _Pragma("unroll") for (int ai = 0; ai < 2; ++ai) _Pragma("unroll") for (int m = 0; m < 4; ++m) p.rq[ai][m] = rowsq[row0 + ai * HALF + m * 16]; return p; }
    static constexpr bool PERM = true;
    bf16_t* O; int ldc; const float* rowsq; float inv_n, eps, scale;
    __device__ __forceinline__ void operator()(const f32x4 (&acc)[2][2][4][2], const Unit& u, int wr, int wc, int fr, int fq, const Pre& P) const {
        const int row0 = u.pm * BM + wr * 64 + fr, col0 = u.pn * BM + wc * 32 + 8 * fq;
#pragma unroll
        for (int ai = 0; ai < 2; ++ai)
#pragma unroll
            for (int m = 0; m < 4; ++m) { const int r = row0 + ai * HALF + m * 16; const float s = __builtin_amdgcn_rsqf(P.rq[ai][m] * inv_n + eps) * scale;
                bf16_t* rowp = O + (size_t)r * ldc + col0;
#pragma unroll
                for (int bj = 0; bj < 2; ++bj) { const f32x4 v0 = acc[ai][bj][m][0] * s, v1 = acc[ai][bj][m][1] * s;
                    u32x4 w; w.x = cvt_pk_bf16(v0[0], v0[1]); w.y = cvt_pk_bf16(v0[2], v0[3]); w.z = cvt_pk_bf16(v1[0], v1[1]); w.w = cvt_pk_bf16(v1[2], v1[3]);
                    *(u32x4*)(rowp + bj * HALF) = w; } }
    }
};
struct EpiResidIn {
    struct Pre {}; __device__ __forceinline__ Pre pre(const Unit&, int, int, int, int) const { return Pre{}; }
    static constexpr bool PERM = true;
    const float* base; bf16_t* xo; unsigned char* x8; float* rowsq; int ldc;
    __device__ __forceinline__ void operator()(const f32x4 (&acc)[2][2][4][2], const Unit& u, int wr, int wc, int fr, int fq, const Pre& P) const {
        const int row0 = u.pm * BM + wr * 64 + fr, col0 = u.pn * BM + wc * 32 + 8 * fq;
#pragma unroll
        for (int ai = 0; ai < 2; ++ai) {
            f32x4 b[4][2][2];
#pragma unroll
            for (int m = 0; m < 4; ++m)
#pragma unroll
                for (int bj = 0; bj < 2; ++bj)
#pragma unroll
                    for (int n = 0; n < 2; ++n) b[m][bj][n] = *(const f32x4*)(base + (size_t)(row0 + ai * HALF + m * 16) * ldc + col0 + bj * HALF + 4 * n);
#pragma unroll
            for (int m = 0; m < 4; ++m) { const int r = row0 + ai * HALF + m * 16; const size_t off = (size_t)r * ldc + col0; float ss = 0.f;
#pragma unroll
                for (int bj = 0; bj < 2; ++bj) { const f32x4 v0 = b[m][bj][0] + acc[ai][bj][m][0], v1 = b[m][bj][1] + acc[ai][bj][m][1];
                    u32x4 w; w.x = cvt_pk_bf16(v0[0], v0[1]); w.y = cvt_pk_bf16(v0[2], v0[3]); w.z = cvt_pk_bf16(v1[0], v1[1]); w.w = cvt_pk_bf16(v1[2], v1[3]);
                    *(u32x4*)(xo + off + bj * HALF) = w;
                    u32x2 q; q.x = pk4_fp8(v0[0], v0[1], v0[2], v0[3]); q.y = pk4_fp8(v1[0], v1[1], v1[2], v1[3]); *(u32x2*)(x8 + off + bj * HALF) = q;
                    ss += ((v0[0] * v0[0] + v0[1] * v0[1]) + (v0[2] * v0[2] + v0[3] * v0[3])) + ((v1[0] * v1[0] + v1[1] * v1[1]) + (v1[2] * v1[2] + v1[3] * v1[3])); }
                ss += __shfl_xor(ss, 16); ss += __shfl_xor(ss, 32); if (fq == 0) atomicAdd(rowsq + r, ss); }
            asm volatile("" ::: "memory"); }
    }
};
struct EpiResidBf {
    struct Pre {}; __device__ __forceinline__ Pre pre(const Unit&, int, int, int, int) const { return Pre{}; }
    static constexpr bool PERM = true;
    bf16_t* x; int ldc; float ascale;
    __device__ __forceinline__ void operator()(const f32x4 (&acc)[2][2][4][2], const Unit& u, int wr, int wc, int fr, int fq, const Pre& P) const {
        const int row0 = u.pm * BM + wr * 64 + fr, col0 = u.pn * BM + wc * 32 + 8 * fq;
        u32x4 b[2][4][2];
#pragma unroll
        for (int ai = 0; ai < 2; ++ai)
#pragma unroll
            for (int m = 0; m < 4; ++m)
#pragma unroll
                for (int bj = 0; bj < 2; ++bj) b[ai][m][bj] = *(const u32x4*)(x + (size_t)(row0 + ai * HALF + m * 16) * ldc + col0 + bj * HALF);
#pragma unroll
        for (int ai = 0; ai < 2; ++ai)
#pragma unroll
            for (int m = 0; m < 4; ++m) { const size_t off = (size_t)(row0 + ai * HALF + m * 16) * ldc + col0;
#pragma unroll
                for (int bj = 0; bj < 2; ++bj) { const f32x4 a0 = acc[ai][bj][m][0] * ascale, a1 = acc[ai][bj][m][1] * ascale; const u32x4 p = b[ai][m][bj];
                    u32x4 w; w.x = cvt_pk_bf16(__builtin_bit_cast(float, p.x << 16) + a0[0], __builtin_bit_cast(float, p.x & 0xffff0000u) + a0[1]);
                    w.y = cvt_pk_bf16(__builtin_bit_cast(float, p.y << 16) + a0[2], __builtin_bit_cast(float, p.y & 0xffff0000u) + a0[3]);
                    w.z = cvt_pk_bf16(__builtin_bit_cast(float, p.z << 16) + a1[0], __builtin_bit_cast(float, p.z & 0xffff0000u) + a1[1]);
                    w.w = cvt_pk_bf16(__builtin_bit_cast(float, p.w << 16) + a1[2], __builtin_bit_cast(float, p.w & 0xffff0000u) + a1[3]);
                    *(u32x4*)(x + off + bj * HALF) = w; } }
    }
};
struct EpiSoftmaxF8 {
    static constexpr bool PERM = true;
    struct Pre { float rq[2][4]; };
    __device__ __forceinline__ Pre pre(const Unit& u, int wr, int, int fr, int) const { Pre p; const int row0 = u.pm * BM + wr * 64 + fr;
        _Pragma("unroll") for (int ai = 0; ai < 2; ++ai) _Pragma("unroll") for (int m = 0; m < 4; ++m) p.rq[ai][m] = rowsq[row0 + ai * HALF + m * 16]; return p; }
    unsigned char* O; int ldc; const float* rowsq; float inv_n, eps, sscale; PG8_LAS float* xch;
    __device__ __forceinline__ void operator()(f32x4 (&acc)[2][2][4][2], const Unit& u, int wr, int wc, int fr, int fq, const Pre& P) const {
        const int row0 = u.pm * BM + wr * 64 + fr, col0 = u.pn * BM + wc * 32 + 8 * fq, rl0 = wr * 64 + fr;
        float f[2][4];
#pragma unroll
        for (int ai = 0; ai < 2; ++ai)
#pragma unroll
            for (int m = 0; m < 4; ++m) { f[ai][m] = __builtin_amdgcn_rsqf(P.rq[ai][m] * inv_n + eps) * sscale; float mx = -INFINITY;
#pragma unroll
                for (int bj = 0; bj < 2; ++bj)
#pragma unroll
                    for (int n = 0; n < 2; ++n) { const f32x4 v = acc[ai][bj][m][n]; mx = fmaxf(mx, fmaxf(fmaxf(v[0], v[1]), fmaxf(v[2], v[3]))); }
                mx = fmaxf(mx, __shfl_xor(mx, 16)); mx = fmaxf(mx, __shfl_xor(mx, 32));
                if (fq == 0) xch[(rl0 + ai * HALF + m * 16) * 4 + wc] = mx * f[ai][m]; }
        asm volatile("s_waitcnt lgkmcnt(0)" ::: "memory"); __builtin_amdgcn_s_barrier(); asm volatile("" ::: "memory");
#pragma unroll
        for (int ai = 0; ai < 2; ++ai)
#pragma unroll
            for (int m = 0; m < 4; ++m) { const f32x4 x4 = *(const PG8_LAS f32x4*)(xch + (rl0 + ai * HALF + m * 16) * 4); const float M = fmaxf(fmaxf(x4[0], x4[1]), fmaxf(x4[2], x4[3])); float sm = 0.f;
#pragma unroll
                for (int bj = 0; bj < 2; ++bj)
#pragma unroll
                    for (int n = 0; n < 2; ++n) { f32x4 v = acc[ai][bj][m][n];
#pragma unroll
                        for (int i = 0; i < 4; ++i) { v[i] = __builtin_amdgcn_exp2f(v[i] * f[ai][m] - M); sm += v[i]; }
                        acc[ai][bj][m][n] = v; }
                sm += __shfl_xor(sm, 16); sm += __shfl_xor(sm, 32);
                if (fq == 0) xch[1024 + (rl0 + ai * HALF + m * 16) * 4 + wc] = sm; }
        asm volatile("s_waitcnt lgkmcnt(0)" ::: "memory"); __builtin_amdgcn_s_barrier(); asm volatile("" ::: "memory");
#pragma unroll
        for (int ai = 0; ai < 2; ++ai)
#pragma unroll
            for (int m = 0; m < 4; ++m) { const f32x4 s4 = *(const PG8_LAS f32x4*)(xch + 1024 + (rl0 + ai * HALF + m * 16) * 4); const float sc = 128.0f * __builtin_amdgcn_rcpf((s4[0] + s4[1]) + (s4[2] + s4[3]));
                unsigned char* rowp = O + (size_t)(row0 + ai * HALF + m * 16) * ldc + col0;
#pragma unroll
                for (int bj = 0; bj < 2; ++bj) { const f32x4 v0 = acc[ai][bj][m][0] * sc, v1 = acc[ai][bj][m][1] * sc;
                    u32x2 w; w.x = pk4_fp8(v0[0], v0[1], v0[2], v0[3]); w.y = pk4_fp8(v1[0], v1[1], v1[2], v1[3]); *(u32x2*)(rowp + bj * HALF) = w; } }
    }
};
struct EpiSwiGLU {
    struct Pre { f32x4 bgv[2], buv[2]; };
    __device__ __forceinline__ Pre pre(const Unit& u, int, int wc, int, int fq) const { Pre p; const float* bg = bias + (size_t)u.e * 2048 + u.pn * HALF + wc * 32 + 8 * fq;
        _Pragma("unroll") for (int n = 0; n < 2; ++n) { p.bgv[n] = *(const f32x4*)(bg + 4 * n); p.buv[n] = *(const f32x4*)(bg + 1024 + 4 * n); } return p; }
    static constexpr bool PERM = true;
    unsigned char* O; const float* bias; float wscale;
    bool wt;
    __device__ __forceinline__ void operator()(const f32x4 (&acc)[2][2][4][2], const Unit& u, int wr, int wc, int fr, int fq, const Pre& P) const {
        const int row0 = u.pm * BM + wr * 64 + fr, colj = u.pn * HALF + wc * 32 + 8 * fq;
#pragma unroll
        for (int ai = 0; ai < 2; ++ai)
#pragma unroll
            for (int m = 0; m < 4; ++m) { unsigned char* rowp = O + (size_t)(row0 + ai * HALF + m * 16) * 1024 + colj; float o[8];
#pragma unroll
                for (int n = 0; n < 2; ++n) { const f32x4 g4 = acc[ai][0][m][n] * wscale + P.bgv[n], u4 = acc[ai][1][m][n] * wscale + P.buv[n];
#pragma unroll
                    for (int i = 0; i < 4; ++i) { const float g = fminf(g4[i], 7.0f), up = fminf(fmaxf(u4[i], -7.0f), 7.0f);
                        const float sg = __builtin_amdgcn_rcpf(1.0f + __builtin_amdgcn_exp2f(g * (-1.702f * 1.44269504f)));
                        o[4 * n + i] = (up + 1.0f) * (g * sg); } }
                u32x2 w; w.x = pk4_fp8(o[0], o[1], o[2], o[3]); w.y = pk4_fp8(o[4], o[5], o[6], o[7]);
                if (wt) __hip_atomic_store((unsigned long long*)rowp, (unsigned long long)w.x | ((unsigned long long)w.y << 32), __ATOMIC_RELAXED, __HIP_MEMORY_SCOPE_AGENT);
                else *(u32x2*)rowp = w; }
    }
};
struct EpiBiasF8 {
    static constexpr bool PERM = true;
    struct Pre { f32x4 bv[2][2]; };
    __device__ __forceinline__ Pre pre(const Unit& u, int, int wc, int, int fq) const { Pre p; const float* bp = bias + (size_t)u.e * 1024 + u.pn * BM + wc * 32 + 8 * fq;
        _Pragma("unroll") for (int bj = 0; bj < 2; ++bj) _Pragma("unroll") for (int n = 0; n < 2; ++n) p.bv[bj][n] = *(const f32x4*)(bp + bj * HALF + 4 * n); return p; }
    unsigned char* O; const float* bias; float wscale;
    __device__ __forceinline__ void operator()(const f32x4 (&acc)[2][2][4][2], const Unit& u, int wr, int wc, int fr, int fq, const Pre& P) const {
        const int row0 = u.pm * BM + wr * 64 + fr, col0 = u.pn * BM + wc * 32 + 8 * fq;
#pragma unroll
        for (int ai = 0; ai < 2; ++ai)
#pragma unroll
            for (int m = 0; m < 4; ++m) { unsigned char* rowp = O + (size_t)(row0 + ai * HALF + m * 16) * 1024 + col0;
#pragma unroll
                for (int bj = 0; bj < 2; ++bj) { const f32x4 v0 = acc[ai][bj][m][0] * wscale + P.bv[bj][0], v1 = acc[ai][bj][m][1] * wscale + P.bv[bj][1];
                    u32x2 w; w.x = pk4_fp8(v0[0], v0[1], v0[2], v0[3]); w.y = pk4_fp8(v1[0], v1[1], v1[2], v1[3]);
                    *(u32x2*)(rowp + bj * HALF) = w; } }
    }
};

typedef int i32x4 __attribute__((ext_vector_type(4)));
typedef int i32x8 __attribute__((ext_vector_type(8)));
__device__ __forceinline__ i32x8 cat16(bf16x8 a, bf16x8 b) { return __builtin_shufflevector(__builtin_bit_cast(i32x4, a), __builtin_bit_cast(i32x4, b), 0, 1, 2, 3, 4, 5, 6, 7); }
typedef int i32x6 __attribute__((ext_vector_type(6)));
typedef bf16x8 __attribute__((aligned(8))) bf16x8_a8;
__device__ __forceinline__ i32x6 cat6(bf16x8 a, bf16x8 b) { return __builtin_shufflevector(__builtin_bit_cast(i32x4, a), __builtin_bit_cast(i32x4, b), 0, 1, 2, 3, 4, 5); }
constexpr int B6_KT = 256 * 96, B6_TILE = 8 * B6_KT;
template <class Epi, class Sched, bool ALIGN_EPI, int FP8 = 0>
__device__ __forceinline__ void gemm_phase(PG8_LAS unsigned char* lds, const Gemm g, const Sched& S, const Epi& E, int wid) {
    const int lane = lane_id(), tid = wid * 64 + lane, wr = wid >> 2, wc = wid & 3, fr = lane & 15, fq = lane >> 4;
    const int K = g.K, nt = K / BK, kmask = nt - 1, krot = nt >> 3;
#define PG8_KOFF(u) (((u).pm + (u).pn) * krot & kmask)
    unsigned voffA[2], voffB[2]; int RA[2], CA[2];
#pragma unroll
    for (int i = 0; i < 2; ++i) { int R, C; stage_rc(tid * 16 + i * 8192, R, C); const int Rb = Epi::PERM ? ((R & ~31) + perm32(R & 31)) : R;
        RA[i] = R; CA[i] = C; voffA[i] = (unsigned)(R * K + C) * 2u; voffB[i] = (unsigned)(Rb * K + C) * 2u; }
    const size_t kstep = (size_t)(BK * 2);
    const size_t hstep = (size_t)HALF * K * 2;
    const size_t tstep = 2 * hstep;
    const unsigned ldsw = (unsigned)wid * 1024u;
    const int aoff = lds_byte(wr * 64 + fr, fq * 8), boff = (FP8 == 2) ? (wc * 32 + fr) * 96 + ((fq + 2 * (fr >> 3)) & 3) * 24 : lds_byte(wc * 32 + fr, fq * 8);
    const unsigned voffB6 = (unsigned)tid * 16u;
#define PG8_SA(b, h) (((b) * 2 + (h)) * HTB)
#define PG8_SB(b, h) ((4 + (b) * 2 + (h)) * HTB)
#define PG8_STAGEB6(b, gbase) do { _Pragma("unroll") for (int _i = 0; _i < 3; ++_i) \
        __builtin_amdgcn_global_load_lds((const unsigned*)((const char*)(gbase) + voffB6 + _i * 8192), (PG8_LAS unsigned*)(lds + PG8_SB(b, 0) + ldsw + _i * 8192), 16, 0, 0); } while (0)
#define PG8_STB(b, pb, p6) do { if constexpr (FP8 == 2) { PG8_STAGEB6(b, p6); } else { PG8_STAGE(PG8_SB(b, 0), pb, voffB); PG8_STAGE(PG8_SB(b, 1), (pb) + hstep, voffB); } } while (0)
#define PG8_STAGE(bufoff, gbase, voff) do { _Pragma("unroll") for (int _i = 0; _i < 2; ++_i) \
        __builtin_amdgcn_global_load_lds((const unsigned*)((const char*)(gbase) + (voff)[_i]), (PG8_LAS unsigned*)(lds + (bufoff) + ldsw + _i * 8192), 16, 0, 0); } while (0)
#define PG8_STAGE2(bufoff, gbase, v0, v1) do { \
        __builtin_amdgcn_global_load_lds((const unsigned*)((const char*)(gbase) + (v0)), (PG8_LAS unsigned*)(lds + (bufoff) + ldsw), 16, 0, 0); \
        __builtin_amdgcn_global_load_lds((const unsigned*)((const char*)(gbase) + (v1)), (PG8_LAS unsigned*)(lds + (bufoff) + ldsw + 8192), 16, 0, 0); } while (0)
#define PG8_STA(bufoff, h, pNG, pG, nx) do { if constexpr (Sched::GATHER) { const unsigned _v0 = (nx) ? nv[h][0] : cv[h][0], _v1 = (nx) ? nv[h][1] : cv[h][1]; PG8_STAGE2(bufoff, pG, _v0, _v1); } \
        else { PG8_STAGE(bufoff, (pNG) + (h) * hstep, voffA); } } while (0)
#define PG8_LDA(dst, b, h) do { _Pragma("unroll") for (int m = 0; m < 4; ++m) _Pragma("unroll") for (int k = 0; k < 2; ++k) dst[m][k] = *(const PG8_LAS bf16x8*)(lds + PG8_SA(b, h) + aoff + m * 2048 + k * 1024); } while (0)
#define PG8_LDB(dst, b, h) do { if constexpr (FP8 == 2) { _Pragma("unroll") for (int n = 0; n < 2; ++n) { const PG8_LAS unsigned char* _p = lds + PG8_SB(b, 0) + boff + (h) * 12288 + n * 1536; \
            const u32x2 _t0 = *(const volatile PG8_LAS u32x2*)_p, _t1 = *(const volatile PG8_LAS u32x2*)(_p + 8), _t2 = *(const volatile PG8_LAS u32x2*)(_p + 16); \
            dst[n][0] = __builtin_bit_cast(bf16x8, __builtin_shufflevector(_t0, _t1, 0, 1, 2, 3)); dst[n][1] = __builtin_bit_cast(bf16x8, __builtin_shufflevector(_t2, _t2, 0, 1, -1, -1)); } } \
        else { _Pragma("unroll") for (int n = 0; n < 2; ++n) _Pragma("unroll") for (int k = 0; k < 2; ++k) dst[n][k] = *(const PG8_LAS bf16x8*)(lds + PG8_SB(b, h) + boff + n * 2048 + k * 1024); } } while (0)
#define PG8_MMA(ai, bj, At, Bt) do { __builtin_amdgcn_s_setprio(1); \
        if constexpr (FP8 == 2) { _Pragma("unroll") for (int m = 0; m < 4; ++m) _Pragma("unroll") for (int n = 0; n < 2; ++n) \
            asm volatile("s_nop 1\n\tv_mfma_scale_f32_16x16x128_f8f6f4 %0, %1, %2, %0, %3, %3 op_sel_hi:[0,0,0] cbsz:2" : "+v"(acc[ai][bj][m][n]) : "v"(cat6(Bt[n][0], Bt[n][1])), "v"(cat16(At[m][0], At[m][1])), "v"(mxs)); } \
        else if constexpr (FP8 == 1) { _Pragma("unroll") for (int m = 0; m < 4; ++m) _Pragma("unroll") for (int n = 0; n < 2; ++n) \
            asm volatile("v_mfma_scale_f32_16x16x128_f8f6f4 %0, %1, %2, %0, %3, %3 op_sel_hi:[0,0,0]" : "+v"(acc[ai][bj][m][n]) : "v"(cat16(Bt[n][0], Bt[n][1])), "v"(cat16(At[m][0], At[m][1])), "v"(mxs)); } \
        else { _Pragma("unroll") for (int m = 0; m < 4; ++m) _Pragma("unroll") for (int n = 0; n < 2; ++n) _Pragma("unroll") for (int k = 0; k < 2; ++k) \
            acc[ai][bj][m][n] = __builtin_amdgcn_mfma_f32_16x16x32_bf16(Bt[n][k], At[m][k], acc[ai][bj][m][n], 0, 0, 0); } \
        __builtin_amdgcn_s_setprio(0); } while (0)
#define PG8_WAIT_V(n) asm volatile("s_waitcnt vmcnt(" #n ")" ::: "memory")
#define PG8_WAIT_L(n) asm volatile("s_waitcnt lgkmcnt(" #n ")" ::: "memory")
#define PG8_WAIT_VK do { if constexpr (FP8 == 2) PG8_WAIT_V(7); else PG8_WAIT_V(8); } while (0)
#define PG8_BAR __builtin_amdgcn_s_barrier()
#define PG8_SCHED __builtin_amdgcn_sched_barrier(0)
    Unit cur, nxt; int ui = 0;
    if (!S.next(0, cur)) return;
    int sig_pm = -1;
    const int mxs = 0x7f7f7f7f;
    f32x4 acc[2][2][4][2];
#pragma unroll
    for (int a = 0; a < 2; ++a)
#pragma unroll
        for (int b = 0; b < 2; ++b)
#pragma unroll
            for (int m = 0; m < 4; ++m)
#pragma unroll
                for (int n = 0; n < 2; ++n) acc[a][b][m][n] = (f32x4){0.f, 0.f, 0.f, 0.f};
    bf16x8 At[4][2], B0[2][2], B1[2][2];
    const char* gA0 = (const char*)g.A;
    const size_t btstep = (FP8 == 2) ? (size_t)B6_TILE : tstep, kmulB = (FP8 == 2) ? (size_t)(B6_KT / (BK * 2)) : (size_t)1;
    const char* cA = gA0 + (size_t)cur.pm * tstep; const char* cB = (const char*)g.Bt + (size_t)cur.e * g.bstride + (size_t)cur.pn * btstep;
    unsigned cv[2][2], nv[2][2];
#pragma unroll
    for (int h = 0; h < 2; ++h)
#pragma unroll
        for (int i = 0; i < 2; ++i) { cv[h][i] = 0u; nv[h][i] = 0u; }
    if constexpr (Sched::GATHER) {
#pragma unroll
        for (int h = 0; h < 2; ++h)
#pragma unroll
            for (int i = 0; i < 2; ++i) cv[h][i] = ((unsigned)S.arow(0, h * HALF + RA[i]) * (unsigned)K + (unsigned)CA[i]) * 2u;
    }
    int coff = PG8_KOFF(cur);
    { const size_t k0 = (size_t)coff * kstep, k1 = (size_t)((coff + 1) & kmask) * kstep;
    PG8_STB(0, cB + k0 * kmulB, cB + k0 * kmulB); PG8_STA(PG8_SA(0, 0), 0, cA + k0, gA0 + k0, false); PG8_STA(PG8_SA(0, 1), 1, cA + k0, gA0 + k0, false);
    if (wr == 1) PG8_BAR;
    PG8_WAIT_V(2); PG8_BAR;
    if constexpr (FP8 == 2) { PG8_STB(1, cB + k1 * kmulB, cB + k1 * kmulB); PG8_STA(PG8_SA(1, 0), 0, cA + k1, gA0 + k1, false); }
    else { PG8_STAGE(PG8_SB(1, 0), cB + k1, voffB); PG8_STA(PG8_SA(1, 0), 0, cA + k1, gA0 + k1, false); PG8_STAGE(PG8_SB(1, 1), cB + hstep + k1, voffB); } }
    if constexpr (FP8 == 2) PG8_WAIT_V(5); else PG8_WAIT_V(6);
    PG8_BAR;
    for (;;) {
        const bool has_next = S.next(ui + 1, nxt);
        const typename Epi::Pre epre = E.pre(cur, wr, wc, fr, fq);
        const int noff = has_next ? PG8_KOFF(nxt) : coff;
        const char* nA = has_next ? gA0 + (size_t)nxt.pm * tstep : cA; const char* nB = has_next ? (const char*)g.Bt + (size_t)nxt.e * g.bstride + (size_t)nxt.pn * btstep : cB;
        if constexpr (Sched::GATHER) {
#pragma unroll
            for (int h = 0; h < 2; ++h)
#pragma unroll
                for (int i = 0; i < 2; ++i) nv[h][i] = has_next ? ((unsigned)S.arow(ui + 1, h * HALF + RA[i]) * (unsigned)K + (unsigned)CA[i]) * 2u : cv[h][i];
        }
#pragma unroll 1
        for (int t = 0; t < nt; t += 2) {
            const bool last = (t == nt - 2);
            if constexpr (Sched::GATHER) { if (t == 2 && sig_pm >= 0) {
                if (S.done && tid == 0) (void)__hip_atomic_fetch_add(S.done + 64 * sig_pm, 1u, __ATOMIC_RELAXED, __HIP_MEMORY_SCOPE_AGENT); sig_pm = -1; } }
            const size_t k1 = (size_t)((t + 1 + coff) & kmask) * kstep, k2 = (size_t)((last ? noff : t + 2 + coff) & kmask) * kstep, k3 = (size_t)((last ? noff + 1 : t + 3 + coff) & kmask) * kstep;
            const char* pa = last ? nA : cA; const char* pb = last ? nB : cB;
            const char* a1 = cA + k1; const char* a1g = gA0 + k1;
            const char* a2 = pa + k2; const char* b2 = pb + k2 * kmulB; const char* a2g = gA0 + k2;
            const char* a3 = pa + k3; const char* b3 = pb + k3 * kmulB; const char* a3g = gA0 + k3;
            PG8_LDB(B0, 0, 0); PG8_LDB(B1, 0, 1); PG8_SCHED; PG8_LDA(At, 0, 0); PG8_STA(PG8_SA(1, 1), 1, a1, a1g, false);
            PG8_WAIT_VK; PG8_WAIT_L(0); PG8_BAR; PG8_MMA(0, 0, At, B0); PG8_MMA(0, 1, At, B1); PG8_BAR; PG8_SCHED;
            PG8_LDA(At, 0, 1); PG8_STB(0, b2, b2); PG8_STA(PG8_SA(0, 0), 0, a2, a2g, last);
            PG8_WAIT_VK; PG8_WAIT_L(0); PG8_BAR; PG8_MMA(1, 0, At, B0); PG8_MMA(1, 1, At, B1); PG8_BAR; PG8_SCHED;
            PG8_LDB(B0, 1, 0); PG8_LDB(B1, 1, 1); PG8_SCHED; PG8_LDA(At, 1, 0); PG8_STA(PG8_SA(0, 1), 1, a2, a2g, last);
            PG8_WAIT_VK; PG8_WAIT_L(0); PG8_BAR; PG8_MMA(0, 0, At, B0); PG8_MMA(0, 1, At, B1); PG8_BAR; PG8_SCHED;
            PG8_LDA(At, 1, 1); PG8_STB(1, b3, b3); PG8_STA(PG8_SA(1, 0), 0, a3, a3g, last);
            PG8_WAIT_VK; PG8_WAIT_L(0); PG8_BAR; PG8_MMA(1, 0, At, B0); PG8_MMA(1, 1, At, B1); PG8_BAR; PG8_SCHED;
        }
        if constexpr (ALIGN_EPI) { if (wr == 0) PG8_BAR; }
        if constexpr (FP8) asm volatile("s_nop 15\n\ts_nop 3" ::: "memory");
        { int le = lane; asm volatile("" : "+v"(le));
          E(acc, cur, wr, wc, le & 15, le >> 4, epre); }
        if (!has_next) break;
#pragma unroll
        for (int a = 0; a < 2; ++a)
#pragma unroll
            for (int b = 0; b < 2; ++b)
#pragma unroll
                for (int m = 0; m < 4; ++m)
#pragma unroll
                    for (int n = 0; n < 2; ++n) acc[a][b][m][n] = (f32x4){0.f, 0.f, 0.f, 0.f};
        if constexpr (Sched::GATHER) sig_pm = cur.pm;
        cur = nxt; cA = nA; cB = nB; coff = noff; ++ui;
        if constexpr (Sched::GATHER) {
#pragma unroll
            for (int h = 0; h < 2; ++h)
#pragma unroll
                for (int i = 0; i < 2; ++i) cv[h][i] = nv[h][i];
        }
        if constexpr (ALIGN_EPI) { if (wr == 1) PG8_BAR; }
    }
    PG8_WAIT_V(0);
    if constexpr (!ALIGN_EPI) { if (wr == 0) PG8_BAR; }
    PG8_BAR;
    if constexpr (Sched::GATHER) { if (S.done && tid == 0) { if (sig_pm >= 0) (void)__hip_atomic_fetch_add(S.done + 64 * sig_pm, 1u, __ATOMIC_RELAXED, __HIP_MEMORY_SCOPE_AGENT);
            (void)__hip_atomic_fetch_add(S.done + 64 * cur.pm, 1u, __ATOMIC_RELAXED, __HIP_MEMORY_SCOPE_AGENT); } }
#undef PG8_KOFF
#undef PG8_SA
#undef PG8_SB
#undef PG8_STAGE
#undef PG8_STAGE2
#undef PG8_STA
#undef PG8_LDA
#undef PG8_LDB
#undef PG8_MMA
#undef PG8_WAIT_V
#undef PG8_WAIT_L
#undef PG8_WAIT_VK
#undef PG8_STB
#undef PG8_STAGEB6
#undef PG8_BAR
#undef PG8_SCHED
}
}

constexpr int NWAVES = 8, NTHR = NWAVES * 64;
constexpr int BATCH = 2, SEQ = 8192, D = 1024, M = BATCH * SEQ;
constexpr int NZ = 2048;
constexpr int CW = 512;
constexpr int MEMLEN = 256, NH = 4, HD = 256, MKV = BATCH * MEMLEN;
constexpr int NE = 32, TOPK = 4, DE = 1024, ECAP = 16384;
constexpr int MAXTILES = (M * TOPK) / 256 + NE;
constexpr float EPS = 1e-5f;
constexpr float WSCALE = 32.0f;
constexpr float QSCALE = 0.0625f * 1.44269504f;
constexpr int FN1 = 128, FN2 = 64;

constexpr size_t MiB = 1u << 20;
constexpr size_t WS_CTL = 0, CTL_ZERO_BYTES = 1 * MiB;
constexpr size_t WS_WINT = 2 * MiB, WS_WOUTT = 6 * MiB, WS_WQT = 8 * MiB, WS_WKT = 10 * MiB, WS_WVT = 12 * MiB, WS_WOT = 14 * MiB;
constexpr size_t WS_WRG = 16 * MiB;
constexpr size_t WS_TAB = 17 * MiB;
constexpr size_t WS_MC = 18 * MiB;
constexpr size_t WS_MEMN = 22 * MiB, WS_KB = 23 * MiB, WS_VT = 24 * MiB;
constexpr size_t WS_TOK = 25 * MiB;
constexpr size_t WS_ETOK = 26 * MiB;
constexpr size_t WS_WGUT = 32 * MiB, WS_WDT = 160 * MiB;
constexpr size_t WS_XR = 224 * MiB;
constexpr size_t WS_XN3 = 288 * MiB;
constexpr size_t WS_CTR = 320 * MiB;
constexpr size_t WS_XN = 464 * MiB, WS_Z = 496 * MiB, WS_G = 560 * MiB, WS_Y = 592 * MiB, WS_XB = 624 * MiB, WS_Q = 656 * MiB, WS_O = 688 * MiB;
constexpr size_t WS_ACT = 464 * MiB;
constexpr size_t WS_WQN = 28 * MiB, WS_WOT16 = 30 * MiB;
constexpr size_t WS_MK = WS_Q, WS_MV = WS_Q + 2 * MiB;
constexpr size_t WS_P = WS_O;
constexpr size_t WS_END = 720 * MiB;
constexpr size_t TAB_WA = 128 * 1024;
constexpr size_t TAB_DCH = 256 * 1024;
constexpr int CW_BAR = 4096;
constexpr int CW_CNT = 8192;
constexpr int CW_ROWSQ = 16384;
constexpr int CW_DONE = 131072;
static_assert((CW_DONE + 64 * 320) * 4 <= (int)CTL_ZERO_BYTES, "ctl");
constexpr int CW_GRP = 65536;
static_assert((CW_GRP + 64 * 64 * 3) * 4 <= (int)CTL_ZERO_BYTES, "ctl");
static_assert((CW_ROWSQ + M) * 4 <= (int)CTL_ZERO_BYTES, "ctl");

constexpr int LDS_BYTES = 147456;
constexpr int RING_BYTES = 131072, LDSCTL_OFF = LDS_BYTES - 512, MISC_OFF = LDSCTL_OFF + 320;
constexpr int MOE_TAB_OFF = 143360;

#define GAS __attribute__((address_space(1)))
#define LAS __attribute__((address_space(3)))
typedef unsigned short bf16;
typedef unsigned v4u __attribute__((ext_vector_type(4)));
typedef unsigned v2u __attribute__((ext_vector_type(2)));
typedef float f32x4 __attribute__((ext_vector_type(4)));
typedef GAS unsigned gu32;
typedef float f32x2v __attribute__((ext_vector_type(2)));
#define RLX_AGENT __ATOMIC_RELAXED, __HIP_MEMORY_SCOPE_AGENT
#define LDS_WAIT() asm volatile("s_waitcnt lgkmcnt(0)" ::: "memory")
__device__ __forceinline__ unsigned pk2(float lo, float hi) { return pg8::cvt_pk_bf16(lo, hi); }
__device__ __forceinline__ unsigned f2bf(float f) { return pg8::cvt_pk_bf16(f, 0.f) & 0xffffu; }
__device__ __forceinline__ float bf2f(unsigned short b) { return __builtin_bit_cast(float, (unsigned)b << 16); }
__device__ __forceinline__ float bflo(unsigned w) { return __builtin_bit_cast(float, w << 16); }
__device__ __forceinline__ float bfhi(unsigned w) { return __builtin_bit_cast(float, w & 0xffff0000u); }

#define XB_TMO      128
#define XB_XCNT(j)  (256  + 64 * (j))
#define XB_XSUB(j)  (1280 + 64 * (j))
#define XB_XGEN(j)  (2304 + 64 * (j))
#define XB_TOP      3328
#define XB_TOPGEN   3392
#define XCD_BAR_WORDS 3456
#define XB_SPIN_CAP (1u << 18)
__device__ __forceinline__ unsigned xb_ld(unsigned* p)              { return __hip_atomic_load(p, __ATOMIC_RELAXED, __HIP_MEMORY_SCOPE_AGENT); }
__device__ __forceinline__ unsigned xb_add(unsigned* p, unsigned v) { return __hip_atomic_fetch_add(p, v, __ATOMIC_RELAXED, __HIP_MEMORY_SCOPE_AGENT); }
__device__ __forceinline__ unsigned xb_xcc_id() { return (unsigned)__builtin_amdgcn_s_getreg((3 << 11) | 20) & 0xFu; }
#define XB_SPIN(cond, bar) do { unsigned _sp = 0; while (cond) { __builtin_amdgcn_s_sleep(1); \
    if ((++_sp & 255u) == 0u) { if (xb_ld(&(bar)[XB_TMO])) break; if (_sp > XB_SPIN_CAP) { atomicAdd(&(bar)[XB_TMO], 1u); break; } } } } while (0)
struct XcdBarrier { unsigned* bar; unsigned x; volatile LAS unsigned* st; };
__device__ __forceinline__ XcdBarrier xcd_barrier_post(unsigned* bar, volatile LAS unsigned* st, bool leader) {
    XcdBarrier b; b.bar = bar; b.x = xb_xcc_id(); b.st = st;
    if (leader) (void)xb_add(&bar[XB_XCNT(b.x)], 1u);
    return b;
}
__device__ __forceinline__ void xcd_barrier_complete(unsigned* bar, unsigned x, unsigned& nloc, unsigned& nx) {
    const unsigned G = gridDim.x * gridDim.y * gridDim.z;
    unsigned sum, cnt, mine, sp = 0u;
    for (;;) {
        sum = 0u; cnt = 0u; mine = 0u;
#pragma unroll
        for (unsigned j = 0; j < 16; ++j) { const unsigned c = xb_ld(&bar[XB_XCNT(j)]); sum += c; cnt += (c > 0u) ? 1u : 0u; mine = (j == x) ? c : mine; }
        if (sum == G) break;
        __builtin_amdgcn_s_sleep(1);
        if ((++sp & 255u) == 0u) { if (xb_ld(&bar[XB_TMO])) break; if (sp > XB_SPIN_CAP) { atomicAdd(&bar[XB_TMO], 1u); break; } }
    }
    nloc = mine > 0u ? mine : 1u; nx = cnt > 0u ? cnt : 1u;
}
__device__ __forceinline__ void xcd_barrier(const XcdBarrier& b, bool leader) {
    asm volatile("s_waitcnt vmcnt(0)" ::: "memory");
    __syncthreads();
    if (leader) {
        unsigned* bar = b.bar;
        __builtin_amdgcn_s_waitcnt(0);
        unsigned nloc = b.st[0], nx = b.st[1];
        if (nloc == 0u) { xcd_barrier_complete(bar, b.x, nloc, nx); b.st[0] = nloc; b.st[1] = nx; }
        const unsigned old = xb_add(&bar[XB_XSUB(b.x)], 1u);
        const unsigned gen = old / nloc;
        if (old + 1u == (gen + 1u) * nloc) {
            __builtin_amdgcn_fence(__ATOMIC_RELEASE, "agent");
            asm volatile("s_waitcnt vmcnt(0)" ::: "memory");
            const unsigned og = xb_add(&bar[XB_TOP], 1u);
            const unsigned tg = og / nx;
            if (og + 1u == (tg + 1u) * nx) xb_add(&bar[XB_TOPGEN], 1u);
            else XB_SPIN(xb_ld(&bar[XB_TOPGEN]) == tg, bar);
            __builtin_amdgcn_fence(__ATOMIC_ACQUIRE, "agent");
            xb_add(&bar[XB_XGEN(b.x)], 1u);
            asm volatile("s_waitcnt vmcnt(0)" ::: "memory");
        } else {
            XB_SPIN(xb_ld(&bar[XB_XGEN(b.x)]) == gen, bar);
            __builtin_amdgcn_fence(__ATOMIC_ACQUIRE, "agent");
            asm volatile("s_waitcnt vmcnt(0)" ::: "memory");
        }
    }
    __syncthreads();
}

constexpr unsigned NGRP = 4;
__device__ __forceinline__ void group_sync(unsigned* bar, unsigned long long* c1, unsigned* c2, bool leader) {
    asm volatile("s_waitcnt vmcnt(0)" ::: "memory");
    __syncthreads();
    if (leader) {
        __builtin_amdgcn_s_waitcnt(0);
        const unsigned x = xb_xcc_id();
        (void)__hip_atomic_fetch_add(c1, 1ull | (1ull << (8 + 3 * x)), __ATOMIC_RELAXED, __HIP_MEMORY_SCOPE_AGENT);
        unsigned long long v = 0ull;
        XB_SPIN(((v = __hip_atomic_load(c1, __ATOMIC_RELAXED, __HIP_MEMORY_SCOPE_AGENT)) & 0xffull) < NGRP, bar);
        if (((v >> (8 + 3 * x)) & 7ull) != NGRP) {
            __builtin_amdgcn_fence(__ATOMIC_RELEASE, "agent");
            asm volatile("s_waitcnt vmcnt(0)" ::: "memory");
            (void)xb_add(c2, 1u);
            XB_SPIN(xb_ld(c2) < NGRP, bar);
        }
        __builtin_amdgcn_fence(__ATOMIC_ACQUIRE, "agent");
        asm volatile("s_waitcnt vmcnt(0)" ::: "memory");
    }
    __syncthreads();
}

struct Args { const float* in[22]; float* out; unsigned char* ws; int ph_lo, ph_hi; };
struct Frame {
    LAS unsigned char* lds;
    unsigned char* ws;
    int wave, vcu, G;
    __device__ __forceinline__ int lane() const { return lane_id(); }
    __device__ __forceinline__ int tid() const { return wave * 64 + lane_id(); }
};
__device__ __forceinline__ float wave_sum(float v) {
#pragma unroll
    for (int o = 1; o < 64; o <<= 1) v += __shfl_xor(v, o);
    return v;
}
__device__ __forceinline__ float wave_max(float v) {
#pragma unroll
    for (int o = 1; o < 64; o <<= 1) v = fmaxf(v, __shfl_xor(v, o));
    return v;
}

template <bool F8>
__device__ __forceinline__ void p0_item(const float* W, int N, unsigned char* WT, int ldt, int k0, int n0s, int n0d, const float* gk, float scale, LAS float* scr, int lane) {
    const int n4 = lane & 15, kr = lane >> 4;
    f32x4 wv[16];
#pragma unroll
    for (int i = 0; i < 16; ++i) wv[i] = __builtin_nontemporal_load((const GAS f32x4*)(W + (size_t)(k0 + 4 * i + kr) * N + n0s + 4 * n4));
#pragma unroll
    for (int i = 0; i < 16; ++i) { const int kk = 4 * i + kr; float g = scale; if (gk) g *= gk[kk];
        LAS float* d = scr + kk * 65 + 4 * n4; d[0] = wv[i].x * g; d[1] = wv[i].y * g; d[2] = wv[i].z * g; d[3] = wv[i].w * g; }
    LDS_WAIT(); asm volatile("" ::: "memory");
    if constexpr (!F8) { const int c = lane & 7;
#pragma unroll
        for (int j = 0; j < 8; ++j) { const int n = (lane >> 3) + 8 * j; const LAS float* sp = scr + (8 * c) * 65 + n;
            v4u o; o.x = pk2(sp[0 * 65], sp[1 * 65]); o.y = pk2(sp[2 * 65], sp[3 * 65]); o.z = pk2(sp[4 * 65], sp[5 * 65]); o.w = pk2(sp[6 * 65], sp[7 * 65]);
            *(GAS v4u*)(WT + (size_t)(n0d + n) * ldt + (k0 + 8 * c) * 2) = o; }
    } else { const int c = lane & 3;
#pragma unroll
        for (int j = 0; j < 4; ++j) { const int n = (lane >> 2) + 16 * j; const LAS float* sp = scr + (16 * c) * 65 + n;
            v4u o; o.x = pg8::pk4_fp8(sp[0 * 65], sp[1 * 65], sp[2 * 65], sp[3 * 65]); o.y = pg8::pk4_fp8(sp[4 * 65], sp[5 * 65], sp[6 * 65], sp[7 * 65]);
            o.z = pg8::pk4_fp8(sp[8 * 65], sp[9 * 65], sp[10 * 65], sp[11 * 65]); o.w = pg8::pk4_fp8(sp[12 * 65], sp[13 * 65], sp[14 * 65], sp[15 * 65]);
            *(GAS v4u*)(WT + (size_t)(n0d + n) * ldt + k0 + 16 * c) = o; }
    }
    LDS_WAIT(); asm volatile("" ::: "memory");
}
constexpr int MOE_IT_GU = (D / 128) * (2 * DE / 32), MOE_IT_DN = (DE / 128) * (D / 32), MOE_ITEMS = NE * (MOE_IT_GU + MOE_IT_DN);
constexpr float W6SCALE = 64.0f;
constexpr size_t WGU6_E = (size_t)(2 * DE / 256) * pg8::B6_TILE, WDN6_E = (size_t)(D / 256) * pg8::B6_TILE;
__device__ __forceinline__ void p0_moe_decode(const Args& a, unsigned char* ws, int it, const float*& src, unsigned char*& dst, int& N) {
    if (it < NE * MOE_IT_GU) { const int e = it / MOE_IT_GU, q = it % MOE_IT_GU, kb = q / (2 * DE / 32), nb = q % (2 * DE / 32);
        const int n0d = 32 * nb, pn = n0d >> 8, hf = (n0d >> 7) & 1, jj = n0d & 127, n0s = hf * DE + 128 * pn + jj;
        N = 2 * DE; src = a.in[17] + (size_t)e * D * 2 * DE + (size_t)(128 * kb) * (2 * DE) + n0s; dst = ws + WS_WGUT + (size_t)e * WGU6_E + (size_t)pn * pg8::B6_TILE + (size_t)kb * pg8::B6_KT + (size_t)(n0d & 255) * 96; }
    else { it -= NE * MOE_IT_GU; const int e = it / MOE_IT_DN, q = it % MOE_IT_DN, kb = q / (D / 32), nb = q % (D / 32);
        N = D; src = a.in[19] + (size_t)e * DE * D + (size_t)(128 * kb) * D + 32 * nb; dst = ws + WS_WDT + (size_t)e * WDN6_E + (size_t)((32 * nb) >> 8) * pg8::B6_TILE + (size_t)kb * pg8::B6_KT + (size_t)((32 * nb) & 255) * 96; }
}
#define P0M_LOAD(wv, src, N) do { const unsigned _vo = (unsigned)(((lane >> 3) * (N) + 4 * (lane & 7)) * 4); _Pragma("unroll") for (int _i = 0; _i < 16; ++_i) \
        wv[_i] = __builtin_nontemporal_load((const GAS f32x4*)((const GAS char*)((src) + (size_t)(8 * _i) * (N)) + _vo)); } while (0)
#define P0M_PROC(wv, dst) do { _Pragma("unroll") for (int _i = 0; _i < 16; ++_i) { LAS float* _d = scr + (8 * _i + (lane >> 3)) * 33 + 4 * (lane & 7); _d[0] = wv[_i].x * WSCALE; _d[1] = wv[_i].y * WSCALE; _d[2] = wv[_i].z * WSCALE; _d[3] = wv[_i].w * WSCALE; } \
        LDS_WAIT(); asm volatile("" ::: "memory"); \
        _Pragma("unroll") for (int _j = 0; _j < 4; ++_j) { const int _n = (lane >> 3) + 8 * _j; const LAS float* _s = scr + (16 * (lane & 7)) * 33 + _n; \
            v4u _o; _o.x = pg8::pk4_fp8(_s[0 * 33], _s[1 * 33], _s[2 * 33], _s[3 * 33]); _o.y = pg8::pk4_fp8(_s[4 * 33], _s[5 * 33], _s[6 * 33], _s[7 * 33]); \
            _o.z = pg8::pk4_fp8(_s[8 * 33], _s[9 * 33], _s[10 * 33], _s[11 * 33]); _o.w = pg8::pk4_fp8(_s[12 * 33], _s[13 * 33], _s[14 * 33], _s[15 * 33]); \
            *(GAS v4u*)((dst) + (size_t)_n * D + 16 * (lane & 7)) = _o; } \
        LDS_WAIT(); asm volatile("" ::: "memory"); } while (0)
#define P0M_PROC6(wv, dst) do { _Pragma("unroll") for (int _i = 0; _i < 16; ++_i) { LAS float* _d = scr + (8 * _i + (lane >> 3)) * 33 + 4 * (lane & 7); _d[0] = wv[_i].x * W6SCALE; _d[1] = wv[_i].y * W6SCALE; _d[2] = wv[_i].z * W6SCALE; _d[3] = wv[_i].w * W6SCALE; } \
        LDS_WAIT(); asm volatile("" ::: "memory"); \
        _Pragma("unroll 1") for (int _j = 0; _j < 2; ++_j) { const int _g = (lane >> 2) + 16 * _j, _q = lane & 3; const LAS float* _s = scr + (32 * _q) * 33 + _g; pg8::f32x16_t _s0, _s1; \
            if (ilv) { _Pragma("unroll") for (int _e = 0; _e < 16; ++_e) { _s0[_e] = _s[(2 * _e) * 33]; _s1[_e] = _s[(2 * _e + 1) * 33]; } } \
            else { _Pragma("unroll") for (int _e = 0; _e < 16; ++_e) { _s0[_e] = _s[_e * 33]; _s1[_e] = _s[(16 + _e) * 33]; } } \
            const pg8::u32x6 _p = pg8::pk32_fp6(_s0, _s1); const int _r = 16 * ((_g >> 2) & 1) + 4 * (_g >> 3) + (_g & 3); unsigned char* _o = (dst) + (size_t)(_r * 96 + 24 * ((_q + 2 * (_r >> 3)) & 3)); \
            *(GAS v2u*)_o = (v2u){_p[0], _p[1]}; *(GAS v2u*)(_o + 8) = (v2u){_p[2], _p[3]}; *(GAS v2u*)(_o + 16) = (v2u){_p[4], _p[5]}; } \
        LDS_WAIT(); asm volatile("" ::: "memory"); } while (0)
__device__ __forceinline__ void p0_moe_stream(Frame& F, const Args& a, int lo, int hi, int gw, int NGW) {
    LAS float* scr = (LAS float*)(F.lds + F.wave * 16896); const int lane = F.lane(); unsigned char* ws = F.ws;
    f32x4 wA[16], wB[16]; const float* sA; const float* sB; unsigned char* dA; unsigned char* dB; int nA, nB;
    bool ilv; { pg8::f32x16_t t0 = {}, t1 = {}; float one = 1.0f, two = 2.0f; asm volatile("" : "+v"(one), "+v"(two)); t0[0] = one; t1[0] = two; const pg8::u32x6 tp = pg8::pk32_fp6(t0, t1);
                ilv = (((tp[0] >> 6) & 63u) == 16u) || (((tp[3] >> 0) & 63u) != 16u); }
    int it = lo + gw;
    if (it < hi) { p0_moe_decode(a, ws, it, sA, dA, nA); P0M_LOAD(wA, sA, nA); }
    for (; it < hi; it += 2 * NGW) {
        const int it2 = it + NGW, it3 = it + 2 * NGW;
        if (it2 < hi) { p0_moe_decode(a, ws, it2, sB, dB, nB); P0M_LOAD(wB, sB, nB); }
        P0M_PROC6(wA, dA);
        if (it3 < hi) { p0_moe_decode(a, ws, it3, sA, dA, nA); P0M_LOAD(wA, sA, nA); }
        if (it2 < hi) P0M_PROC6(wB, dB);
    }
}
__device__ __forceinline__ void rms_row_to_bf16(const float* xrow, const float* gain, bf16* orow, int lane) {
    const GAS f32x4* xr = (const GAS f32x4*)xrow + lane; const GAS f32x4* gr = (const GAS f32x4*)gain + lane;
    f32x4 v[4]; float s = 0.f;
#pragma unroll
    for (int j = 0; j < 4; ++j) { v[j] = xr[64 * j]; s += (v[j].x * v[j].x + v[j].y * v[j].y) + (v[j].z * v[j].z + v[j].w * v[j].w); }
    const float rs = 1.0f / sqrtf(wave_sum(s) * (1.f / D) + EPS);
    GAS unsigned long long* o8 = (GAS unsigned long long*)orow + lane;
#pragma unroll
    for (int j = 0; j < 4; ++j) { const f32x4 g = gr[64 * j]; o8[64 * j] = (unsigned long long)pk2(v[j].x * rs * g.x, v[j].y * rs * g.y) | ((unsigned long long)pk2(v[j].z * rs * g.z, v[j].w * rs * g.w) << 32); }
}
__device__ __forceinline__ void p0_prologue(Frame& F, const Args& a) {
    LAS float* scr = (LAS float*)(F.lds + F.wave * 16896);
    const int gw = F.vcu * NWAVES + F.wave, NGW = F.G * NWAVES;
    unsigned char* ws = F.ws;
    constexpr int I_WIN = (D / 64) * (NZ / 64);
    constexpr int I_SQ = (D / 64) * (D / 64);
    constexpr int NITEMS = I_WIN + 4 * I_SQ + 4 * D;
    for (int it = gw; it < NITEMS; it += NGW) {
        int r = it;
        if (r < I_WIN) { const int nb = r % (NZ / 64), kb = r / (NZ / 64); p0_item<false>(a.in[3], NZ, ws + WS_WINT, D * 2, 64 * kb, 64 * nb, 64 * nb, nullptr, 1.0f, scr, F.lane()); continue; } r -= I_WIN;
        if (r < 2 * I_SQ) { const int w = r / I_SQ, q = r % I_SQ, nb = q % (D / 64), kb = q / (D / 64), k0 = 64 * kb;
            if (w == 0) p0_item<false>(a.in[7], D, ws + WS_WOUTT, D * 2, k0, 64 * nb, 64 * nb, (k0 < CW) ? a.in[5] + k0 : a.in[6] + (k0 - CW), 1.0f, scr, F.lane());
            else p0_item<false>(a.in[13], D, ws + WS_WOT16, D * 2, k0, 64 * nb, 64 * nb, nullptr, 1.0f, scr, F.lane());
            continue; } r -= 2 * I_SQ;
        if (r < 2 * I_SQ) { const int w = r / I_SQ, q = r % I_SQ, nb = q % (D / 64), kb = q / (D / 64), k0 = 64 * kb;
            p0_item<true>(w == 0 ? a.in[11] : a.in[12], D, ws + (w == 0 ? WS_WKT : WS_WVT), D, k0, 64 * nb, 64 * nb, nullptr, WSCALE, scr, F.lane()); continue; } r -= 2 * I_SQ;
        { const int k = r >> 2, c0 = (r & 3) * 256 + 4 * F.lane(); const float g = a.in[8][k];
            const f32x4 v = *(const GAS f32x4*)(a.in[10] + (size_t)k * D + c0); v2u o; o.x = pk2(v.x * g, v.y * g); o.y = pk2(v.z * g, v.w * g);
            *(GAS v2u*)((bf16*)(ws + WS_WQN) + (size_t)k * D + c0) = o; }
    }
    for (int m = 2 * gw; m < M; m += 2 * NGW) {
        const GAS f32x4* x0 = (const GAS f32x4*)(a.in[0] + (size_t)m * D) + F.lane(); const GAS f32x4* x1 = x0 + D / 4; const GAS f32x4* gr = (const GAS f32x4*)a.in[2] + F.lane();
        f32x4 v0[4], v1[4]; float s0 = 0.f, s1 = 0.f;
#pragma unroll
        for (int j = 0; j < 4; ++j) { v0[j] = __builtin_nontemporal_load(x0 + 64 * j); v1[j] = __builtin_nontemporal_load(x1 + 64 * j); }
#pragma unroll
        for (int j = 0; j < 4; ++j) { s0 += (v0[j].x * v0[j].x + v0[j].y * v0[j].y) + (v0[j].z * v0[j].z + v0[j].w * v0[j].w); s1 += (v1[j].x * v1[j].x + v1[j].y * v1[j].y) + (v1[j].z * v1[j].z + v1[j].w * v1[j].w); }
        const float r0 = 1.0f / sqrtf(wave_sum(s0) * (1.f / D) + EPS), r1 = 1.0f / sqrtf(wave_sum(s1) * (1.f / D) + EPS);
        GAS unsigned long long* o0 = (GAS unsigned long long*)((bf16*)(ws + WS_XN) + (size_t)m * D) + F.lane(); GAS unsigned long long* o1 = o0 + D / 4;
#pragma unroll
        for (int j = 0; j < 4; ++j) { const f32x4 g = gr[64 * j];
            o0[64 * j] = (unsigned long long)pk2(v0[j].x * r0 * g.x, v0[j].y * r0 * g.y) | ((unsigned long long)pk2(v0[j].z * r0 * g.z, v0[j].w * r0 * g.w) << 32);
            o1[64 * j] = (unsigned long long)pk2(v1[j].x * r1 * g.x, v1[j].y * r1 * g.y) | ((unsigned long long)pk2(v1[j].z * r1 * g.z, v1[j].w * r1 * g.w) << 32); }
    }
    for (int m = gw; m < MKV; m += NGW) {
        const GAS f32x4* xr = (const GAS f32x4*)(a.in[1] + (size_t)m * D) + F.lane(); const GAS f32x4* gr = (const GAS f32x4*)a.in[9] + F.lane();
        f32x4 v[4]; float ss = 0.f;
#pragma unroll
        for (int j = 0; j < 4; ++j) { v[j] = xr[64 * j]; ss += (v[j].x * v[j].x + v[j].y * v[j].y) + (v[j].z * v[j].z + v[j].w * v[j].w); }
        const float rs = 1.0f / sqrtf(wave_sum(ss) * (1.f / D) + EPS);
        GAS unsigned* o4 = (GAS unsigned*)(ws + WS_MEMN + (size_t)m * D) + F.lane();
#pragma unroll
        for (int j = 0; j < 4; ++j) { const f32x4 g = gr[64 * j]; o4[64 * j] = pg8::pk4_fp8(v[j].x * rs * g.x, v[j].y * rs * g.y, v[j].z * rs * g.z, v[j].w * rs * g.w); }
    }
    const int gt = F.vcu * NTHR + F.tid(), NGT = F.G * NTHR;
    float* wrg = (float*)(ws + WS_WRG);
    for (int i = gt; i < D * NE; i += NGT) { const int e = i >> 10, k = i & 1023; wrg[i] = a.in[15][k * NE + e] * a.in[14][k]; }
    bf16* wa = (bf16*)(ws + WS_TAB + TAB_WA); bf16* mc = (bf16*)(ws + WS_MC); bf16* dch = (bf16*)(ws + WS_TAB + TAB_DCH);
    for (int i = gt; i < 256 * 128; i += NGT) { const int m = i >> 7, k = i & 127; float sn, cs; sincospif((float)((k * (m & 127)) & 127) * (2.0f / 128.0f), &sn, &cs); wa[i] = (bf16)f2bf(m < 128 ? cs : -sn); }
    for (int i = gt; i < 128 * 128 * 128; i += NGT) { const int s1p = i >> 14, mp = (i >> 7) & 127, k = i & 127, op = mp >> 6, s2q = mp & 63, s2 = k >> 1, part = k & 1;
        const int sp = s1p + 128 * s2q, r = (s2 * sp) & 8191; float sn, cs; sincospif((float)r * (2.0f / 8192.0f), &sn, &cs);
        mc[i] = (bf16)f2bf(op == 0 ? (part == 0 ? cs : sn) : (part == 0 ? -sn : cs)); }
    for (int i = gt; i < 8192; i += NGT) { const int p = i >> 12, hc = (i >> 11) & 1, cp = (i >> 5) & 63, q = (i >> 3) & 3, j = i & 7, c = 32 * hc + (j < 4 ? 4 * q + j : 16 + 4 * q + (j - 4));
        float sn, cs; sincospif((float)((c * cp) & 63) * (2.0f / 64.0f), &sn, &cs); dch[i] = (bf16)f2bf(p == 0 ? cs : sn); }
}

typedef short s16x4 __attribute__((ext_vector_type(4)));
typedef short bf16x8v __attribute__((ext_vector_type(8)));
__device__ __forceinline__ bf16x8v tr_pair(LAS unsigned char* p0, int delta) {
    const s16x4 lo = __builtin_amdgcn_ds_read_tr16_b64_v4i16((LAS s16x4*)p0); const s16x4 hi = __builtin_amdgcn_ds_read_tr16_b64_v4i16((LAS s16x4*)(p0 + delta));
    return __builtin_shufflevector(lo, hi, 0, 1, 2, 3, 4, 5, 6, 7);
}
constexpr int FA_P = 544;
constexpr int FC_P = 1056;
__device__ __forceinline__ void fftA_phase(Frame& F) {
    const bf16* Z = (const bf16*)(F.ws + WS_Z); bf16* G = (bf16*)(F.ws + WS_G); const bf16* WA = (const bf16*)(F.ws + WS_TAB + TAB_WA);
    const int tid = F.tid(), lane = F.lane(), w = F.wave, nb = w & 3, mh = w >> 2, g = lane >> 4, q = (lane & 15) >> 2, p = lane & 3;
    for (int unit = F.vcu; unit < BATCH * FN2 * 2; unit += F.G) {
        const int b = unit >> 7, s2 = (unit >> 1) & 63, ch = unit & 1;
        __syncthreads();
#pragma unroll
        for (int i = 0; i < 8; ++i) { const int row = 16 * i + (tid >> 5), piece = tid & 31;
            const v4u v = *(const GAS v4u*)(Z + ((size_t)b * SEQ + 64 * row + s2) * NZ + 1536 + 256 * ch + 8 * piece);
            *(LAS v4u*)(F.lds + row * FA_P + piece * 16) = v; }
        __syncthreads();
        bf16x8v af[4][4];
#pragma unroll
        for (int nt = 0; nt < 4; ++nt)
#pragma unroll
            for (int ks = 0; ks < 4; ++ks) af[nt][ks] = tr_pair(F.lds + (32 * ks + 8 * g + q) * FA_P + (64 * nb + 16 * nt) * 2 + 8 * p, 4 * FA_P);
#pragma unroll
        for (int mt = 0; mt < 8; ++mt) {
            const int m0 = 128 * mh + 16 * mt;
            bf16x8v bfr[4];
#pragma unroll
            for (int ks = 0; ks < 4; ++ks) bfr[ks] = *(const GAS bf16x8v*)(WA + (size_t)(m0 + (lane & 15)) * 128 + 32 * ks + 8 * (lane >> 4));
            const int s1p = 16 * mt + (lane & 15);
            bf16* gp = G + ((((size_t)b * FN1 + s1p) * FN2 + s2) * 2 + mh) * CW + 256 * ch + 64 * nb + 4 * (lane >> 4);
#pragma unroll
            for (int nt = 0; nt < 4; ++nt) { f32x4 acc = {0.f, 0.f, 0.f, 0.f};
#pragma unroll
                for (int ks = 0; ks < 4; ++ks) acc = __builtin_amdgcn_mfma_f32_16x16x32_bf16(af[nt][ks], bfr[ks], acc, 0, 0, 0);
                v2u o; o.x = pk2(acc[0], acc[1]); o.y = pk2(acc[2], acc[3]);
                *(GAS v2u*)(gp + 16 * nt) = o; }
        }
    }
}
__device__ __forceinline__ void conv_phase(Frame& F, const Args& a, int wgi, int nwg) {
    const bf16* Z = (const bf16*)(F.ws + WS_Z); bf16* Y = (bf16*)(F.ws + WS_Y);
    const int gw = wgi * NWAVES + F.wave, NGW = nwg * NWAVES, lane = F.lane();
    const float* cw = a.in[4];
    float w0[8], w1[8], w2[8];
#pragma unroll
    for (int j = 0; j < 8; ++j) { w0[j] = cw[8 * lane + j]; w1[j] = cw[CW + 8 * lane + j]; w2[j] = cw[2 * CW + 8 * lane + j]; }
    constexpr int CH = 8;
    for (int c = gw; c < M / CH; c += NGW) {
        const int t0 = c * CH, s0 = t0 & (SEQ - 1);
        v4u zc[CH + 2], zv[CH + 2], zb[CH];
#pragma unroll
        for (int i = 0; i < CH + 2; ++i) { const int t = t0 - 1 + i; const bool valid = (i == 0) ? (s0 > 0) : ((i == CH + 1) ? (s0 + CH < SEQ) : true);
            if (valid) { zc[i] = *(const GAS v4u*)(Z + (size_t)t * NZ + CW + 8 * lane); zv[i] = *(const GAS v4u*)(Z + (size_t)t * NZ + 2 * CW + 8 * lane); }
            else { zc[i] = (v4u){0u, 0u, 0u, 0u}; zv[i] = (v4u){0u, 0u, 0u, 0u}; } }
#pragma unroll
        for (int i = 0; i < CH; ++i) zb[i] = *(const GAS v4u*)(Z + (size_t)(t0 + i) * NZ + 8 * lane);
        float prev[8], cur[8], nxt[8];
#define CV_OF(dst, cc, vv) do { dst[0] = bflo(cc.x) * bflo(vv.x); dst[1] = bfhi(cc.x) * bfhi(vv.x); dst[2] = bflo(cc.y) * bflo(vv.y); dst[3] = bfhi(cc.y) * bfhi(vv.y); \
            dst[4] = bflo(cc.z) * bflo(vv.z); dst[5] = bfhi(cc.z) * bfhi(vv.z); dst[6] = bflo(cc.w) * bflo(vv.w); dst[7] = bfhi(cc.w) * bfhi(vv.w); } while (0)
        CV_OF(prev, zc[0], zv[0]);
        CV_OF(cur, zc[1], zv[1]);
#pragma unroll
        for (int i = 0; i < CH; ++i) {
            const int t = t0 + i;
            CV_OF(nxt, zc[i + 2], zv[i + 2]);
            const v4u bb = zb[i];
            float bg[8] = {bflo(bb.x), bfhi(bb.x), bflo(bb.y), bfhi(bb.y), bflo(bb.z), bfhi(bb.z), bflo(bb.w), bfhi(bb.w)};
            float y[8]; float ss = 0.f;
#pragma unroll
            for (int j = 0; j < 8; ++j) { y[j] = bg[j] * (w0[j] * prev[j] + w1[j] * cur[j] + w2[j] * nxt[j]); ss += y[j] * y[j]; }
            const float rs = 1.0f / sqrtf(wave_sum(ss) * (1.f / CW) + EPS);
            v4u o; o.x = pk2(y[0] * rs, y[1] * rs); o.y = pk2(y[2] * rs, y[3] * rs); o.z = pk2(y[4] * rs, y[5] * rs); o.w = pk2(y[6] * rs, y[7] * rs);
            *(GAS v4u*)(Y + (size_t)t * D + 8 * lane) = o;
#pragma unroll
            for (int j = 0; j < 8; ++j) { prev[j] = cur[j]; cur[j] = nxt[j]; }
        }
#undef CV_OF
    }
}
__device__ __forceinline__ void absorb_phase(Frame& F) {
    const bf16* KB = (const bf16*)(F.ws + WS_KB); const bf16* VB = (const bf16*)(F.ws + WS_VT); const bf16* WQN = (const bf16*)(F.ws + WS_WQN); const bf16* WOT = (const bf16*)(F.ws + WS_WOT16);
    const int lane = F.lane(), w = F.wave, li = lane & 15, q = lane >> 4;
    for (int unit = F.vcu; unit < 256; unit += F.G) {
        const int type = unit >> 7, bh = (unit >> 4) & 7, slab = unit & 15, b = bh >> 2, h = bh & 3;
        const bf16* Xp; const bf16* Yp; unsigned char* outp; int itf, jtf, dit, djt;
        if (type == 0) { Xp = WQN + (size_t)(64 * slab) * D + h * HD; Yp = KB + (size_t)(b * MEMLEN) * D + h * HD;
            outp = F.ws + WS_MK + (size_t)b * MiB + (size_t)(h * HD) * D + 64 * slab; itf = w & 3; dit = 0; jtf = (w >> 2) * 8; djt = 1; }
        else { Xp = VB + (size_t)(b * MEMLEN) * D + h * HD; Yp = WOT + (size_t)(64 * slab) * D + h * HD;
            outp = F.ws + WS_MV + (size_t)b * MiB + (size_t)(64 * slab) * D + h * HD; jtf = w & 3; djt = 0; itf = (w >> 2) * 8; dit = 1; }
#pragma unroll 2
        for (int t = 0; t < 8; ++t) { const int it = itf + dit * t, jt = jtf + djt * t;
            const bf16* xr = Xp + (size_t)(it * 16 + li) * D + 8 * q; const bf16* yr = Yp + (size_t)(jt * 16 + li) * D + 8 * q;
            bf16x8v xf[8], yf[8];
#pragma unroll
            for (int ks = 0; ks < 8; ++ks) { xf[ks] = *(const GAS bf16x8v*)(xr + 32 * ks); yf[ks] = *(const GAS bf16x8v*)(yr + 32 * ks); }
            f32x4 acc = {0.f, 0.f, 0.f, 0.f};
#pragma unroll
            for (int ks = 0; ks < 8; ++ks) acc = __builtin_amdgcn_mfma_f32_16x16x32_bf16(xf[ks], yf[ks], acc, 0, 0, 0);
            *(GAS unsigned*)(outp + (size_t)(jt * 16 + li) * D + it * 16 + 4 * q) = pg8::pk4_fp8(acc[0] * WSCALE, acc[1] * WSCALE, acc[2] * WSCALE, acc[3] * WSCALE); }
    }
}
__device__ __forceinline__ void fftC_phase(Frame& F) {
    const bf16* G = (const bf16*)(F.ws + WS_G); bf16* Y = (bf16*)(F.ws + WS_Y); const bf16* MC = (const bf16*)(F.ws + WS_MC); const bf16* DCH = (const bf16*)(F.ws + WS_TAB + TAB_DCH);
    const int tid = F.tid(), lane = F.lane(), w = F.wave, tt = w & 3, ch = w >> 2, g = lane >> 4, q = (lane & 15) >> 2, p = lane & 3;
    const float scale = 1.0f / sqrtf((float)SEQ * 64.0f);
    LAS float* ex = (LAS float*)(F.lds + 128 * FC_P);
    for (int unit = F.vcu; unit < BATCH * FN1; unit += F.G) {
        const int b = unit >> 7, s1p = unit & 127;
        __syncthreads();
        const bf16* Gt = G + (size_t)(b * FN1 + s1p) * (FN2 * 2) * CW;
#pragma unroll
        for (int i = 0; i < 16; ++i) { const int idx = i * NTHR + tid, row = idx >> 6, piece = idx & 63;
            const v4u v = *(const GAS v4u*)(Gt + (size_t)row * CW + 8 * piece);
            *(LAS v4u*)(F.lds + row * FC_P + piece * 16) = v; }
        __syncthreads();
        bf16x8v Bre[4], Bim[4];
#pragma unroll
        for (int ks = 0; ks < 4; ++ks) { const bf16* mp = MC + ((size_t)s1p * 128 + 16 * tt + (lane & 15)) * 128 + 32 * ks + 8 * (lane >> 4);
            Bre[ks] = *(const GAS bf16x8v*)mp; Bim[ks] = *(const GAS bf16x8v*)(mp + 64 * 128); }
        bf16x8v dfr[4][2][2];
#pragma unroll
        for (int ct = 0; ct < 4; ++ct)
#pragma unroll
            for (int pp = 0; pp < 2; ++pp)
#pragma unroll
                for (int hc = 0; hc < 2; ++hc) dfr[ct][pp][hc] = *(const GAS bf16x8v*)(DCH + ((((pp * 2 + hc) * 64 + 16 * ct + (lane & 15)) * 4 + (lane >> 4)) * 8));
        v2u y[4][4]; float ssq = 0.f;
#pragma unroll
        for (int g4 = 0; g4 < 4; ++g4) {
            f32x4 are[4], aim[4];
#pragma unroll
            for (int nt = 0; nt < 4; ++nt) { are[nt] = (f32x4){0.f, 0.f, 0.f, 0.f}; aim[nt] = (f32x4){0.f, 0.f, 0.f, 0.f};
#pragma unroll
                for (int ks = 0; ks < 4; ++ks) { const bf16x8v af = tr_pair(F.lds + (32 * ks + 8 * g + q) * FC_P + (256 * ch + 64 * g4 + 16 * nt) * 2 + 8 * p, 4 * FC_P);
                    are[nt] = __builtin_amdgcn_mfma_f32_16x16x32_bf16(af, Bre[ks], are[nt], 0, 0, 0);
                    aim[nt] = __builtin_amdgcn_mfma_f32_16x16x32_bf16(af, Bim[ks], aim[nt], 0, 0, 0); } }
            bf16x8v xf[2][2];
#pragma unroll
            for (int hc = 0; hc < 2; ++hc) {
                { v4u t; t.x = pk2(are[2 * hc][0], are[2 * hc][1]); t.y = pk2(are[2 * hc][2], are[2 * hc][3]); t.z = pk2(are[2 * hc + 1][0], are[2 * hc + 1][1]); t.w = pk2(are[2 * hc + 1][2], are[2 * hc + 1][3]); xf[0][hc] = __builtin_bit_cast(bf16x8v, t); }
                { v4u t; t.x = pk2(aim[2 * hc][0], aim[2 * hc][1]); t.y = pk2(aim[2 * hc][2], aim[2 * hc][3]); t.z = pk2(aim[2 * hc + 1][0], aim[2 * hc + 1][1]); t.w = pk2(aim[2 * hc + 1][2], aim[2 * hc + 1][3]); xf[1][hc] = __builtin_bit_cast(bf16x8v, t); }
            }
#pragma unroll
            for (int ct = 0; ct < 4; ++ct) { f32x4 ya = {0.f, 0.f, 0.f, 0.f};
#pragma unroll
                for (int pp = 0; pp < 2; ++pp)
#pragma unroll
                    for (int hc = 0; hc < 2; ++hc) ya = __builtin_amdgcn_mfma_f32_16x16x32_bf16(dfr[ct][pp][hc], xf[pp][hc], ya, 0, 0, 0);
                ya = ya * scale; y[g4][ct].x = pk2(ya[0], ya[1]); y[g4][ct].y = pk2(ya[2], ya[3]); ssq += (ya[0] * ya[0] + ya[1] * ya[1]) + (ya[2] * ya[2] + ya[3] * ya[3]); }
        }
        ssq += __shfl_xor(ssq, 16); ssq += __shfl_xor(ssq, 32);
        if (lane < 16) ex[w * 16 + lane] = ssq;
        __syncthreads();
        const float tot = ex[w * 16 + (lane & 15)] + ex[(w ^ 4) * 16 + (lane & 15)];
        const float rf = 1.0f / sqrtf(tot * (1.f / CW) + EPS);
        const int t = b * SEQ + s1p + 128 * (16 * tt + (lane & 15));
        bf16* yp = Y + (size_t)t * D + CW + 256 * ch + 4 * (lane >> 4);
#pragma unroll
        for (int g4 = 0; g4 < 4; ++g4)
#pragma unroll
            for (int ct = 0; ct < 4; ++ct) { const v2u p = y[g4][ct]; v2u o; o.x = pk2(bflo(p.x) * rf, bfhi(p.x) * rf); o.y = pk2(bflo(p.y) * rf, bfhi(p.y) * rf); *(GAS v2u*)(yp + 64 * g4 + 16 * ct) = o; }
    }
}
typedef float f32x16 __attribute__((ext_vector_type(16)));
constexpr int AT_P = 528;
__device__ __forceinline__ void attn_phase(Frame& F) {
    const bf16* Q = (const bf16*)(F.ws + WS_Q); const bf16* KB = (const bf16*)(F.ws + WS_KB); const bf16* VT = (const bf16*)(F.ws + WS_VT); unsigned char* O = F.ws + WS_O;
    const int tid = F.tid(), lane = F.lane(), w = F.wave, r = lane & 31, h = lane >> 5, pr = (r & ~12) | ((r & 4) << 1) | ((r & 8) >> 1);
    for (int unit = F.vcu; unit < BATCH * NH * (SEQ / 256); unit += F.G) {
        const int bh = unit >> 5, qt = unit & 31, b = bh >> 2, hh = bh & 3;
        const int t0 = b * SEQ + qt * 256 + 32 * w;
        bf16x8v qf[16];
#pragma unroll
        for (int ds = 0; ds < 16; ++ds) qf[ds] = *(const GAS bf16x8v*)(Q + (size_t)(t0 + r) * D + hh * HD + 16 * ds + 8 * h);
        __syncthreads();
#pragma unroll
        for (int i = 0; i < 16; ++i) { const int idx = i * NTHR + tid, row = idx >> 5, piece = idx & 31;
            const v4u v = *(const GAS v4u*)(KB + (size_t)(b * MEMLEN + row) * D + hh * HD + 8 * piece);
            *(LAS v4u*)(F.lds + row * AT_P + piece * 16) = v; }
        __syncthreads();
        f32x16 sacc[8];
#pragma unroll
        for (int kt = 0; kt < 8; ++kt) {
#pragma unroll
            for (int i = 0; i < 16; ++i) sacc[kt][i] = 0.f;
#pragma unroll
            for (int ds = 0; ds < 16; ++ds) { const bf16x8v kf = *(const LAS bf16x8v*)(F.lds + (32 * kt + pr) * AT_P + (16 * ds + 8 * h) * 2);
                sacc[kt] = __builtin_amdgcn_mfma_f32_32x32x16_bf16(kf, qf[ds], sacc[kt], 0, 0, 0); }
        }
        float mx = -INFINITY;
#pragma unroll
        for (int kt = 0; kt < 8; ++kt)
#pragma unroll
            for (int i = 0; i < 16; ++i) mx = fmaxf(mx, sacc[kt][i]);
        mx = fmaxf(mx, __shfl_xor(mx, 32));
        float sum = 0.f; bf16x8v pf[8][2];
#pragma unroll
        for (int kt = 0; kt < 8; ++kt)
#pragma unroll
            for (int s2 = 0; s2 < 2; ++s2) { float pv[8];
#pragma unroll
                for (int j = 0; j < 8; ++j) { pv[j] = __builtin_amdgcn_exp2f(sacc[kt][8 * s2 + j] - mx); sum += pv[j]; }
                v4u t; t.x = pk2(pv[0], pv[1]); t.y = pk2(pv[2], pv[3]); t.z = pk2(pv[4], pv[5]); t.w = pk2(pv[6], pv[7]); pf[kt][s2] = __builtin_bit_cast(bf16x8v, t); }
        sum += __shfl_xor(sum, 32);
        const float inv = 1.0f / sum;
        __syncthreads();
#pragma unroll
        for (int i = 0; i < 16; ++i) { const int idx = i * NTHR + tid, row = idx >> 5, piece = idx & 31;
            const v4u v = *(const GAS v4u*)(VT + (size_t)(hh * HD + row) * MKV + b * MEMLEN + 8 * piece);
            *(LAS v4u*)(F.lds + row * AT_P + piece * 16) = v; }
        __syncthreads();
        unsigned char* op = O + (size_t)(t0 + r) * D + hh * HD + 4 * h;
#pragma unroll
        for (int dt = 0; dt < 8; ++dt) { f32x16 oacc;
#pragma unroll
            for (int i = 0; i < 16; ++i) oacc[i] = 0.f;
#pragma unroll
            for (int kt = 0; kt < 8; ++kt)
#pragma unroll
                for (int s2 = 0; s2 < 2; ++s2) { const bf16x8v vf = *(const LAS bf16x8v*)(F.lds + (32 * dt + r) * AT_P + (32 * kt + 16 * s2 + 8 * h) * 2);
                    oacc = __builtin_amdgcn_mfma_f32_32x32x16_bf16(vf, pf[kt][s2], oacc, 0, 0, 0); }
#pragma unroll
            for (int i = 0; i < 4; ++i) *(GAS unsigned*)(op + 32 * dt + 8 * i) = pg8::pk4_fp8(oacc[4 * i] * inv, oacc[4 * i + 1] * inv, oacc[4 * i + 2] * inv, oacc[4 * i + 3] * inv);
        }
    }
}
constexpr int RT_P = 2064;
constexpr int RT_LO = 32 * RT_P, RT_PART = 2 * 32 * RT_P, RT_SQP = RT_PART + 8192, RT_RSB = RT_SQP + 256, RT_HIST = RT_RSB + 256, RT_BASE = RT_HIST + 128;
static_assert(RT_BASE + 128 <= MOE_TAB_OFF, "router LDS map");
__device__ __forceinline__ void router_phase(Frame& F, const Args& a, int blk0, unsigned long long* gs1) {
    const bf16* XR = (const bf16*)(F.ws + WS_XR); unsigned char* XN3 = F.ws + WS_XN3; const float* wrgT = (const float*)(F.ws + WS_WRG);
    int* tok_e = (int*)(F.ws + WS_TOK); float* tok_w = (float*)(F.ws + WS_TOK + 256 * 1024); int* tok_rank = (int*)(F.ws + WS_TOK + 512 * 1024);
    int* etok = (int*)(F.ws + WS_ETOK); unsigned* ctl = (unsigned*)(F.ws + WS_CTL);
    const int tid = F.tid(), lane = F.lane(), w = F.wave, tt = w & 3, kh = w >> 2, li = lane & 15, kq = lane >> 4;
    LAS float* part = (LAS float*)(F.lds + RT_PART); LAS float* sqp = (LAS float*)(F.lds + RT_SQP); LAS float* rsb = (LAS float*)(F.lds + RT_RSB);
    LAS unsigned* hist = (LAS unsigned*)(F.lds + RT_HIST); LAS unsigned* base = (LAS unsigned*)(F.lds + RT_BASE);
    const float* gain = a.in[14]; const float* brt = a.in[16];
    __syncthreads();
#pragma unroll
    for (int i = 0; i < 16; ++i) { const int idx = i * NTHR + tid, e = idx >> 8, piece = idx & 255;
        const f32x4 v = *(const GAS f32x4*)(wrgT + (size_t)e * D + 4 * piece);
        v2u hi; hi.x = pk2(v.x, v.y); hi.y = pk2(v.z, v.w);
        v2u lo; lo.x = pk2(v.x - bflo(hi.x), v.y - bfhi(hi.x)); lo.y = pk2(v.z - bflo(hi.y), v.w - bfhi(hi.y));
        *(LAS v2u*)(F.lds + e * RT_P + piece * 8) = hi; *(LAS v2u*)(F.lds + RT_LO + e * RT_P + piece * 8) = lo; }
    if (tid < NE) hist[tid] = 0u;
    if (gs1) group_sync(ctl + CW_BAR, gs1, (unsigned*)gs1 + 2, F.wave == 0 && lane_id() == 0);
    f32x4 gv[4];
#pragma unroll
    for (int j = 0; j < 4; ++j) gv[j] = ((const GAS f32x4*)gain + lane)[64 * j];
    for (int blk = blk0; blk < M / 64; blk += F.G) {
        __syncthreads();
        const int t = blk * 64 + 16 * tt + li;
        f32x4 acc[2]; acc[0] = (f32x4){0.f, 0.f, 0.f, 0.f}; acc[1] = (f32x4){0.f, 0.f, 0.f, 0.f}; float ssq = 0.f;
        const bf16* xp = XR + (size_t)t * D + 512 * kh + 8 * kq;
        bf16x8v xb[16];
#pragma unroll
        for (int ks = 0; ks < 16; ++ks) xb[ks] = *(const GAS bf16x8v*)(xp + 32 * ks);
        v2u xw[8][4];
#pragma unroll
        for (int i = 0; i < 8; ++i) { const GAS v2u* xr = (const GAS v2u*)(XR + (size_t)(blk * 64 + 8 * w + i) * D) + lane;
#pragma unroll
            for (int j = 0; j < 4; ++j) xw[i][j] = xr[64 * j]; }
#pragma unroll
        for (int ks = 0; ks < 16; ++ks) {
            { const v4u u4 = __builtin_bit_cast(v4u, xb[ks]); const float x0 = bflo(u4.x), x1 = bfhi(u4.x), x2 = bflo(u4.y), x3 = bfhi(u4.y), x4 = bflo(u4.z), x5 = bfhi(u4.z), x6 = bflo(u4.w), x7 = bfhi(u4.w);
              ssq += ((x0 * x0 + x1 * x1) + (x2 * x2 + x3 * x3)) + ((x4 * x4 + x5 * x5) + (x6 * x6 + x7 * x7)); }
#pragma unroll
            for (int mt = 0; mt < 2; ++mt) { const int off = (16 * mt + li) * RT_P + (512 * kh + 32 * ks + 8 * kq) * 2;
                const bf16x8v whi = *(const LAS bf16x8v*)(F.lds + off), wlo = *(const LAS bf16x8v*)(F.lds + RT_LO + off);
                acc[mt] = __builtin_amdgcn_mfma_f32_16x16x32_bf16(whi, xb[ks], acc[mt], 0, 0, 0);
                acc[mt] = __builtin_amdgcn_mfma_f32_16x16x32_bf16(wlo, xb[ks], acc[mt], 0, 0, 0); }
        }
        ssq += __shfl_xor(ssq, 16); ssq += __shfl_xor(ssq, 32);
        if (kh == 1) {
#pragma unroll
            for (int mt = 0; mt < 2; ++mt)
#pragma unroll
                for (int rg = 0; rg < 4; ++rg) part[(tt * 32 + 16 * mt + 4 * kq + rg) * 16 + li] = acc[mt][rg];
            if (lane < 16) sqp[tt * 16 + lane] = ssq;
        }
        __syncthreads();
        int my_e = 0; float my_w = 0.f; unsigned my_lr = 0u;
        if (kh == 0) {
            const float rs = 1.0f / sqrtf((ssq + sqp[tt * 16 + li]) * (1.f / D) + EPS);
            if (kq == 0) rsb[16 * tt + li] = rs;
            float val[8];
#pragma unroll
            for (int mt = 0; mt < 2; ++mt)
#pragma unroll
                for (int rg = 0; rg < 4; ++rg) { const int e = 16 * mt + 4 * kq + rg; val[4 * mt + rg] = (acc[mt][rg] + part[(tt * 32 + e) * 16 + li]) * rs + brt[e]; }
            float sv[4]; int se[4];
#pragma unroll
            for (int k = 0; k < TOPK; ++k) {
                float bv = val[0]; int be = 4 * kq;
#pragma unroll
                for (int i = 1; i < 8; ++i) { const int e = 16 * (i >> 2) + 4 * kq + (i & 3); if (val[i] > bv) { bv = val[i]; be = e; } }
#pragma unroll
                for (int o = 16; o < 64; o <<= 1) { const float ov = __shfl_xor(bv, o); const int oe = __shfl_xor(be, o); if (ov > bv || (ov == bv && oe < be)) { bv = ov; be = oe; } }
                sv[k] = bv; se[k] = be;
#pragma unroll
                for (int i = 0; i < 8; ++i) { const int e = 16 * (i >> 2) + 4 * kq + (i & 3); if (e == be) val[i] = -INFINITY; }
            }
            float wk[4]; float wsum = 0.f;
#pragma unroll
            for (int k = 0; k < TOPK; ++k) { wk[k] = __expf(sv[k] - sv[0]); wsum += wk[k]; }
            my_e = (kq == 0) ? se[0] : (kq == 1) ? se[1] : (kq == 2) ? se[2] : se[3];
            my_w = ((kq == 0) ? wk[0] : (kq == 1) ? wk[1] : (kq == 2) ? wk[2] : wk[3]) / wsum;
            my_lr = __hip_atomic_fetch_add(hist + my_e, 1u, __ATOMIC_RELAXED, __HIP_MEMORY_SCOPE_WORKGROUP);
        }
        __syncthreads();
        unsigned basev = 0u;
        if (tid < NE) { const unsigned c = hist[tid]; basev = c ? __hip_atomic_fetch_add(ctl + CW_CNT + 64 * tid, c, RLX_AGENT) : 0u; hist[tid] = 0u; }
#pragma unroll
        for (int i = 0; i < 8; ++i) { const int tk = blk * 64 + 8 * w + i; const float rs = rsb[8 * w + i]; GAS unsigned* o4 = (GAS unsigned*)(XN3 + (size_t)tk * D) + lane;
#pragma unroll
            for (int j = 0; j < 4; ++j) { const v2u x2 = xw[i][j]; const f32x4 g = gv[j];
                o4[64 * j] = pg8::pk4_fp8(bflo(x2.x) * rs * g.x, bfhi(x2.x) * rs * g.y, bflo(x2.y) * rs * g.z, bfhi(x2.y) * rs * g.w); } }
        if (tid < NE) base[tid] = basev;
        __syncthreads();
        if (kh == 0) { const unsigned rank = base[my_e] + my_lr;
            tok_e[t * 4 + kq] = my_e; tok_w[t * 4 + kq] = my_w; tok_rank[t * 4 + kq] = (int)rank; etok[(size_t)my_e * ECAP + rank] = t; }
    }
}
__device__ __forceinline__ int moe_tables(Frame& F) {
    LAS int* tile_e = (LAS int*)(F.lds + MOE_TAB_OFF); LAS int* tile0 = tile_e + 320; LAS int* cnt = tile0 + 40;
    const unsigned* ctl = (const unsigned*)(F.ws + WS_CTL);
    __syncthreads();
    if (F.tid() < NE) cnt[F.tid()] = (int)__hip_atomic_load(ctl + CW_CNT + 64 * F.tid(), RLX_AGENT);
    __syncthreads();
    if (F.tid() == 0) { int acc = 0; for (int e = 0; e < NE; ++e) { tile0[e] = acc; acc += (cnt[e] + 255) >> 8; } tile0[NE] = acc; }
    __syncthreads();
    const int R = tile0[NE];
    for (int rt = F.tid(); rt < R; rt += NTHR) { int e = 0; for (int q = 0; q < NE; ++q) if (rt >= tile0[q] && rt < tile0[q + 1]) e = q; tile_e[rt] = e; }
    __syncthreads();
    return R;
}
__device__ __forceinline__ void combine_phase(Frame& F, const Args& a) {
    const bf16* XR = (const bf16*)(F.ws + WS_XR); const unsigned char* CTR = F.ws + WS_CTR;
    const int* tok_e = (const int*)(F.ws + WS_TOK); const float* tok_w = (const float*)(F.ws + WS_TOK + 256 * 1024); const int* tok_rank = (const int*)(F.ws + WS_TOK + 512 * 1024);
    LAS int* tile0 = (LAS int*)(F.lds + MOE_TAB_OFF) + 320;
    const int gw = F.vcu * NWAVES + F.wave, NGW = F.G * NWAVES, lane = F.lane();
    const float* gain = a.in[21];
    constexpr int TPW = 8;
    const GAS f32x4* gr = (const GAS f32x4*)gain; const f32x4 gv[4] = {gr[2 * lane], gr[2 * lane + 1], gr[128 + 2 * lane], gr[128 + 2 * lane + 1]};
    for (int tb = gw * TPW; tb < M; tb += NGW * TPW) {
        int myslot = 0; float myw = 0.f;
        if (lane < 4 * TPW) { const int q = (tb + (lane >> 2)) * 4 + (lane & 3); const int e = tok_e[q]; myw = tok_w[q]; myslot = tile0[e] * 256 + tok_rank[q]; }
#pragma unroll 4
        for (int i = 0; i < TPW; ++i) {
            const int t = tb + i;
            const GAS v4u* xr = (const GAS v4u*)(XR + (size_t)t * D);
            v4u xw[2]; v2u cw[4][2]; float wk[4];
            xw[0] = xr[lane]; xw[1] = xr[64 + lane];
#pragma unroll
            for (int k = 0; k < TOPK; ++k) { const int slot = __builtin_amdgcn_readlane(myslot, 4 * i + k); wk[k] = __builtin_bit_cast(float, __builtin_amdgcn_readlane(__builtin_bit_cast(int, myw), 4 * i + k));
                const GAS v2u* cp = (const GAS v2u*)(CTR + (size_t)slot * D); cw[k][0] = cp[lane]; cw[k][1] = cp[64 + lane]; }
            f32x4 v[4]; float s = 0.f;
#pragma unroll
            for (int h = 0; h < 2; ++h) { v[2 * h] = (f32x4){bflo(xw[h].x), bfhi(xw[h].x), bflo(xw[h].y), bfhi(xw[h].y)}; v[2 * h + 1] = (f32x4){bflo(xw[h].z), bfhi(xw[h].z), bflo(xw[h].w), bfhi(xw[h].w)};
#pragma unroll
                for (int k = 0; k < TOPK; ++k) {
#pragma unroll
                    for (int u = 0; u < 2; ++u) { const int cwd = (int)(u ? cw[k][h].y : cw[k][h].x); const f32x2v lo = __builtin_amdgcn_cvt_pk_f32_fp8(cwd, false), hi = __builtin_amdgcn_cvt_pk_f32_fp8(cwd, true);
                        v[2 * h + u].x += wk[k] * lo.x; v[2 * h + u].y += wk[k] * lo.y; v[2 * h + u].z += wk[k] * hi.x; v[2 * h + u].w += wk[k] * hi.y; } }
#pragma unroll
                for (int u = 0; u < 2; ++u) s += (v[2 * h + u].x * v[2 * h + u].x + v[2 * h + u].y * v[2 * h + u].y) + (v[2 * h + u].z * v[2 * h + u].z + v[2 * h + u].w * v[2 * h + u].w); }
            const float rs = 1.0f / sqrtf(wave_sum(s) * (1.f / D) + EPS);
            GAS f32x4* op = (GAS f32x4*)(a.out + (size_t)t * D);
#pragma unroll
            for (int h = 0; h < 2; ++h)
#pragma unroll
                for (int u = 0; u < 2; ++u) { const f32x4 g = gv[2 * h + u], w4 = v[2 * h + u]; op[128 * h + 2 * lane + u] = (f32x4){w4.x * rs * g.x, w4.y * rs * g.y, w4.z * rs * g.z, w4.w * rs * g.w}; }
        }
    }
}

struct MoeSel { int nM, lo, start, stride, limit, xhas, xnM, xlo, xslot; };
__device__ __forceinline__ bool moe_plan(int R, int G, int y, int w, int which, MoeSel& s) {
    if (G != 256 || R <= 256 || R > 288) return false;
    int NI = 0, pre = 0; bool bad = false;
#pragma unroll
    for (int yy = 0; yy < 8; ++yy) { const int l0 = (yy * R) >> 3, nj = (((yy + 1) * R) >> 3) - l0, left = 8 * nj - 256;
        bad = bad || left < 0 || left > 32; NI += 32 - left; pre += (yy < y) ? 32 - left : 0; }
    if (bad || NI < 4 * R - 1024) return false;
    if (which < 0) return true;
    const int l0 = (y * R) >> 3, nj = (((y + 1) * R) >> 3) - l0, left = 8 * nj - 256;
    s.nM = nj; s.lo = l0; s.start = w; s.stride = 32; s.xhas = 0; s.xnM = 0; s.xlo = 0; s.xslot = 0;
    if (which == 0) { s.limit = 8 * nj; return true; }
    s.limit = 128;
    if (w >= left) { int e = pre + (w - left); bool found = false;
#pragma unroll
        for (int yy = 0; yy < 8; ++yy) { const int m0 = (yy * R) >> 3, mj = (((yy + 1) * R) >> 3) - m0, Ex = 4 * mj - 128;
            if (!found) { if (e < Ex) { found = true; s.xhas = 1; s.xnM = mj; s.xlo = m0; s.xslot = 128 + e; } else e -= Ex; } } }
    return true;
}

constexpr int NPHASE = 14;
__global__ void __launch_bounds__(NTHR, 2) mk_fwd(Args args) {
    extern __shared__ __attribute__((aligned(16))) unsigned char lds[];
    Frame F;
    F.lds = (LAS unsigned char*)lds; F.ws = args.ws;
    F.wave = __builtin_amdgcn_readfirstlane((int)threadIdx.x >> 6);
    F.G = gridDim.x; { const int bx = blockIdx.x; F.vcu = (F.G % 8 == 0) ? (bx % 8) * (F.G / 8) + bx / 8 : bx; }
    unsigned char* ws = args.ws;
    for (int u = F.tid(); u < (LDS_BYTES - LDSCTL_OFF) / 4; u += NTHR) ((LAS unsigned*)(F.lds + LDSCTL_OFF))[u] = 0u;
    __syncthreads();
    volatile LAS unsigned* MISC = (volatile LAS unsigned*)(F.lds + MISC_OFF);
    XcdBarrier bar; bar.bar = (unsigned*)(ws + WS_CTL) + CW_BAR; bar.x = 0; bar.st = nullptr;
#if MK_ONE_LAUNCH
    bar = xcd_barrier_post((unsigned*)(ws + WS_CTL) + CW_BAR, MISC + 8, F.wave == 0 && lane_id() == 0);
#define GRID_BAR() xcd_barrier(bar, F.wave == 0 && lane_id() == 0)
#else
#define GRID_BAR() do { } while (0)
#endif
    const int lo = args.ph_lo, hi = args.ph_hi;
#define IN(k) (lo <= (k) && (k) < hi)
#define REP(k) for (int _rep = 0; _rep < (((MK_DUP) >> (k)) & 1) + 1; ++_rep)
#define SEAM(k) do { if (IN(k) && IN((k) + 1)) GRID_BAR(); } while (0)
    int gpm = 0, gpn = 0; const bool lsync = MK_ONE_LAUNCH && (F.G == (M / 256) * (D / 256));
    if (lsync) { pg8::StaticOrder S0; S0.init(M, D, F.G, (int)blockIdx.x); pg8::Unit u0; (void)S0.next(0, u0); gpm = u0.pm; gpn = u0.pn; }
#define GSW(s) ((unsigned long long*)((unsigned*)(ws + WS_CTL) + CW_GRP + 64 * (64 * (s) + gpm)))
#define LSEAM(k, s) do { if (IN(k) && IN((k) + 1)) { if (lsync) group_sync((unsigned*)(ws + WS_CTL) + CW_BAR, GSW(s), (unsigned*)GSW(s) + 2, F.wave == 0 && lane_id() == 0); else GRID_BAR(); } } while (0)
    using pg8::Gemm; using pg8::StaticOrder; using pg8::GroupedOrder; using pg8::gemm_phase; using pg8::bf16_t; using pg8::EpiBf16; using pg8::EpiRowScaleBf16; using pg8::EpiResidIn; using pg8::EpiResidBf; using pg8::EpiSwiGLU; using pg8::EpiBiasF8; using pg8::EpiSoftmaxF8;
    if (IN(0)) REP(0) { p0_prologue(F, args); } SEAM(0);
    if (IN(1)) REP(1) { Gemm g{(const bf16_t*)(ws + WS_XN), (const bf16_t*)(ws + WS_WINT), D, 0}; StaticOrder S; S.init(M, NZ, F.G, (int)blockIdx.x);
        const bool split = (F.G % 16) == 0; const int grp = split ? (((int)blockIdx.x >> 3) & 1) : 0, ng = split ? F.G / 2 : F.G;
        const int gi = split ? (((int)blockIdx.x >> 4) * 8 + ((int)blockIdx.x & 7)) : (int)blockIdx.x, mlo = (split && grp) ? MOE_ITEMS / 2 : 0, mhi = (split && !grp) ? MOE_ITEMS / 2 : MOE_ITEMS;
        if (grp == 0) { p0_moe_stream(F, args, mlo, mhi, gi * NWAVES + F.wave, ng * NWAVES); __syncthreads(); }
        EpiBf16 E{(bf16_t*)(ws + WS_Z), NZ, 1.0f}; gemm_phase<EpiBf16, StaticOrder, true>(F.lds, g, S, E, F.wave);
        if (grp == 1) { __syncthreads(); p0_moe_stream(F, args, mlo, mhi, gi * NWAVES + F.wave, ng * NWAVES); } } SEAM(1);
    if (IN(3)) REP(3) {
        const bool split = F.G >= 64;
        if (!split || blockIdx.x < 16) {
            { Gemm g{(const bf16_t*)(ws + WS_MEMN), (const bf16_t*)(ws + WS_WKT), D / 2, 0}; StaticOrder S; S.init(MKV, D, F.G, (int)blockIdx.x);
              EpiBf16 E{(bf16_t*)(ws + WS_KB), D, 1.0f / WSCALE}; gemm_phase<EpiBf16, StaticOrder, true, true>(F.lds, g, S, E, F.wave); }
            { Gemm g{(const bf16_t*)(ws + WS_MEMN), (const bf16_t*)(ws + WS_WVT), D / 2, 0}; StaticOrder S; S.init(MKV, D, F.G, (int)((blockIdx.x + F.G - 8) % F.G));
              EpiBf16 E{(bf16_t*)(ws + WS_VT), D, 1.0f / WSCALE}; gemm_phase<EpiBf16, StaticOrder, true, true>(F.lds, g, S, E, F.wave); }
        }
        if (!split) conv_phase(F, args, F.vcu, F.G); else if (blockIdx.x >= 16) conv_phase(F, args, (int)blockIdx.x - 16, F.G - 16);
        fftA_phase(F); } SEAM(3);
    if (IN(4)) REP(4) { absorb_phase(F); fftC_phase(F); } SEAM(4);
    if (IN(6)) REP(6) { Gemm g{(const bf16_t*)(ws + WS_Y), (const bf16_t*)(ws + WS_WOUTT), D, 0}; StaticOrder S; S.init(M, D, F.G, (int)blockIdx.x);
        EpiResidIn E{args.in[0], (bf16_t*)(ws + WS_XR), ws + WS_XB, (float*)(ws + WS_CTL) + CW_ROWSQ, D}; gemm_phase<EpiResidIn, StaticOrder, false>(F.lds, g, S, E, F.wave); } LSEAM(6, 0);
    if (IN(7)) REP(7) { Gemm g{(const bf16_t*)(ws + WS_XB), (const bf16_t*)(ws + WS_MK), D / 2, MiB}; StaticOrder S; S.init(M, D, F.G, (int)blockIdx.x, 5);
        EpiSoftmaxF8 E{ws + WS_P, D, (const float*)(ws + WS_CTL) + CW_ROWSQ, 1.0f / D, EPS, QSCALE / WSCALE, (LAS float*)(F.lds + RING_BYTES)}; gemm_phase<EpiSoftmaxF8, StaticOrder, true, true>(F.lds, g, S, E, F.wave); } LSEAM(7, 1);
    if (IN(9)) REP(9) { Gemm g{(const bf16_t*)(ws + WS_P), (const bf16_t*)(ws + WS_MV), D / 2, MiB}; StaticOrder S; S.init(M, D, F.G, (int)blockIdx.x, 5);
        EpiResidBf E{(bf16_t*)(ws + WS_XR), D, 1.0f / (128.0f * WSCALE)}; gemm_phase<EpiResidBf, StaticOrder, false, true>(F.lds, g, S, E, F.wave); } if (!lsync) SEAM(9);
    if (IN(10)) REP(10) { router_phase(F, args, lsync ? 4 * gpm + gpn : F.vcu, (lsync && IN(9)) ? GSW(2) : nullptr); } SEAM(10);
    if (IN(11) || IN(12)) {
        const int R = moe_tables(F);
        LAS int* tile_e = (LAS int*)(F.lds + MOE_TAB_OFF);
        const int cy = (int)blockIdx.x & 7, cw = (int)blockIdx.x >> 3;
        bool df; { MoeSel m0; df = MK_ONE_LAUNCH && IN(11) && IN(12) && moe_plan(R, F.G, cy, cw, -1, m0); }
        unsigned* ctlw = (unsigned*)(ws + WS_CTL);
        if (IN(11)) { MoeSel ms = {0, 0, 0, 0, 0, 0, 0, 0, 0}; if (df) (void)moe_plan(R, F.G, cy, cw, 0, ms);
            GroupedOrder<true> S; S.nM = df ? ms.nM : R; S.nN = 2 * DE / 256; S.nwg = R * S.nN; S.G = F.G; S.c = (int)blockIdx.x; S.own = df ? 1 : 0; S.lo = ms.lo; S.start = ms.start; S.stride = ms.stride; S.limit = ms.limit;
            S.xhas = 0; S.xnM = 0; S.xlo = 0; S.xslot = 0; S.done = df ? ctlw + CW_DONE : nullptr; S.tmo = ctlw + CW_BAR + XB_TMO;
            S.tile_e = tile_e; S.tile0 = tile_e + 320; S.cnt = tile_e + 360; S.etok = (const int*)(ws + WS_ETOK); S.ecap = ECAP;
            { LAS int* rowtok = (LAS int*)(F.lds + RING_BYTES); pg8::Unit u;
              for (int ui = 0; ui < 12 && S.next(ui, u); ++ui) if (F.tid() < 256) { const int idx = (u.pm - S.tile0[u.e]) * 256 + F.tid(); rowtok[ui * 256 + F.tid()] = idx < S.cnt[u.e] ? S.etok[(size_t)u.e * ECAP + idx] : 0; }
              __syncthreads(); S.rowtok = rowtok; }
            Gemm g{(const bf16_t*)(ws + WS_XN3), (const bf16_t*)(ws + WS_WGUT), D / 2, WGU6_E};
            EpiSwiGLU E{ws + WS_ACT, args.in[18], 1.0f / W6SCALE, df}; gemm_phase<EpiSwiGLU, GroupedOrder<true>, true, 2>(F.lds, g, S, E, F.wave); }
        if (!df) SEAM(11);
        if (IN(12)) { MoeSel ms = {0, 0, 0, 0, 0, 0, 0, 0, 0}; if (df) (void)moe_plan(R, F.G, cy, cw, 1, ms);
            GroupedOrder<false> S; S.nM = df ? ms.nM : R; S.nN = D / 256; S.nwg = R * S.nN; S.G = F.G; S.c = (int)blockIdx.x; S.own = df ? 1 : 0; S.lo = ms.lo; S.start = ms.start; S.stride = ms.stride; S.limit = ms.limit;
            S.xhas = ms.xhas; S.xnM = ms.xnM; S.xlo = ms.xlo; S.xslot = ms.xslot; S.done = df ? ctlw + CW_DONE : nullptr; S.tmo = ctlw + CW_BAR + XB_TMO;
            S.tile_e = tile_e; S.tile0 = tile_e + 320; S.cnt = tile_e + 360; S.etok = nullptr; S.ecap = ECAP; S.rowtok = nullptr;
            Gemm g{(const bf16_t*)(ws + WS_ACT), (const bf16_t*)(ws + WS_WDT), DE / 2, WDN6_E};
            EpiBiasF8 E{ws + WS_CTR, args.in[20], 1.0f / W6SCALE}; gemm_phase<EpiBiasF8, GroupedOrder<false>, true, 2>(F.lds, g, S, E, F.wave); }
        SEAM(12);
    }
    if (IN(13)) REP(13) { (void)moe_tables(F); combine_phase(F, args); }
#undef IN
#undef SEAM
}

extern "C" void kernel_launch(void* const* d_in, const int* in_sizes, int n_in, void* d_out, int out_size, void* d_ws, size_t ws_size, hipStream_t stream) {
    static int grid = 0;
    if (grid == 0) {
        if (n_in != 22 || in_sizes[0] != M * D || out_size != M * D || ws_size < WS_END) { fprintf(stderr, "kernel_launch: unexpected problem (n_in %d, in0 %d, out %d, ws %zu)\n", n_in, n_in > 0 ? in_sizes[0] : -1, out_size, ws_size); grid = -1; return; }
        int dev = 0, cus = 0;
        if (hipGetDevice(&dev) != hipSuccess || hipDeviceGetAttribute(&cus, hipDeviceAttributeMultiprocessorCount, dev) != hipSuccess) { grid = -1; return; }
        if (hipFuncSetAttribute((const void*)mk_fwd, hipFuncAttributeMaxDynamicSharedMemorySize, LDS_BYTES) != hipSuccess) { fprintf(stderr, "kernel_launch: hipFuncSetAttribute failed\n"); grid = -1; return; }
        int per_cu = 0;
        if (hipOccupancyMaxActiveBlocksPerMultiprocessor(&per_cu, (const void*)mk_fwd, NTHR, LDS_BYTES) != hipSuccess || per_cu < 1) fprintf(stderr, "kernel_launch: occupancy query reports %d\n", per_cu);
        (void)hipGetLastError();
        grid = cus;
    }
    if (grid < 0) return;
    if (hipMemsetAsync((char*)d_ws + WS_CTL, 0, CTL_ZERO_BYTES, stream) != hipSuccess) return;
    Args a{};
    for (int i = 0; i < 22; ++i) a.in[i] = (const float*)d_in[i];
    a.out = (float*)d_out; a.ws = (unsigned char*)d_ws;
#if MK_ONE_LAUNCH
    a.ph_lo = 0; a.ph_hi = NPHASE;
    hipLaunchKernelGGL(mk_fwd, dim3(grid), dim3(NTHR), LDS_BYTES, stream, a);
#else
    for (int p = 0; p < NPHASE; ++p) { a.ph_lo = p; a.ph_hi = p + 1; hipLaunchKernelGGL(mk_fwd, dim3(grid), dim3(NTHR), LDS_BYTES, stream, a); }
#endif
}
```

```cpp
#include <hip/hip_runtime.h>
#include <cstdio>
#include <cstdint>

#ifndef MK_ONE_LAUNCH
#define MK_ONE_LAUNCH 1
#endif
#ifndef MK_DUP
#define MK_DUP 0
#endif

__device__ __forceinline__ int lane_id() { return (int)__builtin_amdgcn_mbcnt_hi(~0u, __builtin_amdgcn_mbcnt_lo(~0u, 0u)) & 63; }
namespace pg8 {
#define PG8_LAS __attribute__((address_space(3)))
typedef unsigned short bf16_t;
typedef short bf16x8 __attribute__((ext_vector_type(8)));
typedef float f32x4 __attribute__((ext_vector_type(4)));
typedef unsigned u32x4 __attribute__((ext_vector_type(4)));
typedef unsigned u32x2 __attribute__((ext_vector_type(2)));
constexpr int BM = 256, BK = 64, HALF = 128, HTB = HALF * BK * 2, STAGE_BYTES = 8 * HTB, NXCD = 8, WGM = 8;

__host__ __device__ __forceinline__ int lds_byte(int r, int c) { const int st = (r >> 4) * 2 + (c >> 5), rr = r & 15, cc = c & 31, ob = rr * 64 + cc * 2; return st * 1024 + (ob ^ (((ob >> 9) & 1) << 5)); }
__host__ __device__ __forceinline__ void stage_rc(int b, int& R, int& C) { const int st = b / 1024, sb = b % 1024, swz = sb ^ (((sb >> 9) & 1) << 5); R = (st >> 1) * 16 + swz / 64; C = (st & 1) * 32 + (swz % 64) / 2; }
__host__ __device__ __forceinline__ int perm32(int rho) { const int n = rho >> 4, i = rho & 15; return 8 * (i >> 2) + 4 * n + (i & 3); }

struct Unit { int pm, pn, e; };
struct Gemm { const bf16_t* A; const bf16_t* Bt; int K; size_t bstride; };

struct StaticOrder {
    static constexpr bool GATHER = false;
    int nM, nN, nwg, G, c, eshift;
    __device__ __forceinline__ void init(int M, int N, int G_, int c_, int eshift_ = -1) { nM = M / BM; nN = N / BM; nwg = nM * nN; G = G_; c = c_; eshift = eshift_; }
    __device__ __forceinline__ bool next(int i, Unit& u) const {
        const long L = (long)i * G + c; if (L >= nwg) return false;
        int wgid = (int)L; { const int q = nwg / NXCD, r = nwg % NXCD, xcd = wgid % NXCD, off = wgid / NXCD; wgid = (xcd < r ? xcd * (q + 1) : r * (q + 1) + (xcd - r) * q) + off; }
        const int nig = WGM * nN, gid = wgid / nig, fm = gid * WGM, gsz = (nM - fm) < WGM ? (nM - fm) : WGM;
        u.pm = fm + ((wgid % nig) % gsz); u.pn = (wgid % nig) / gsz; u.e = eshift >= 0 ? (u.pm >> eshift) : 0; return true;
    }
    __device__ __forceinline__ int arow(int, int) const { return 0; }
};
template <bool GATHER_>
struct GroupedOrder {
    static constexpr bool GATHER = GATHER_;
    int nM, nN, nwg, G, c;
    int own, lo, start, stride, limit, xhas, xnM, xlo, xslot;
    unsigned* done; unsigned* tmo;
    const PG8_LAS int* tile_e;
    const PG8_LAS int* tile0;
    const PG8_LAS int* cnt;
    const int* etok;
    int ecap;
    __device__ __forceinline__ bool next(int i, Unit& u) const {
        int wgid, nMl = nM, lol = 0;
        if (own) { const int s = start + i * stride;
            if (s < limit) { wgid = s; lol = lo; }
            else { const int nmain = start < limit ? (limit - start + stride - 1) / stride : 0; if (!xhas || i != nmain) return false; wgid = xslot; nMl = xnM; lol = xlo; } }
        else { const long L = (long)i * G + c; if (L >= nwg) return false;
            wgid = (int)L; { const int q = nwg / NXCD, r = nwg % NXCD, xcd = wgid % NXCD, off = wgid / NXCD; wgid = (xcd < r ? xcd * (q + 1) : r * (q + 1) + (xcd - r) * q) + off; } }
        const int nig = WGM * nN, gid = wgid / nig, fm = gid * WGM, gsz = (nMl - fm) < WGM ? (nMl - fm) : WGM;
        u.pm = lol + fm + ((wgid % nig) % gsz); u.pn = (wgid % nig) / gsz; u.e = tile_e[u.pm];
        if constexpr (!GATHER_) { if (done) { const unsigned* dp = done + 64 * u.pm; unsigned sp = 0;
            while (__hip_atomic_load(dp, __ATOMIC_RELAXED, __HIP_MEMORY_SCOPE_AGENT) < 8u) { __builtin_amdgcn_s_sleep(2); if ((++sp & 255u) == 0u && (__hip_atomic_load(tmo, __ATOMIC_RELAXED, __HIP_MEMORY_SCOPE_AGENT) || sp > (1u << 18))) break; } } }
        return true;
    }
    const PG8_LAS int* rowtok;
    __device__ __forceinline__ int arow(int ui, int r) const { return rowtok[ui * BM + r]; }
};

typedef float f32x2_t __attribute__((ext_vector_type(2)));
typedef float f32x16_t __attribute__((ext_vector_type(16)));
typedef unsigned u32x6 __attribute__((ext_vector_type(6)));
__device__ __forceinline__ u32x6 pk32_fp6(const f32x16_t s0, const f32x16_t s1) { return __builtin_amdgcn_cvt_scalef32_2xpk16_fp6_f32(s0, s1, 1.0f); }
typedef __bf16 bf16x2_t __attribute__((ext_vector_type(2)));
__device__ __forceinline__ unsigned cvt_pk_bf16(float lo, float hi) { const f32x2_t v = {lo, hi}; return __builtin_bit_cast(unsigned, __builtin_convertvector(v, bf16x2_t)); }

__device__ __forceinline__ unsigned pk4_fp8(float a, float b, float c, float d) { int v = __builtin_amdgcn_cvt_pk_fp8_f32(a, b, 0, false); v = __builtin_amdgcn_cvt_pk_fp8_f32(c, d, v, true); return (unsigned)v; }
struct EpiBf16 {
    struct Pre {}; __device__ __forceinline__ Pre pre(const Unit&, int, int, int, int) const { return Pre{}; }
    static constexpr bool PERM = true;
    bf16_t* O; int ldc; float scale;
    __device__ __forceinline__ void operator()(const f32x4 (&acc)[2][2][4][2], const Unit& u, int wr, int wc, int fr, int fq, const Pre& P) const {
        const int row0 = u.pm * BM + wr * 64 + fr, col0 = u.pn * BM + wc * 32 + 8 * fq;
#pragma unroll
        for (int ai = 0; ai < 2; ++ai)
#pragma unroll
            for (int m = 0; m < 4; ++m) { bf16_t* rowp = O + (size_t)(row0 + ai * HALF + m * 16) * ldc + col0;
#pragma unroll
                for (int bj = 0; bj < 2; ++bj) { const f32x4 v0 = acc[ai][bj][m][0] * scale, v1 = acc[ai][bj][m][1] * scale;
                    u32x4 w; w.x = cvt_pk_bf16(v0[0], v0[1]); w.y = cvt_pk_bf16(v0[2], v0[3]); w.z = cvt_pk_bf16(v1[0], v1[1]); w.w = cvt_pk_bf16(v1[2], v1[3]);
                    *(u32x4*)(rowp + bj * HALF) = w; } }
    }
};
struct EpiRowScaleBf16 {
    struct Pre { float rq[2][4]; };
    __device__ __forceinline__ Pre pre(const Unit& u, int wr, int, int fr, int) const { Pre p; const int row0 = u.pm * BM + wr * 64 + fr;
        _Pragma("unroll") for (int ai = 0; ai < 2; ++ai) _Pragma("unroll") for (int m = 0; m < 4; ++m) p.rq[ai][m] = rowsq[row0 + ai * HALF + m * 16]; return p; }
    static constexpr bool PERM = true;
    bf16_t* O; int ldc; const float* rowsq; float inv_n, eps, scale;
    __device__ __forceinline__ void operator()(const f32x4 (&acc)[2][2][4][2], const Unit& u, int wr, int wc, int fr, int fq, const Pre& P) const {
        const int row0 = u.pm * BM + wr * 64 + fr, col0 = u.pn * BM + wc * 32 + 8 * fq;
#pragma unroll
        for (int ai = 0; ai < 2; ++ai)
#pragma unroll
            for (int m = 0; m < 4; ++m) { const int r = row0 + ai * HALF + m * 16; const float s = __builtin_amdgcn_rsqf(P.rq[ai][m] * inv_n + eps) * scale;
                bf16_t* rowp = O + (size_t)r * ldc + col0;
#pragma unroll
                for (int bj = 0; bj < 2; ++bj) { const f32x4 v0 = acc[ai][bj][m][0] * s, v1 = acc[ai][bj][m][1] * s;
                    u32x4 w; w.x = cvt_pk_bf16(v0[0], v0[1]); w.y = cvt_pk_bf16(v0[2], v0[3]); w.z = cvt_pk_bf16(v1[0], v1[1]); w.w = cvt_pk_bf16(v1[2], v1[3]);
                    *(u32x4*)(rowp + bj * HALF) = w; } }
    }
};
struct EpiResidIn {
    struct Pre {}; __device__ __forceinline__ Pre pre(const Unit&, int, int, int, int) const { return Pre{}; }
    static constexpr bool PERM = true;
    const float* base; bf16_t* xo; unsigned char* x8; float* rowsq; int ldc;
    __device__ __forceinline__ void operator()(const f32x4 (&acc)[2][2][4][2], const Unit& u, int wr, int wc, int fr, int fq, const Pre& P) const {
        const int row0 = u.pm * BM + wr * 64 + fr, col0 = u.pn * BM + wc * 32 + 8 * fq;
#pragma unroll
        for (int ai = 0; ai < 2; ++ai) {
            f32x4 b[4][2][2];
#pragma unroll
            for (int m = 0; m < 4; ++m)
#pragma unroll
                for (int bj = 0; bj < 2; ++bj)
#pragma unroll
                    for (int n = 0; n < 2; ++n) b[m][bj][n] = *(const f32x4*)(base + (size_t)(row0 + ai * HALF + m * 16) * ldc + col0 + bj * HALF + 4 * n);
#pragma unroll
            for (int m = 0; m < 4; ++m) { const int r = row0 + ai * HALF + m * 16; const size_t off = (size_t)r * ldc + col0; float ss = 0.f;
#pragma unroll
                for (int bj = 0; bj < 2; ++bj) { const f32x4 v0 = b[m][bj][0] + acc[ai][bj][m][0], v1 = b[m][bj][1] + acc[ai][bj][m][1];
                    u32x4 w; w.x = cvt_pk_bf16(v0[0], v0[1]); w.y = cvt_pk_bf16(v0[2], v0[3]); w.z = cvt_pk_bf16(v1[0], v1[1]); w.w = cvt_pk_bf16(v1[2], v1[3]);
                    *(u32x4*)(xo + off + bj * HALF) = w;
                    u32x2 q; q.x = pk4_fp8(v0[0], v0[1], v0[2], v0[3]); q.y = pk4_fp8(v1[0], v1[1], v1[2], v1[3]); *(u32x2*)(x8 + off + bj * HALF) = q;
                    ss += ((v0[0] * v0[0] + v0[1] * v0[1]) + (v0[2] * v0[2] + v0[3] * v0[3])) + ((v1[0] * v1[0] + v1[1] * v1[1]) + (v1[2] * v1[2] + v1[3] * v1[3])); }
                ss += __shfl_xor(ss, 16); ss += __shfl_xor(ss, 32); if (fq == 0) atomicAdd(rowsq + r, ss); }
            asm volatile("" ::: "memory"); }
    }
};
struct EpiResidBf {
    struct Pre {}; __device__ __forceinline__ Pre pre(const Unit&, int, int, int, int) const { return Pre{}; }
    static constexpr bool PERM = true;
    bf16_t* x; int ldc; float ascale;
    __device__ __forceinline__ void operator()(const f32x4 (&acc)[2][2][4][2], const Unit& u, int wr, int wc, int fr, int fq, const Pre& P) const {
        const int row0 = u.pm * BM + wr * 64 + fr, col0 = u.pn * BM + wc * 32 + 8 * fq;
        u32x4 b[2][4][2];
#pragma unroll
        for (int ai = 0; ai < 2; ++ai)
#pragma unroll
            for (int m = 0; m < 4; ++m)
#pragma unroll
                for (int bj = 0; bj < 2; ++bj) b[ai][m][bj] = *(const u32x4*)(x + (size_t)(row0 + ai * HALF + m * 16) * ldc + col0 + bj * HALF);
#pragma unroll
        for (int ai = 0; ai < 2; ++ai)
#pragma unroll
            for (int m = 0; m < 4; ++m) { const size_t off = (size_t)(row0 + ai * HALF + m * 16) * ldc + col0;
#pragma unroll
                for (int bj = 0; bj < 2; ++bj) { const f32x4 a0 = acc[ai][bj][m][0] * ascale, a1 = acc[ai][bj][m][1] * ascale; const u32x4 p = b[ai][m][bj];
                    u32x4 w; w.x = cvt_pk_bf16(__builtin_bit_cast(float, p.x << 16) + a0[0], __builtin_bit_cast(float, p.x & 0xffff0000u) + a0[1]);
                    w.y = cvt_pk_bf16(__builtin_bit_cast(float, p.y << 16) + a0[2], __builtin_bit_cast(float, p.y & 0xffff0000u) + a0[3]);
                    w.z = cvt_pk_bf16(__builtin_bit_cast(float, p.z << 16) + a1[0], __builtin_bit_cast(float, p.z & 0xffff0000u) + a1[1]);
                    w.w = cvt_pk_bf16(__builtin_bit_cast(float, p.w << 16) + a1[2], __builtin_bit_cast(float, p.w & 0xffff0000u) + a1[3]);
                    *(u32x4*)(x + off + bj * HALF) = w; } }
    }
};
struct EpiSoftmaxF8 {
    static constexpr bool PERM = true;
    struct Pre { float rq[2][4]; };
    __device__ __forceinline__ Pre pre(const Unit& u, int wr, int, int fr, int) const { Pre p; const int row0 = u.pm * BM + wr * 64 + fr;
        _Pragma("unroll") for (int ai = 0; ai < 2; ++ai) _Pragma("unroll") for (int m = 0; m < 4; ++m) p.rq[ai][m] = rowsq[row0 + ai * HALF + m * 16]; return p; }
    unsigned char* O; int ldc; const float* rowsq; float inv_n, eps, sscale; PG8_LAS float* xch;
    __device__ __forceinline__ void operator()(f32x4 (&acc)[2][2][4][2], const Unit& u, int wr, int wc, int fr, int fq, const Pre& P) const {
        const int row0 = u.pm * BM + wr * 64 + fr, col0 = u.pn * BM + wc * 32 + 8 * fq, rl0 = wr * 64 + fr;
        float f[2][4];
#pragma unroll
        for (int ai = 0; ai < 2; ++ai)
#pragma unroll
            for (int m = 0; m < 4; ++m) { f[ai][m] = __builtin_amdgcn_rsqf(P.rq[ai][m] * inv_n + eps) * sscale; float mx = -INFINITY;
#pragma unroll
                for (int bj = 0; bj < 2; ++bj)
#pragma unroll
                    for (int n = 0; n < 2; ++n) { const f32x4 v = acc[ai][bj][m][n]; mx = fmaxf(mx, fmaxf(fmaxf(v[0], v[1]), fmaxf(v[2], v[3]))); }
                mx = fmaxf(mx, __shfl_xor(mx, 16)); mx = fmaxf(mx, __shfl_xor(mx, 32));
                if (fq == 0) xch[(rl0 + ai * HALF + m * 16) * 4 + wc] = mx * f[ai][m]; }
        asm volatile("s_waitcnt lgkmcnt(0)" ::: "memory"); __builtin_amdgcn_s_barrier(); asm volatile("" ::: "memory");
#pragma unroll
        for (int ai = 0; ai < 2; ++ai)
#pragma unroll
            for (int m = 0; m < 4; ++m) { const f32x4 x4 = *(const PG8_LAS f32x4*)(xch + (rl0 + ai * HALF + m * 16) * 4); const float M = fmaxf(fmaxf(x4[0], x4[1]), fmaxf(x4[2], x4[3])); float sm = 0.f;
#pragma unroll
                for (int bj = 0; bj < 2; ++bj)
#pragma unroll
                    for (int n = 0; n < 2; ++n) { f32x4 v = acc[ai][bj][m][n];
#pragma unroll
                        for (int i = 0; i < 4; ++i) { v[i] = __builtin_amdgcn_exp2f(v[i] * f[ai][m] - M); sm += v[i]; }
                        acc[ai][bj][m][n] = v; }
                sm += __shfl_xor(sm, 16); sm += __shfl_xor(sm, 32);
                if (fq == 0) xch[1024 + (rl0 + ai * HALF + m * 16) * 4 + wc] = sm; }
        asm volatile("s_waitcnt lgkmcnt(0)" ::: "memory"); __builtin_amdgcn_s_barrier(); asm volatile("" ::: "memory");
#pragma unroll
        for (int ai = 0; ai < 2; ++ai)
#pragma unroll
            for (int m = 0; m < 4; ++m) { const f32x4 s4 = *(const PG8_LAS f32x4*)(xch + 1024 + (rl0 + ai * HALF + m * 16) * 4); const float sc = 128.0f * __builtin_amdgcn_rcpf((s4[0] + s4[1]) + (s4[2] + s4[3]));
                unsigned char* rowp = O + (size_t)(row0 + ai * HALF + m * 16) * ldc + col0;
#pragma unroll
                for (int bj = 0; bj < 2; ++bj) { const f32x4 v0 = acc[ai][bj][m][0] * sc, v1 = acc[ai][bj][m][1] * sc;
                    u32x2 w; w.x = pk4_fp8(v0[0], v0[1], v0[2], v0[3]); w.y = pk4_fp8(v1[0], v1[1], v1[2], v1[3]); *(u32x2*)(rowp + bj * HALF) = w; } }
    }
};
struct EpiSwiGLU {
    struct Pre { f32x4 bgv[2], buv[2]; };
    __device__ __forceinline__ Pre pre(const Unit& u, int, int wc, int, int fq) const { Pre p; const float* bg = bias + (size_t)u.e * 2048 + u.pn * HALF + wc * 32 + 8 * fq;
        _Pragma("unroll") for (int n = 0; n < 2; ++n) { p.bgv[n] = *(const f32x4*)(bg + 4 * n); p.buv[n] = *(const f32x4*)(bg + 1024 + 4 * n); } return p; }
    static constexpr bool PERM = true;
    unsigned char* O; const float* bias; float wscale;
    bool wt;
    __device__ __forceinline__ void operator()(const f32x4 (&acc)[2][2][4][2], const Unit& u, int wr, int wc, int fr, int fq, const Pre& P) const {
        const int row0 = u.pm * BM + wr * 64 + fr, colj = u.pn * HALF + wc * 32 + 8 * fq;
#pragma unroll
        for (int ai = 0; ai < 2; ++ai)
#pragma unroll
            for (int m = 0; m < 4; ++m) { unsigned char* rowp = O + (size_t)(row0 + ai * HALF + m * 16) * 1024 + colj; float o[8];
#pragma unroll
                for (int n = 0; n < 2; ++n) { const f32x4 g4 = acc[ai][0][m][n] * wscale + P.bgv[n], u4 = acc[ai][1][m][n] * wscale + P.buv[n];
#pragma unroll
                    for (int i = 0; i < 4; ++i) { const float g = fminf(g4[i], 7.0f), up = fminf(fmaxf(u4[i], -7.0f), 7.0f);
                        const float sg = __builtin_amdgcn_rcpf(1.0f + __builtin_amdgcn_exp2f(g * (-1.702f * 1.44269504f)));
                        o[4 * n + i] = (up + 1.0f) * (g * sg); } }
                u32x2 w; w.x = pk4_fp8(o[0], o[1], o[2], o[3]); w.y = pk4_fp8(o[4], o[5], o[6], o[7]);
                if (wt) __hip_atomic_store((unsigned long long*)rowp, (unsigned long long)w.x | ((unsigned long long)w.y << 32), __ATOMIC_RELAXED, __HIP_MEMORY_SCOPE_AGENT);
                else *(u32x2*)rowp = w; }
    }
};
struct EpiBiasF8 {
    static constexpr bool PERM = true;
    struct Pre { f32x4 bv[2][2]; };
    __device__ __forceinline__ Pre pre(const Unit& u, int, int wc, int, int fq) const { Pre p; const float* bp = bias + (size_t)u.e * 1024 + u.pn * BM + wc * 32 + 8 * fq;
        _Pragma("unroll") for (int bj = 0; bj < 2; ++bj) _Pragma("unroll") for (int n = 0; n < 2; ++n) p.bv[bj][n] = *(const f32x4*)(bp + bj * HALF + 4 * n); return p; }
    unsigned char* O; const float* bias; float wscale;
    __device__ __forceinline__ void operator()(const f32x4 (&acc)[2][2][4][2], const Unit& u, int wr, int wc, int fr, int fq, const Pre& P) const {
        const int row0 = u.pm * BM + wr * 64 + fr, col0 = u.pn * BM + wc * 32 + 8 * fq;
#pragma unroll
        for (int ai = 0; ai < 2; ++ai)
#pragma unroll
            for (int m = 0; m < 4; ++m) { unsigned char* rowp = O + (size_t)(row0 + ai * HALF + m * 16) * 1024 + col0;
#pragma unroll
                for (int bj = 0; bj < 2; ++bj) { const f32x4 v0 = acc[ai][bj][m][0] * wscale + P.bv[bj][0], v1 = acc[ai][bj][m][1] * wscale + P.bv[bj][1];
                    u32x2 w; w.x = pk4_fp8(v0[0], v0[1], v0[2], v0[3]); w.y = pk4_fp8(v1[0], v1[1], v1[2], v1[3]);
                    *(u32x2*)(rowp + bj * HALF) = w; } }
    }
};

typedef int i32x4 __attribute__((ext_vector_type(4)));
typedef int i32x8 __attribute__((ext_vector_type(8)));
__device__ __forceinline__ i32x8 cat16(bf16x8 a, bf16x8 b) { return __builtin_shufflevector(__builtin_bit_cast(i32x4, a), __builtin_bit_cast(i32x4, b), 0, 1, 2, 3, 4, 5, 6, 7); }
typedef int i32x6 __attribute__((ext_vector_type(6)));
typedef bf16x8 __attribute__((aligned(8))) bf16x8_a8;
__device__ __forceinline__ i32x6 cat6(bf16x8 a, bf16x8 b) { return __builtin_shufflevector(__builtin_bit_cast(i32x4, a), __builtin_bit_cast(i32x4, b), 0, 1, 2, 3, 4, 5); }
constexpr int B6_KT = 256 * 96, B6_TILE = 8 * B6_KT;
template <class Epi, class Sched, bool ALIGN_EPI, int FP8 = 0>
__device__ __forceinline__ void gemm_phase(PG8_LAS unsigned char* lds, const Gemm g, const Sched& S, const Epi& E, int wid) {
    const int lane = lane_id(), tid = wid * 64 + lane, wr = wid >> 2, wc = wid & 3, fr = lane & 15, fq = lane >> 4;
    const int K = g.K, nt = K / BK, kmask = nt - 1, krot = nt >> 3;
#define PG8_KOFF(u) (((u).pm + (u).pn) * krot & kmask)
    unsigned voffA[2], voffB[2]; int RA[2], CA[2];
#pragma unroll
    for (int i = 0; i < 2; ++i) { int R, C; stage_rc(tid * 16 + i * 8192, R, C); const int Rb = Epi::PERM ? ((R & ~31) + perm32(R & 31)) : R;
        RA[i] = R; CA[i] = C; voffA[i] = (unsigned)(R * K + C) * 2u; voffB[i] = (unsigned)(Rb * K + C) * 2u; }
    const size_t kstep = (size_t)(BK * 2);
    const size_t hstep = (size_t)HALF * K * 2;
    const size_t tstep = 2 * hstep;
    const unsigned ldsw = (unsigned)wid * 1024u;
    const int aoff = lds_byte(wr * 64 + fr, fq * 8), boff = (FP8 == 2) ? (wc * 32 + fr) * 96 + ((fq + 2 * (fr >> 3)) & 3) * 24 : lds_byte(wc * 32 + fr, fq * 8);
    const unsigned voffB6 = (unsigned)tid * 16u;
#define PG8_SA(b, h) (((b) * 2 + (h)) * HTB)
#define PG8_SB(b, h) ((4 + (b) * 2 + (h)) * HTB)
#define PG8_STAGEB6(b, gbase) do { _Pragma("unroll") for (int _i = 0; _i < 3; ++_i) \
        __builtin_amdgcn_global_load_lds((const unsigned*)((const char*)(gbase) + voffB6 + _i * 8192), (PG8_LAS unsigned*)(lds + PG8_SB(b, 0) + ldsw + _i * 8192), 16, 0, 0); } while (0)
#define PG8_STB(b, pb, p6) do { if constexpr (FP8 == 2) { PG8_STAGEB6(b, p6); } else { PG8_STAGE(PG8_SB(b, 0), pb, voffB); PG8_STAGE(PG8_SB(b, 1), (pb) + hstep, voffB); } } while (0)
#define PG8_STAGE(bufoff, gbase, voff) do { _Pragma("unroll") for (int _i = 0; _i < 2; ++_i) \
        __builtin_amdgcn_global_load_lds((const unsigned*)((const char*)(gbase) + (voff)[_i]), (PG8_LAS unsigned*)(lds + (bufoff) + ldsw + _i * 8192), 16, 0, 0); } while (0)
#define PG8_STAGE2(bufoff, gbase, v0, v1) do { \
        __builtin_amdgcn_global_load_lds((const unsigned*)((const char*)(gbase) + (v0)), (PG8_LAS unsigned*)(lds + (bufoff) + ldsw), 16, 0, 0); \
        __builtin_amdgcn_global_load_lds((const unsigned*)((const char*)(gbase) + (v1)), (PG8_LAS unsigned*)(lds + (bufoff) + ldsw + 8192), 16, 0, 0); } while (0)
#define PG8_STA(bufoff, h, pNG, pG, nx) do { if constexpr (Sched::GATHER) { const unsigned _v0 = (nx) ? nv[h][0] : cv[h][0], _v1 = (nx) ? nv[h][1] : cv[h][1]; PG8_STAGE2(bufoff, pG, _v0, _v1); } \
        else { PG8_STAGE(bufoff, (pNG) + (h) * hstep, voffA); } } while (0)
#define PG8_LDA(dst, b, h) do { _Pragma("unroll") for (int m = 0; m < 4; ++m) _Pragma("unroll") for (int k = 0; k < 2; ++k) dst[m][k] = *(const PG8_LAS bf16x8*)(lds + PG8_SA(b, h) + aoff + m * 2048 + k * 1024); } while (0)
#define PG8_LDB(dst, b, h) do { if constexpr (FP8 == 2) { _Pragma("unroll") for (int n = 0; n < 2; ++n) { const PG8_LAS unsigned char* _p = lds + PG8_SB(b, 0) + boff + (h) * 12288 + n * 1536; \
            const u32x2 _t0 = *(const volatile PG8_LAS u32x2*)_p, _t1 = *(const volatile PG8_LAS u32x2*)(_p + 8), _t2 = *(const volatile PG8_LAS u32x2*)(_p + 16); \
            dst[n][0] = __builtin_bit_cast(bf16x8, __builtin_shufflevector(_t0, _t1, 0, 1, 2, 3)); dst[n][1] = __builtin_bit_cast(bf16x8, __builtin_shufflevector(_t2, _t2, 0, 1, -1, -1)); } } \
        else { _Pragma("unroll") for (int n = 0; n < 2; ++n) _Pragma("unroll") for (int k = 0; k < 2; ++k) dst[n][k] = *(const PG8_LAS bf16x8*)(lds + PG8_SB(b, h) + boff + n * 2048 + k * 1024); } } while (0)
#define PG8_MMA(ai, bj, At, Bt) do { __builtin_amdgcn_s_setprio(1); \
        if constexpr (FP8 == 2) { _Pragma("unroll") for (int m = 0; m < 4; ++m) _Pragma("unroll") for (int n = 0; n < 2; ++n) \
            asm volatile("s_nop 1\n\tv_mfma_scale_f32_16x16x128_f8f6f4 %0, %1, %2, %0, %3, %3 op_sel_hi:[0,0,0] cbsz:2" : "+v"(acc[ai][bj][m][n]) : "v"(cat6(Bt[n][0], Bt[n][1])), "v"(cat16(At[m][0], At[m][1])), "v"(mxs)); } \
        else if constexpr (FP8 == 1) { _Pragma("unroll") for (int m = 0; m < 4; ++m) _Pragma("unroll") for (int n = 0; n < 2; ++n) \
            asm volatile("v_mfma_scale_f32_16x16x128_f8f6f4 %0, %1, %2, %0, %3, %3 op_sel_hi:[0,0,0]" : "+v"(acc[ai][bj][m][n]) : "v"(cat16(Bt[n][0], Bt[n][1])), "v"(cat16(At[m][0], At[m][1])), "v"(mxs)); } \
        else { _Pragma("unroll") for (int m = 0; m < 4; ++m) _Pragma("unroll") for (int n = 0; n < 2; ++n) _Pragma("unroll") for (int k = 0; k < 2; ++k) \
            acc[ai][bj][m][n] = __builtin_amdgcn_mfma_f32_16x16x32_bf16(Bt[n][k], At[m][k], acc[ai][bj][m][n], 0, 0, 0); } \
        __builtin_amdgcn_s_setprio(0); } while (0)
#define PG8_WAIT_V(n) asm volatile("s_waitcnt vmcnt(" #n ")" ::: "memory")
#define PG8_WAIT_L(n) asm volatile("s_waitcnt lgkmcnt(" #n ")" ::: "memory")
#define PG8_WAIT_VK do { if constexpr (FP8 == 2) PG8_WAIT_V(7); else PG8_WAIT_V(8); } while (0)
#define PG8_BAR __builtin_amdgcn_s_barrier()
#define PG8_SCHED __builtin_amdgcn_sched_barrier(0)
    Unit cur, nxt; int ui = 0;
    if (!S.next(0, cur)) return;
    int sig_pm = -1;
    const int mxs = 0x7f7f7f7f;
    f32x4 acc[2][2][4][2];
#pragma unroll
    for (int a = 0; a < 2; ++a)
#pragma unroll
        for (int b = 0; b < 2; ++b)
#pragma unroll
            for (int m = 0; m < 4; ++m)
#pragma unroll
                for (int n = 0; n < 2; ++n) acc[a][b][m][n] = (f32x4){0.f, 0.f, 0.f, 0.f};
    bf16x8 At[4][2], B0[2][2], B1[2][2];
    const char* gA0 = (const char*)g.A;
    const size_t btstep = (FP8 == 2) ? (size_t)B6_TILE : tstep, kmulB = (FP8 == 2) ? (size_t)(B6_KT / (BK * 2)) : (size_t)1;
    const char* cA = gA0 + (size_t)cur.pm * tstep; const char* cB = (const char*)g.Bt + (size_t)cur.e * g.bstride + (size_t)cur.pn * btstep;
    unsigned cv[2][2], nv[2][2];
#pragma unroll
    for (int h = 0; h < 2; ++h)
#pragma unroll
        for (int i = 0; i < 2; ++i) { cv[h][i] = 0u; nv[h][i] = 0u; }
    if constexpr (Sched::GATHER) {
#pragma unroll
        for (int h = 0; h < 2; ++h)
#pragma unroll
            for (int i = 0; i < 2; ++i) cv[h][i] = ((unsigned)S.arow(0, h * HALF + RA[i]) * (unsigned)K + (unsigned)CA[i]) * 2u;
    }
    int coff = PG8_KOFF(cur);
    { const size_t k0 = (size_t)coff * kstep, k1 = (size_t)((coff + 1) & kmask) * kstep;
    PG8_STB(0, cB + k0 * kmulB, cB + k0 * kmulB); PG8_STA(PG8_SA(0, 0), 0, cA + k0, gA0 + k0, false); PG8_STA(PG8_SA(0, 1), 1, cA + k0, gA0 + k0, false);
    if (wr == 1) PG8_BAR;
    PG8_WAIT_V(2); PG8_BAR;
    if constexpr (FP8 == 2) { PG8_STB(1, cB + k1 * kmulB, cB + k1 * kmulB); PG8_STA(PG8_SA(1, 0), 0, cA + k1, gA0 + k1, false); }
    else { PG8_STAGE(PG8_SB(1, 0), cB + k1, voffB); PG8_STA(PG8_SA(1, 0), 0, cA + k1, gA0 + k1, false); PG8_STAGE(PG8_SB(1, 1), cB + hstep + k1, voffB); } }
    if constexpr (FP8 == 2) PG8_WAIT_V(5); else PG8_WAIT_V(6);
    PG8_BAR;
    for (;;) {
        const bool has_next = S.next(ui + 1, nxt);
        const typename Epi::Pre epre = E.pre(cur, wr, wc, fr, fq);
        const int noff = has_next ? PG8_KOFF(nxt) : coff;
        const char* nA = has_next ? gA0 + (size_t)nxt.pm * tstep : cA; const char* nB = has_next ? (const char*)g.Bt + (size_t)nxt.e * g.bstride + (size_t)nxt.pn * btstep : cB;
        if constexpr (Sched::GATHER) {
#pragma unroll
            for (int h = 0; h < 2; ++h)
#pragma unroll
                for (int i = 0; i < 2; ++i) nv[h][i] = has_next ? ((unsigned)S.arow(ui + 1, h * HALF + RA[i]) * (unsigned)K + (unsigned)CA[i]) * 2u : cv[h][i];
        }
#pragma unroll 1
        for (int t = 0; t < nt; t += 2) {
            const bool last = (t == nt - 2);
            if constexpr (Sched::GATHER) { if (t == 2 && sig_pm >= 0) {
                if (S.done && tid == 0) (void)__hip_atomic_fetch_add(S.done + 64 * sig_pm, 1u, __ATOMIC_RELAXED, __HIP_MEMORY_SCOPE_AGENT); sig_pm = -1; } }
            const size_t k1 = (size_t)((t + 1 + coff) & kmask) * kstep, k2 = (size_t)((last ? noff : t + 2 + coff) & kmask) * kstep, k3 = (size_t)((last ? noff + 1 : t + 3 + coff) & kmask) * kstep;
            const char* pa = last ? nA : cA; const char* pb = last ? nB : cB;
            const char* a1 = cA + k1; const char* a1g = gA0 + k1;
            const char* a2 = pa + k2; const char* b2 = pb + k2 * kmulB; const char* a2g = gA0 + k2;
            const char* a3 = pa + k3; const char* b3 = pb + k3 * kmulB; const char* a3g = gA0 + k3;
            PG8_LDB(B0, 0, 0); PG8_LDB(B1, 0, 1); PG8_SCHED; PG8_LDA(At, 0, 0); PG8_STA(PG8_SA(1, 1), 1, a1, a1g, false);
            PG8_WAIT_VK; PG8_WAIT_L(0); PG8_BAR; PG8_MMA(0, 0, At, B0); PG8_MMA(0, 1, At, B1); PG8_BAR; PG8_SCHED;
            PG8_LDA(At, 0, 1); PG8_STB(0, b2, b2); PG8_STA(PG8_SA(0, 0), 0, a2, a2g, last);
            PG8_WAIT_VK; PG8_WAIT_L(0); PG8_BAR; PG8_MMA(1, 0, At, B0); PG8_MMA(1, 1, At, B1); PG8_BAR; PG8_SCHED;
            PG8_LDB(B0, 1, 0); PG8_LDB(B1, 1, 1); PG8_SCHED; PG8_LDA(At, 1, 0); PG8_STA(PG8_SA(0, 1), 1, a2, a2g, last);
            PG8_WAIT_VK; PG8_WAIT_L(0); PG8_BAR; PG8_MMA(0, 0, At, B0); PG8_MMA(0, 1, At, B1); PG8_BAR; PG8_SCHED;
            PG8_LDA(At, 1, 1); PG8_STB(1, b3, b3); PG8_STA(PG8_SA(1, 0), 0, a3, a3g, last);
            PG8_WAIT_VK; PG8_WAIT_L(0); PG8_BAR; PG8_MMA(1, 0, At, B0); PG8_MMA(1, 1, At, B1); PG8_BAR; PG8_SCHED;
        }
        if constexpr (ALIGN_EPI) { if (wr == 0) PG8_BAR; }
        if constexpr (FP8) asm volatile("s_nop 15\n\ts_nop 3" ::: "memory");
        { int le = lane; asm volatile("" : "+v"(le));
          E(acc, cur, wr, wc, le & 15, le >> 4, epre); }
        if (!has_next) break;
#pragma unroll
        for (int a = 0; a < 2; ++a)
#pragma unroll
            for (int b = 0; b < 2; ++b)
#pragma unroll
                for (int m = 0; m < 4; ++m)
#pragma unroll
                    for (int n = 0; n < 2; ++n) acc[a][b][m][n] = (f32x4){0.f, 0.f, 0.f, 0.f};
        if constexpr (Sched::GATHER) sig_pm = cur.pm;
        cur = nxt; cA = nA; cB = nB; coff = noff; ++ui;
        if constexpr (Sched::GATHER) {
#pragma unroll
            for (int h = 0; h < 2; ++h)
#pragma unroll
                for (int i = 0; i < 2; ++i) cv[h][i] = nv[h][i];
        }
        if constexpr (ALIGN_EPI) { if (wr == 1) PG8_BAR; }
    }
    PG8_WAIT_V(0);
    if constexpr (!ALIGN_EPI) { if (wr == 0) PG8_BAR; }
    PG8_BAR;
    if constexpr (Sched::GATHER) { if (S.done && tid == 0) { if (sig_pm >= 0) (void)__hip_atomic_fetch_add(S.done + 64 * sig_pm, 1u, __ATOMIC_RELAXED, __HIP_MEMORY_SCOPE_AGENT);
            (void)__hip_atomic_fetch_add(S.done + 64 * cur.pm, 1u, __ATOMIC_RELAXED, __HIP_MEMORY_SCOPE_AGENT); } }
#undef PG8_KOFF
#undef PG8_SA
#undef PG8_SB
#undef PG8_STAGE
#undef PG8_STAGE2
#undef PG8_STA
#undef PG8_LDA
#undef PG8_LDB
#undef PG8_MMA
#undef PG8_WAIT_V
#undef PG8_WAIT_L
#undef PG8_WAIT_VK
#undef PG8_STB
#undef PG8_STAGEB6
#undef PG8_BAR
#undef PG8_SCHED
}
}

constexpr int NWAVES = 8, NTHR = NWAVES * 64;
constexpr int BATCH = 2, SEQ = 8192, D = 1024, M = BATCH * SEQ;
constexpr int NZ = 2048;
constexpr int CW = 512;
constexpr int MEMLEN = 256, NH = 4, HD = 256, MKV = BATCH * MEMLEN;
constexpr int NE = 32, TOPK = 4, DE = 1024, ECAP = 16384;
constexpr int MAXTILES = (M * TOPK) / 256 + NE;
constexpr float EPS = 1e-5f;
constexpr float WSCALE = 32.0f;
constexpr float QSCALE = 0.0625f * 1.44269504f;
constexpr int FN1 = 128, FN2 = 64;

constexpr size_t MiB = 1u << 20;
constexpr size_t WS_CTL = 0, CTL_ZERO_BYTES = 1 * MiB;
constexpr size_t WS_WINT = 2 * MiB, WS_WOUTT = 6 * MiB, WS_WQT = 8 * MiB, WS_WKT = 10 * MiB, WS_WVT = 12 * MiB, WS_WOT = 14 * MiB;
constexpr size_t WS_WRG = 16 * MiB;
constexpr size_t WS_TAB = 17 * MiB;
constexpr size_t WS_MC = 18 * MiB;
constexpr size_t WS_MEMN = 22 * MiB, WS_KB = 23 * MiB, WS_VT = 24 * MiB;
constexpr size_t WS_TOK = 25 * MiB;
constexpr size_t WS_ETOK = 26 * MiB;
constexpr size_t WS_WGUT = 32 * MiB, WS_WDT = 160 * MiB;
constexpr size_t WS_XR = 224 * MiB;
constexpr size_t WS_XN3 = 288 * MiB;
constexpr size_t WS_CTR = 320 * MiB;
constexpr size_t WS_XN = 464 * MiB, WS_Z = 496 * MiB, WS_G = 560 * MiB, WS_Y = 592 * MiB, WS_XB = 624 * MiB, WS_Q = 656 * MiB, WS_O = 688 * MiB;
constexpr size_t WS_ACT = 464 * MiB;
constexpr size_t WS_WQN = 28 * MiB, WS_WOT16 = 30 * MiB;
constexpr size_t WS_MK = WS_Q, WS_MV = WS_Q + 2 * MiB;
constexpr size_t WS_P = WS_O;
constexpr size_t WS_END = 720 * MiB;
constexpr size_t TAB_WA = 128 * 1024;
constexpr size_t TAB_DCH = 256 * 1024;
constexpr int CW_BAR = 4096;
constexpr int CW_CNT = 8192;
constexpr int CW_ROWSQ = 16384;
constexpr int CW_DONE = 131072;
static_assert((CW_DONE + 64 * 320) * 4 <= (int)CTL_ZERO_BYTES, "ctl");
constexpr int CW_GRP = 65536;
static_assert((CW_GRP + 64 * 64 * 3) * 4 <= (int)CTL_ZERO_BYTES, "ctl");
static_assert((CW_ROWSQ + M) * 4 <= (int)CTL_ZERO_BYTES, "ctl");

constexpr int LDS_BYTES = 147456;
constexpr int RING_BYTES = 131072, LDSCTL_OFF = LDS_BYTES - 512, MISC_OFF = LDSCTL_OFF + 320;
constexpr int MOE_TAB_OFF = 143360;

#define GAS __attribute__((address_space(1)))
#define LAS __attribute__((address_space(3)))
typedef unsigned short bf16;
typedef unsigned v4u __attribute__((ext_vector_type(4)));
typedef unsigned v2u __attribute__((ext_vector_type(2)));
typedef float f32x4 __attribute__((ext_vector_type(4)));
typedef GAS unsigned gu32;
typedef float f32x2v __attribute__((ext_vector_type(2)));
#define RLX_AGENT __ATOMIC_RELAXED, __HIP_MEMORY_SCOPE_AGENT
#define LDS_WAIT() asm volatile("s_waitcnt lgkmcnt(0)" ::: "memory")
__device__ __forceinline__ unsigned pk2(float lo, float hi) { return pg8::cvt_pk_bf16(lo, hi); }
__device__ __forceinline__ unsigned f2bf(float f) { return pg8::cvt_pk_bf16(f, 0.f) & 0xffffu; }
__device__ __forceinline__ float bf2f(unsigned short b) { return __builtin_bit_cast(float, (unsigned)b << 16); }
__device__ __forceinline__ float bflo(unsigned w) { return __builtin_bit_cast(float, w << 16); }
__device__ __forceinline__ float bfhi(unsigned w) { return __builtin_bit_cast(float, w & 0xffff0000u); }

#define XB_TMO      128
#define XB_XCNT(j)  (256  + 64 * (j))
#define XB_XSUB(j)  (1280 + 64 * (j))
#define XB_XGEN(j)  (2304 + 64 * (j))
#define XB_TOP      3328
#define XB_TOPGEN   3392
#define XCD_BAR_WORDS 3456
#define XB_SPIN_CAP (1u << 18)
__device__ __forceinline__ unsigned xb_ld(unsigned* p)              { return __hip_atomic_load(p, __ATOMIC_RELAXED, __HIP_MEMORY_SCOPE_AGENT); }
__device__ __forceinline__ unsigned xb_add(unsigned* p, unsigned v) { return __hip_atomic_fetch_add(p, v, __ATOMIC_RELAXED, __HIP_MEMORY_SCOPE_AGENT); }
__device__ __forceinline__ unsigned xb_xcc_id() { return (unsigned)__builtin_amdgcn_s_getreg((3 << 11) | 20) & 0xFu; }
#define XB_SPIN(cond, bar) do { unsigned _sp = 0; while (cond) { __builtin_amdgcn_s_sleep(1); \
    if ((++_sp & 255u) == 0u) { if (xb_ld(&(bar)[XB_TMO])) break; if (_sp > XB_SPIN_CAP) { atomicAdd(&(bar)[XB_TMO], 1u); break; } } } } while (0)
struct XcdBarrier { unsigned* bar; unsigned x; volatile LAS unsigned* st; };
__device__ __forceinline__ XcdBarrier xcd_barrier_post(unsigned* bar, volatile LAS unsigned* st, bool leader) {
    XcdBarrier b; b.bar = bar; b.x = xb_xcc_id(); b.st = st;
    if (leader) (void)xb_add(&bar[XB_XCNT(b.x)], 1u);
    return b;
}
__device__ __forceinline__ void xcd_barrier_complete(unsigned* bar, unsigned x, unsigned& nloc, unsigned& nx) {
    const unsigned G = gridDim.x * gridDim.y * gridDim.z;
    unsigned sum, cnt, mine, sp = 0u;
    for (;;) {
        sum = 0u; cnt = 0u; mine = 0u;
#pragma unroll
        for (unsigned j = 0; j < 16; ++j) { const unsigned c = xb_ld(&bar[XB_XCNT(j)]); sum += c; cnt += (c > 0u) ? 1u : 0u; mine = (j == x) ? c : mine; }
        if (sum == G) break;
        __builtin_amdgcn_s_sleep(1);
        if ((++sp & 255u) == 0u) { if (xb_ld(&bar[XB_TMO])) break; if (sp > XB_SPIN_CAP) { atomicAdd(&bar[XB_TMO], 1u); break; } }
    }
    nloc = mine > 0u ? mine : 1u; nx = cnt > 0u ? cnt : 1u;
}
__device__ __forceinline__ void xcd_barrier(const XcdBarrier& b, bool leader) {
    asm volatile("s_waitcnt vmcnt(0)" ::: "memory");
    __syncthreads();
    if (leader) {
        unsigned* bar = b.bar;
        __builtin_amdgcn_s_waitcnt(0);
        unsigned nloc = b.st[0], nx = b.st[1];
        if (nloc == 0u) { xcd_barrier_complete(bar, b.x, nloc, nx); b.st[0] = nloc; b.st[1] = nx; }
        const unsigned old = xb_add(&bar[XB_XSUB(b.x)], 1u);
        const unsigned gen = old / nloc;
        if (old + 1u == (gen + 1u) * nloc) {
            __builtin_amdgcn_fence(__ATOMIC_RELEASE, "agent");
            asm volatile("s_waitcnt vmcnt(0)" ::: "memory");
            const unsigned og = xb_add(&bar[XB_TOP], 1u);
            const unsigned tg = og / nx;
            if (og + 1u == (tg + 1u) * nx) xb_add(&bar[XB_TOPGEN], 1u);
            else XB_SPIN(xb_ld(&bar[XB_TOPGEN]) == tg, bar);
            __builtin_amdgcn_fence(__ATOMIC_ACQUIRE, "agent");
            xb_add(&bar[XB_XGEN(b.x)], 1u);
            asm volatile("s_waitcnt vmcnt(0)" ::: "memory");
        } else {
            XB_SPIN(xb_ld(&bar[XB_XGEN(b.x)]) == gen, bar);
            __builtin_amdgcn_fence(__ATOMIC_ACQUIRE, "agent");
            asm volatile("s_waitcnt vmcnt(0)" ::: "memory");
        }
    }
    __syncthreads();
}

constexpr unsigned NGRP = 4;
__device__ __forceinline__ void group_sync(unsigned* bar, unsigned long long* c1, unsigned* c2, bool leader) {
    asm volatile("s_waitcnt vmcnt(0)" ::: "memory");
    __syncthreads();
    if (leader) {
        __builtin_amdgcn_s_waitcnt(0);
        const unsigned x = xb_xcc_id();
        (void)__hip_atomic_fetch_add(c1, 1ull | (1ull << (8 + 3 * x)), __ATOMIC_RELAXED, __HIP_MEMORY_SCOPE_AGENT);
        unsigned long long v = 0ull;
        XB_SPIN(((v = __hip_atomic_load(c1, __ATOMIC_RELAXED, __HIP_MEMORY_SCOPE_AGENT)) & 0xffull) < NGRP, bar);
        if (((v >> (8 + 3 * x)) & 7ull) != NGRP) {
            __builtin_amdgcn_fence(__ATOMIC_RELEASE, "agent");
            asm volatile("s_waitcnt vmcnt(0)" ::: "memory");
            (void)xb_add(c2, 1u);
            XB_SPIN(xb_ld(c2) < NGRP, bar);
        }
        __builtin_amdgcn_fence(__ATOMIC_ACQUIRE, "agent");
        asm volatile("s_waitcnt vmcnt(0)" ::: "memory");
    }
    __syncthreads();
}

struct Args { const float* in[22]; float* out; unsigned char* ws; int ph_lo, ph_hi; };
struct Frame {
    LAS unsigned char* lds;
    unsigned char* ws;
    int wave, vcu, G;
    __device__ __forceinline__ int lane() const { return lane_id(); }
    __device__ __forceinline__ int tid() const { return wave * 64 + lane_id(); }
};
__device__ __forceinline__ float wave_sum(float v) {
#pragma unroll
    for (int o = 1; o < 64; o <<= 1) v += __shfl_xor(v, o);
    return v;
}
__device__ __forceinline__ float wave_max(float v) {
#pragma unroll
    for (int o = 1; o < 64; o <<= 1) v = fmaxf(v, __shfl_xor(v, o));
    return v;
}

template <bool F8>
__device__ __forceinline__ void p0_item(const float* W, int N, unsigned char* WT, int ldt, int k0, int n0s, int n0d, const float* gk, float scale, LAS float* scr, int lane) {
    const int n4 = lane & 15, kr = lane >> 4;
    f32x4 wv[16];
#pragma unroll
    for (int i = 0; i < 16; ++i) wv[i] = __builtin_nontemporal_load((const GAS f32x4*)(W + (size_t)(k0 + 4 * i + kr) * N + n0s + 4 * n4));
#pragma unroll
    for (int i = 0; i < 16; ++i) { const int kk = 4 * i + kr; float g = scale; if (gk) g *= gk[kk];
        LAS float* d = scr + kk * 65 + 4 * n4; d[0] = wv[i].x * g; d[1] = wv[i].y * g; d[2] = wv[i].z * g; d[3] = wv[i].w * g; }
    LDS_WAIT(); asm volatile("" ::: "memory");
    if constexpr (!F8) { const int c = lane & 7;
#pragma unroll
        for (int j = 0; j < 8; ++j) { const int n = (lane >> 3) + 8 * j; const LAS float* sp = scr + (8 * c) * 65 + n;
            v4u o; o.x = pk2(sp[0 * 65], sp[1 * 65]); o.y = pk2(sp[2 * 65], sp[3 * 65]); o.z = pk2(sp[4 * 65], sp[5 * 65]); o.w = pk2(sp[6 * 65], sp[7 * 65]);
            *(GAS v4u*)(WT + (size_t)(n0d + n) * ldt + (k0 + 8 * c) * 2) = o; }
    } else { const int c = lane & 3;
#pragma unroll
        for (int j = 0; j < 4; ++j) { const int n = (lane >> 2) + 16 * j; const LAS float* sp = scr + (16 * c) * 65 + n;
            v4u o; o.x = pg8::pk4_fp8(sp[0 * 65], sp[1 * 65], sp[2 * 65], sp[3 * 65]); o.y = pg8::pk4_fp8(sp[4 * 65], sp[5 * 65], sp[6 * 65], sp[7 * 65]);
            o.z = pg8::pk4_fp8(sp[8 * 65], sp[9 * 65], sp[10 * 65], sp[11 * 65]); o.w = pg8::pk4_fp8(sp[12 * 65], sp[13 * 65], sp[14 * 65], sp[15 * 65]);
            *(GAS v4u*)(WT + (size_t)(n0d + n) * ldt + k0 + 16 * c) = o; }
    }
    LDS_WAIT(); asm volatile("" ::: "memory");
}
constexpr int MOE_IT_GU = (D / 128) * (2 * DE / 32), MOE_IT_DN = (DE / 128) * (D / 32), MOE_ITEMS = NE * (MOE_IT_GU + MOE_IT_DN);
constexpr float W6SCALE = 64.0f;
constexpr size_t WGU6_E = (size_t)(2 * DE / 256) * pg8::B6_TILE, WDN6_E = (size_t)(D / 256) * pg8::B6_TILE;
__device__ __forceinline__ void p0_moe_decode(const Args& a, unsigned char* ws, int it, const float*& src, unsigned char*& dst, int& N) {
    if (it < NE * MOE_IT_GU) { const int e = it / MOE_IT_GU, q = it % MOE_IT_GU, kb = q / (2 * DE / 32), nb = q % (2 * DE / 32);
        const int n0d = 32 * nb, pn = n0d >> 8, hf = (n0d >> 7) & 1, jj = n0d & 127, n0s = hf * DE + 128 * pn + jj;
        N = 2 * DE; src = a.in[17] + (size_t)e * D * 2 * DE + (size_t)(128 * kb) * (2 * DE) + n0s; dst = ws + WS_WGUT + (size_t)e * WGU6_E + (size_t)pn * pg8::B6_TILE + (size_t)kb * pg8::B6_KT + (size_t)(n0d & 255) * 96; }
    else { it -= NE * MOE_IT_GU; const int e = it / MOE_IT_DN, q = it % MOE_IT_DN, kb = q / (D / 32), nb = q % (D / 32);
        N = D; src = a.in[19] + (size_t)e * DE * D + (size_t)(128 * kb) * D + 32 * nb; dst = ws + WS_WDT + (size_t)e * WDN6_E + (size_t)((32 * nb) >> 8) * pg8::B6_TILE + (size_t)kb * pg8::B6_KT + (size_t)((32 * nb) & 255) * 96; }
}
#define P0M_LOAD(wv, src, N) do { const unsigned _vo = (unsigned)(((lane >> 3) * (N) + 4 * (lane & 7)) * 4); _Pragma("unroll") for (int _i = 0; _i < 16; ++_i) \
        wv[_i] = __builtin_nontemporal_load((const GAS f32x4*)((const GAS char*)((src) + (size_t)(8 * _i) * (N)) + _vo)); } while (0)
#define P0M_PROC(wv, dst) do { _Pragma("unroll") for (int _i = 0; _i < 16; ++_i) { LAS float* _d = scr + (8 * _i + (lane >> 3)) * 33 + 4 * (lane & 7); _d[0] = wv[_i].x * WSCALE; _d[1] = wv[_i].y * WSCALE; _d[2] = wv[_i].z * WSCALE; _d[3] = wv[_i].w * WSCALE; } \
        LDS_WAIT(); asm volatile("" ::: "memory"); \
        _Pragma("unroll") for (int _j = 0; _j < 4; ++_j) { const int _n = (lane >> 3) + 8 * _j; const LAS float* _s = scr + (16 * (lane & 7)) * 33 + _n; \
            v4u _o; _o.x = pg8::pk4_fp8(_s[0 * 33], _s[1 * 33], _s[2 * 33], _s[3 * 33]); _o.y = pg8::pk4_fp8(_s[4 * 33], _s[5 * 33], _s[6 * 33], _s[7 * 33]); \
            _o.z = pg8::pk4_fp8(_s[8 * 33], _s[9 * 33], _s[10 * 33], _s[11 * 33]); _o.w = pg8::pk4_fp8(_s[12 * 33], _s[13 * 33], _s[14 * 33], _s[15 * 33]); \
            *(GAS v4u*)((dst) + (size_t)_n * D + 16 * (lane & 7)) = _o; } \
        LDS_WAIT(); asm volatile("" ::: "memory"); } while (0)
#define P0M_PROC6(wv, dst) do { _Pragma("unroll") for (int _i = 0; _i < 16; ++_i) { LAS float* _d = scr + (8 * _i + (lane >> 3)) * 33 + 4 * (lane & 7); _d[0] = wv[_i].x * W6SCALE; _d[1] = wv[_i].y * W6SCALE; _d[2] = wv[_i].z * W6SCALE; _d[3] = wv[_i].w * W6SCALE; } \
        LDS_WAIT(); asm volatile("" ::: "memory"); \
        _Pragma("unroll 1") for (int _j = 0; _j < 2; ++_j) { const int _g = (lane >> 2) + 16 * _j, _q = lane & 3; const LAS float* _s = scr + (32 * _q) * 33 + _g; pg8::f32x16_t _s0, _s1; \
            if (ilv) { _Pragma("unroll") for (int _e = 0; _e < 16; ++_e) { _s0[_e] = _s[(2 * _e) * 33]; _s1[_e] = _s[(2 * _e + 1) * 33]; } } \
            else { _Pragma("unroll") for (int _e = 0; _e < 16; ++_e) { _s0[_e] = _s[_e * 33]; _s1[_e] = _s[(16 + _e) * 33]; } } \
            const pg8::u32x6 _p = pg8::pk32_fp6(_s0, _s1); const int _r = 16 * ((_g >> 2) & 1) + 4 * (_g >> 3) + (_g & 3); unsigned char* _o = (dst) + (size_t)(_r * 96 + 24 * ((_q + 2 * (_r >> 3)) & 3)); \
            __builtin_nontemporal_store((v2u){_p[0], _p[1]}, (GAS v2u*)_o); __builtin_nontemporal_store((v2u){_p[2], _p[3]}, (GAS v2u*)(_o + 8)); __builtin_nontemporal_store((v2u){_p[4], _p[5]}, (GAS v2u*)(_o + 16)); } \
        LDS_WAIT(); asm volatile("" ::: "memory"); } while (0)
__device__ __forceinline__ void p0_moe_stream(Frame& F, const Args& a, int lo, int hi, int gw, int NGW) {
    LAS float* scr = (LAS float*)(F.lds + F.wave * 16896); const int lane = F.lane(); unsigned char* ws = F.ws;
    f32x4 wA[16], wB[16]; const float* sA; const float* sB; unsigned char* dA; unsigned char* dB; int nA, nB;
    bool ilv; { pg8::f32x16_t t0 = {}, t1 = {}; float one = 1.0f, two = 2.0f; asm volatile("" : "+v"(one), "+v"(two)); t0[0] = one; t1[0] = two; const pg8::u32x6 tp = pg8::pk32_fp6(t0, t1);
                ilv = (((tp[0] >> 6) & 63u) == 16u) || (((tp[3] >> 0) & 63u) != 16u); }
    int it = lo + gw;
    if (it < hi) { p0_moe_decode(a, ws, it, sA, dA, nA); P0M_LOAD(wA, sA, nA); }
    for (; it < hi; it += 2 * NGW) {
        const int it2 = it + NGW, it3 = it + 2 * NGW;
        if (it2 < hi) { p0_moe_decode(a, ws, it2, sB, dB, nB); P0M_LOAD(wB, sB, nB); }
        P0M_PROC6(wA, dA);
        if (it3 < hi) { p0_moe_decode(a, ws, it3, sA, dA, nA); P0M_LOAD(wA, sA, nA); }
        if (it2 < hi) P0M_PROC6(wB, dB);
    }
}
__device__ __forceinline__ void rms_row_to_bf16(const float* xrow, const float* gain, bf16* orow, int lane) {
    const GAS f32x4* xr = (const GAS f32x4*)xrow + lane; const GAS f32x4* gr = (const GAS f32x4*)gain + lane;
    f32x4 v[4]; float s = 0.f;
#pragma unroll
    for (int j = 0; j < 4; ++j) { v[j] = xr[64 * j]; s += (v[j].x * v[j].x + v[j].y * v[j].y) + (v[j].z * v[j].z + v[j].w * v[j].w); }
    const float rs = 1.0f / sqrtf(wave_sum(s) * (1.f / D) + EPS);
    GAS unsigned long long* o8 = (GAS unsigned long long*)orow + lane;
#pragma unroll
    for (int j = 0; j < 4; ++j) { const f32x4 g = gr[64 * j]; o8[64 * j] = (unsigned long long)pk2(v[j].x * rs * g.x, v[j].y * rs * g.y) | ((unsigned long long)pk2(v[j].z * rs * g.z, v[j].w * rs * g.w) << 32); }
}
__device__ __forceinline__ void p0_prologue(Frame& F, const Args& a) {
    LAS float* scr = (LAS float*)(F.lds + F.wave * 16896);
    const int gw = F.vcu * NWAVES + F.wave, NGW = F.G * NWAVES;
    unsigned char* ws = F.ws;
    constexpr int I_WIN = (D / 64) * (NZ / 64);
    constexpr int I_SQ = (D / 64) * (D / 64);
    constexpr int NITEMS = I_WIN + 4 * I_SQ + 4 * D;
    for (int it = gw; it < NITEMS; it += NGW) {
        int r = it;
        if (r < I_WIN) { const int nb = r % (NZ / 64), kb = r / (NZ / 64); p0_item<false>(a.in[3], NZ, ws + WS_WINT, D * 2, 64 * kb, 64 * nb, 64 * nb, nullptr, 1.0f, scr, F.lane()); continue; } r -= I_WIN;
        if (r < 2 * I_SQ) { const int w = r / I_SQ, q = r % I_SQ, nb = q % (D / 64), kb = q / (D / 64), k0 = 64 * kb;
            if (w == 0) p0_item<false>(a.in[7], D, ws + WS_WOUTT, D * 2, k0, 64 * nb, 64 * nb, (k0 < CW) ? a.in[5] + k0 : a.in[6] + (k0 - CW), 1.0f, scr, F.lane());
            else p0_item<false>(a.in[13], D, ws + WS_WOT16, D * 2, k0, 64 * nb, 64 * nb, nullptr, 1.0f, scr, F.lane());
            continue; } r -= 2 * I_SQ;
        if (r < 2 * I_SQ) { const int w = r / I_SQ, q = r % I_SQ, nb = q % (D / 64), kb = q / (D / 64), k0 = 64 * kb;
            p0_item<true>(w == 0 ? a.in[11] : a.in[12], D, ws + (w == 0 ? WS_WKT : WS_WVT), D, k0, 64 * nb, 64 * nb, nullptr, WSCALE, scr, F.lane()); continue; } r -= 2 * I_SQ;
        { const int k = r >> 2, c0 = (r & 3) * 256 + 4 * F.lane(); const float g = a.in[8][k];
            const f32x4 v = *(const GAS f32x4*)(a.in[10] + (size_t)k * D + c0); v2u o; o.x = pk2(v.x * g, v.y * g); o.y = pk2(v.z * g, v.w * g);
            *(GAS v2u*)((bf16*)(ws + WS_WQN) + (size_t)k * D + c0) = o; }
    }
    for (int m = 2 * gw; m < M; m += 2 * NGW) {
        const GAS f32x4* x0 = (const GAS f32x4*)(a.in[0] + (size_t)m * D) + F.lane(); const GAS f32x4* x1 = x0 + D / 4; const GAS f32x4* gr = (const GAS f32x4*)a.in[2] + F.lane();
        f32x4 v0[4], v1[4]; float s0 = 0.f, s1 = 0.f;
#pragma unroll
        for (int j = 0; j < 4; ++j) { v0[j] = __builtin_nontemporal_load(x0 + 64 * j); v1[j] = __builtin_nontemporal_load(x1 + 64 * j); }
#pragma unroll
        for (int j = 0; j < 4; ++j) { s0 += (v0[j].x * v0[j].x + v0[j].y * v0[j].y) + (v0[j].z * v0[j].z + v0[j].w * v0[j].w); s1 += (v1[j].x * v1[j].x + v1[j].y * v1[j].y) + (v1[j].z * v1[j].z + v1[j].w * v1[j].w); }
        const float r0 = 1.0f / sqrtf(wave_sum(s0) * (1.f / D) + EPS), r1 = 1.0f / sqrtf(wave_sum(s1) * (1.f / D) + EPS);
        GAS unsigned long long* o0 = (GAS unsigned long long*)((bf16*)(ws + WS_XN) + (size_t)m * D) + F.lane(); GAS unsigned long long* o1 = o0 + D / 4;
#pragma unroll
        for (int j = 0; j < 4; ++j) { const f32x4 g = gr[64 * j];
            o0[64 * j] = (unsigned long long)pk2(v0[j].x * r0 * g.x, v0[j].y * r0 * g.y) | ((unsigned long long)pk2(v0[j].z * r0 * g.z, v0[j].w * r0 * g.w) << 32);
            o1[64 * j] = (unsigned long long)pk2(v1[j].x * r1 * g.x, v1[j].y * r1 * g.y) | ((unsigned long long)pk2(v1[j].z * r1 * g.z, v1[j].w * r1 * g.w) << 32); }
    }
    for (int m = gw; m < MKV; m += NGW) {
        const GAS f32x4* xr = (const GAS f32x4*)(a.in[1] + (size_t)m * D) + F.lane(); const GAS f32x4* gr = (const GAS f32x4*)a.in[9] + F.lane();
        f32x4 v[4]; float ss = 0.f;
#pragma unroll
        for (int j = 0; j < 4; ++j) { v[j] = xr[64 * j]; ss += (v[j].x * v[j].x + v[j].y * v[j].y) + (v[j].z * v[j].z + v[j].w * v[j].w); }
        const float rs = 1.0f / sqrtf(wave_sum(ss) * (1.f / D) + EPS);
        GAS unsigned* o4 = (GAS unsigned*)(ws + WS_MEMN + (size_t)m * D) + F.lane();
#pragma unroll
        for (int j = 0; j < 4; ++j) { const f32x4 g = gr[64 * j]; o4[64 * j] = pg8::pk4_fp8(v[j].x * rs * g.x, v[j].y * rs * g.y, v[j].z * rs * g.z, v[j].w * rs * g.w); }
    }
    const int gt = F.vcu * NTHR + F.tid(), NGT = F.G * NTHR;
    float* wrg = (float*)(ws + WS_WRG);
    for (int i = gt; i < D * NE; i += NGT) { const int e = i >> 10, k = i & 1023; wrg[i] = a.in[15][k * NE + e] * a.in[14][k]; }
    bf16* wa = (bf16*)(ws + WS_TAB + TAB_WA); bf16* mc = (bf16*)(ws + WS_MC); bf16* dch = (bf16*)(ws + WS_TAB + TAB_DCH);
    for (int i = gt; i < 256 * 128; i += NGT) { const int m = i >> 7, k = i & 127; float sn, cs; sincospif((float)((k * (m & 127)) & 127) * (2.0f / 128.0f), &sn, &cs); wa[i] = (bf16)f2bf(m < 128 ? cs : -sn); }
    for (int i = gt; i < 128 * 128 * 128; i += NGT) { const int s1p = i >> 14, mp = (i >> 7) & 127, k = i & 127, op = mp >> 6, s2q = mp & 63, s2 = k >> 1, part = k & 1;
        const int sp = s1p + 128 * s2q, r = (s2 * sp) & 8191; float sn, cs; sincospif((float)r * (2.0f / 8192.0f), &sn, &cs);
        mc[i] = (bf16)f2bf(op == 0 ? (part == 0 ? cs : sn) : (part == 0 ? -sn : cs)); }
    for (int i = gt; i < 8192; i += NGT) { const int p = i >> 12, hc = (i >> 11) & 1, cp = (i >> 5) & 63, q = (i >> 3) & 3, j = i & 7, c = 32 * hc + (j < 4 ? 4 * q + j : 16 + 4 * q + (j - 4));
        float sn, cs; sincospif((float)((c * cp) & 63) * (2.0f / 64.0f), &sn, &cs); dch[i] = (bf16)f2bf(p == 0 ? cs : sn); }
}

typedef short s16x4 __attribute__((ext_vector_type(4)));
typedef short bf16x8v __attribute__((ext_vector_type(8)));
__device__ __forceinline__ bf16x8v tr_pair(LAS unsigned char* p0, int delta) {
    const s16x4 lo = __builtin_amdgcn_ds_read_tr16_b64_v4i16((LAS s16x4*)p0); const s16x4 hi = __builtin_amdgcn_ds_read_tr16_b64_v4i16((LAS s16x4*)(p0 + delta));
    return __builtin_shufflevector(lo, hi, 0, 1, 2, 3, 4, 5, 6, 7);
}
constexpr int FA_P = 544;
constexpr int FC_P = 1056;
__device__ __forceinline__ void fftA_phase(Frame& F) {
    const bf16* Z = (const bf16*)(F.ws + WS_Z); bf16* G = (bf16*)(F.ws + WS_G); const bf16* WA = (const bf16*)(F.ws + WS_TAB + TAB_WA);
    const int tid = F.tid(), lane = F.lane(), w = F.wave, nb = w & 3, mh = w >> 2, g = lane >> 4, q = (lane & 15) >> 2, p = lane & 3;
    for (int unit = F.vcu; unit < BATCH * FN2 * 2; unit += F.G) {
        const int b = unit >> 7, s2 = (unit >> 1) & 63, ch = unit & 1;
        __syncthreads();
#pragma unroll
        for (int i = 0; i < 8; ++i) { const int row = 16 * i + (tid >> 5), piece = tid & 31;
            const v4u v = *(const GAS v4u*)(Z + ((size_t)b * SEQ + 64 * row + s2) * NZ + 1536 + 256 * ch + 8 * piece);
            *(LAS v4u*)(F.lds + row * FA_P + piece * 16) = v; }
        __syncthreads();
        bf16x8v af[4][4];
#pragma unroll
        for (int nt = 0; nt < 4; ++nt)
#pragma unroll
            for (int ks = 0; ks < 4; ++ks) af[nt][ks] = tr_pair(F.lds + (32 * ks + 8 * g + q) * FA_P + (64 * nb + 16 * nt) * 2 + 8 * p, 4 * FA_P);
#pragma unroll
        for (int mt = 0; mt < 8; ++mt) {
            const int m0 = 128 * mh + 16 * mt;
            bf16x8v bfr[4];
#pragma unroll
            for (int ks = 0; ks < 4; ++ks) bfr[ks] = *(const GAS bf16x8v*)(WA + (size_t)(m0 + (lane & 15)) * 128 + 32 * ks + 8 * (lane >> 4));
            const int s1p = 16 * mt + (lane & 15);
            bf16* gp = G + ((((size_t)b * FN1 + s1p) * FN2 + s2) * 2 + mh) * CW + 256 * ch + 64 * nb + 4 * (lane >> 4);
#pragma unroll
            for (int nt = 0; nt < 4; ++nt) { f32x4 acc = {0.f, 0.f, 0.f, 0.f};
#pragma unroll
                for (int ks = 0; ks < 4; ++ks) acc = __builtin_amdgcn_mfma_f32_16x16x32_bf16(af[nt][ks], bfr[ks], acc, 0, 0, 0);
                v2u o; o.x = pk2(acc[0], acc[1]); o.y = pk2(acc[2], acc[3]);
                *(GAS v2u*)(gp + 16 * nt) = o; }
        }
    }
}
__device__ __forceinline__ void conv_phase(Frame& F, const Args& a, int wgi, int nwg) {
    const bf16* Z = (const bf16*)(F.ws + WS_Z); bf16* Y = (bf16*)(F.ws + WS_Y);
    const int gw = wgi * NWAVES + F.wave, NGW = nwg * NWAVES, lane = F.lane();
    const float* cw = a.in[4];
    float w0[8], w1[8], w2[8];
#pragma unroll
    for (int j = 0; j < 8; ++j) { w0[j] = cw[8 * lane + j]; w1[j] = cw[CW + 8 * lane + j]; w2[j] = cw[2 * CW + 8 * lane + j]; }
    constexpr int CH = 8;
    for (int c = gw; c < M / CH; c += NGW) {
        const int t0 = c * CH, s0 = t0 & (SEQ - 1);
        v4u zc[CH + 2], zv[CH + 2], zb[CH];
#pragma unroll
        for (int i = 0; i < CH + 2; ++i) { const int t = t0 - 1 + i; const bool valid = (i == 0) ? (s0 > 0) : ((i == CH + 1) ? (s0 + CH < SEQ) : true);
            if (valid) { zc[i] = *(const GAS v4u*)(Z + (size_t)t * NZ + CW + 8 * lane); zv[i] = *(const GAS v4u*)(Z + (size_t)t * NZ + 2 * CW + 8 * lane); }
            else { zc[i] = (v4u){0u, 0u, 0u, 0u}; zv[i] = (v4u){0u, 0u, 0u, 0u}; } }
#pragma unroll
        for (int i = 0; i < CH; ++i) zb[i] = *(const GAS v4u*)(Z + (size_t)(t0 + i) * NZ + 8 * lane);
        float prev[8], cur[8], nxt[8];
#define CV_OF(dst, cc, vv) do { dst[0] = bflo(cc.x) * bflo(vv.x); dst[1] = bfhi(cc.x) * bfhi(vv.x); dst[2] = bflo(cc.y) * bflo(vv.y); dst[3] = bfhi(cc.y) * bfhi(vv.y); \
            dst[4] = bflo(cc.z) * bflo(vv.z); dst[5] = bfhi(cc.z) * bfhi(vv.z); dst[6] = bflo(cc.w) * bflo(vv.w); dst[7] = bfhi(cc.w) * bfhi(vv.w); } while (0)
        CV_OF(prev, zc[0], zv[0]);
        CV_OF(cur, zc[1], zv[1]);
#pragma unroll
        for (int i = 0; i < CH; ++i) {
            const int t = t0 + i;
            CV_OF(nxt, zc[i + 2], zv[i + 2]);
            const v4u bb = zb[i];
            float bg[8] = {bflo(bb.x), bfhi(bb.x), bflo(bb.y), bfhi(bb.y), bflo(bb.z), bfhi(bb.z), bflo(bb.w), bfhi(bb.w)};
            float y[8]; float ss = 0.f;
#pragma unroll
            for (int j = 0; j < 8; ++j) { y[j] = bg[j] * (w0[j] * prev[j] + w1[j] * cur[j] + w2[j] * nxt[j]); ss += y[j] * y[j]; }
            const float rs = 1.0f / sqrtf(wave_sum(ss) * (1.f / CW) + EPS);
            v4u o; o.x = pk2(y[0] * rs, y[1] * rs); o.y = pk2(y[2] * rs, y[3] * rs); o.z = pk2(y[4] * rs, y[5] * rs); o.w = pk2(y[6] * rs, y[7] * rs);
            *(GAS v4u*)(Y + (size_t)t * D + 8 * lane) = o;
#pragma unroll
            for (int j = 0; j < 8; ++j) { prev[j] = cur[j]; cur[j] = nxt[j]; }
        }
#undef CV_OF
    }
}
__device__ __forceinline__ void absorb_phase(Frame& F) {
    const bf16* KB = (const bf16*)(F.ws + WS_KB); const bf16* VB = (const bf16*)(F.ws + WS_VT); const bf16* WQN = (const bf16*)(F.ws + WS_WQN); const bf16* WOT = (const bf16*)(F.ws + WS_WOT16);
    const int lane = F.lane(), w = F.wave, li = lane & 15, q = lane >> 4;
    for (int unit = F.vcu; unit < 256; unit += F.G) {
        const int type = unit >> 7, bh = (unit >> 4) & 7, slab = unit & 15, b = bh >> 2, h = bh & 3;
        const bf16* Xp; const bf16* Yp; unsigned char* outp; int itf, jtf, dit, djt;
        if (type == 0) { Xp = WQN + (size_t)(64 * slab) * D + h * HD; Yp = KB + (size_t)(b * MEMLEN) * D + h * HD;
            outp = F.ws + WS_MK + (size_t)b * MiB + (size_t)(h * HD) * D + 64 * slab; itf = w & 3; dit = 0; jtf = (w >> 2) * 8; djt = 1; }
        else { Xp = VB + (size_t)(b * MEMLEN) * D + h * HD; Yp = WOT + (size_t)(64 * slab) * D + h * HD;
            outp = F.ws + WS_MV + (size_t)b * MiB + (size_t)(64 * slab) * D + h * HD; jtf = w & 3; djt = 0; itf = (w >> 2) * 8; dit = 1; }
#pragma unroll 2
        for (int t = 0; t < 8; ++t) { const int it = itf + dit * t, jt = jtf + djt * t;
            const bf16* xr = Xp + (size_t)(it * 16 + li) * D + 8 * q; const bf16* yr = Yp + (size_t)(jt * 16 + li) * D + 8 * q;
            bf16x8v xf[8], yf[8];
#pragma unroll
            for (int ks = 0; ks < 8; ++ks) { xf[ks] = *(const GAS bf16x8v*)(xr + 32 * ks); yf[ks] = *(const GAS bf16x8v*)(yr + 32 * ks); }
            f32x4 acc = {0.f, 0.f, 0.f, 0.f};
#pragma unroll
            for (int ks = 0; ks < 8; ++ks) acc = __builtin_amdgcn_mfma_f32_16x16x32_bf16(xf[ks], yf[ks], acc, 0, 0, 0);
            *(GAS unsigned*)(outp + (size_t)(jt * 16 + li) * D + it * 16 + 4 * q) = pg8::pk4_fp8(acc[0] * WSCALE, acc[1] * WSCALE, acc[2] * WSCALE, acc[3] * WSCALE); }
    }
}
__device__ __forceinline__ void fftC_phase(Frame& F) {
    const bf16* G = (const bf16*)(F.ws + WS_G); bf16* Y = (bf16*)(F.ws + WS_Y); const bf16* MC = (const bf16*)(F.ws + WS_MC); const bf16* DCH = (const bf16*)(F.ws + WS_TAB + TAB_DCH);
    const int tid = F.tid(), lane = F.lane(), w = F.wave, tt = w & 3, ch = w >> 2, g = lane >> 4, q = (lane & 15) >> 2, p = lane & 3;
    const float scale = 1.0f / sqrtf((float)SEQ * 64.0f);
    LAS float* ex = (LAS float*)(F.lds + 128 * FC_P);
    for (int unit = F.vcu; unit < BATCH * FN1; unit += F.G) {
        const int b = unit >> 7, s1p = unit & 127;
        __syncthreads();
        const bf16* Gt = G + (size_t)(b * FN1 + s1p) * (FN2 * 2) * CW;
#pragma unroll
        for (int i = 0; i < 16; ++i) { const int idx = i * NTHR + tid, row = idx >> 6, piece = idx & 63;
            const v4u v = *(const GAS v4u*)(Gt + (size_t)row * CW + 8 * piece);
            *(LAS v4u*)(F.lds + row * FC_P + piece * 16) = v; }
        __syncthreads();
        bf16x8v Bre[4], Bim[4];
#pragma unroll
        for (int ks = 0; ks < 4; ++ks) { const bf16* mp = MC + ((size_t)s1p * 128 + 16 * tt + (lane & 15)) * 128 + 32 * ks + 8 * (lane >> 4);
            Bre[ks] = *(const GAS bf16x8v*)mp; Bim[ks] = *(const GAS bf16x8v*)(mp + 64 * 128); }
        bf16x8v dfr[4][2][2];
#pragma unroll
        for (int ct = 0; ct < 4; ++ct)
#pragma unroll
            for (int pp = 0; pp < 2; ++pp)
#pragma unroll
                for (int hc = 0; hc < 2; ++hc) dfr[ct][pp][hc] = *(const GAS bf16x8v*)(DCH + ((((pp * 2 + hc) * 64 + 16 * ct + (lane & 15)) * 4 + (lane >> 4)) * 8));
        v2u y[4][4]; float ssq = 0.f;
#pragma unroll
        for (int g4 = 0; g4 < 4; ++g4) {
            f32x4 are[4], aim[4];
#pragma unroll
            for (int nt = 0; nt < 4; ++nt) { are[nt] = (f32x4){0.f, 0.f, 0.f, 0.f}; aim[nt] = (f32x4){0.f, 0.f, 0.f, 0.f};
#pragma unroll
                for (int ks = 0; ks < 4; ++ks) { const bf16x8v af = tr_pair(F.lds + (32 * ks + 8 * g + q) * FC_P + (256 * ch + 64 * g4 + 16 * nt) * 2 + 8 * p, 4 * FC_P);
                    are[nt] = __builtin_amdgcn_mfma_f32_16x16x32_bf16(af, Bre[ks], are[nt], 0, 0, 0);
                    aim[nt] = __builtin_amdgcn_mfma_f32_16x16x32_bf16(af, Bim[ks], aim[nt], 0, 0, 0); } }
            bf16x8v xf[2][2];
#pragma unroll
            for (int hc = 0; hc < 2; ++hc) {
                { v4u t; t.x = pk2(are[2 * hc][0], are[2 * hc][1]); t.y = pk2(are[2 * hc][2], are[2 * hc][3]); t.z = pk2(are[2 * hc + 1][0], are[2 * hc + 1][1]); t.w = pk2(are[2 * hc + 1][2], are[2 * hc + 1][3]); xf[0][hc] = __builtin_bit_cast(bf16x8v, t); }
                { v4u t; t.x = pk2(aim[2 * hc][0], aim[2 * hc][1]); t.y = pk2(aim[2 * hc][2], aim[2 * hc][3]); t.z = pk2(aim[2 * hc + 1][0], aim[2 * hc + 1][1]); t.w = pk2(aim[2 * hc + 1][2], aim[2 * hc + 1][3]); xf[1][hc] = __builtin_bit_cast(bf16x8v, t); }
            }
#pragma unroll
            for (int ct = 0; ct < 4; ++ct) { f32x4 ya = {0.f, 0.f, 0.f, 0.f};
#pragma unroll
                for (int pp = 0; pp < 2; ++pp)
#pragma unroll
                    for (int hc = 0; hc < 2; ++hc) ya = __builtin_amdgcn_mfma_f32_16x16x32_bf16(dfr[ct][pp][hc], xf[pp][hc], ya, 0, 0, 0);
                ya = ya * scale; y[g4][ct].x = pk2(ya[0], ya[1]); y[g4][ct].y = pk2(ya[2], ya[3]); ssq += (ya[0] * ya[0] + ya[1] * ya[1]) + (ya[2] * ya[2] + ya[3] * ya[3]); }
        }
        ssq += __shfl_xor(ssq, 16); ssq += __shfl_xor(ssq, 32);
        if (lane < 16) ex[w * 16 + lane] = ssq;
        __syncthreads();
        const float tot = ex[w * 16 + (lane & 15)] + ex[(w ^ 4) * 16 + (lane & 15)];
        const float rf = 1.0f / sqrtf(tot * (1.f / CW) + EPS);
        const int t = b * SEQ + s1p + 128 * (16 * tt + (lane & 15));
        bf16* yp = Y + (size_t)t * D + CW + 256 * ch + 4 * (lane >> 4);
#pragma unroll
        for (int g4 = 0; g4 < 4; ++g4)
#pragma unroll
            for (int ct = 0; ct < 4; ++ct) { const v2u p = y[g4][ct]; v2u o; o.x = pk2(bflo(p.x) * rf, bfhi(p.x) * rf); o.y = pk2(bflo(p.y) * rf, bfhi(p.y) * rf); *(GAS v2u*)(yp + 64 * g4 + 16 * ct) = o; }
    }
}
typedef float f32x16 __attribute__((ext_vector_type(16)));
constexpr int AT_P = 528;
__device__ __forceinline__ void attn_phase(Frame& F) {
    const bf16* Q = (const bf16*)(F.ws + WS_Q); const bf16* KB = (const bf16*)(F.ws + WS_KB); const bf16* VT = (const bf16*)(F.ws + WS_VT); unsigned char* O = F.ws + WS_O;
    const int tid = F.tid(), lane = F.lane(), w = F.wave, r = lane & 31, h = lane >> 5, pr = (r & ~12) | ((r & 4) << 1) | ((r & 8) >> 1);
    for (int unit = F.vcu; unit < BATCH * NH * (SEQ / 256); unit += F.G) {
        const int bh = unit >> 5, qt = unit & 31, b = bh >> 2, hh = bh & 3;
        const int t0 = b * SEQ + qt * 256 + 32 * w;
        bf16x8v qf[16];
#pragma unroll
        for (int ds = 0; ds < 16; ++ds) qf[ds] = *(const GAS bf16x8v*)(Q + (size_t)(t0 + r) * D + hh * HD + 16 * ds + 8 * h);
        __syncthreads();
#pragma unroll
        for (int i = 0; i < 16; ++i) { const int idx = i * NTHR + tid, row = idx >> 5, piece = idx & 31;
            const v4u v = *(const GAS v4u*)(KB + (size_t)(b * MEMLEN + row) * D + hh * HD + 8 * piece);
            *(LAS v4u*)(F.lds + row * AT_P + piece * 16) = v; }
        __syncthreads();
        f32x16 sacc[8];
#pragma unroll
        for (int kt = 0; kt < 8; ++kt) {
#pragma unroll
            for (int i = 0; i < 16; ++i) sacc[kt][i] = 0.f;
#pragma unroll
            for (int ds = 0; ds < 16; ++ds) { const bf16x8v kf = *(const LAS bf16x8v*)(F.lds + (32 * kt + pr) * AT_P + (16 * ds + 8 * h) * 2);
                sacc[kt] = __builtin_amdgcn_mfma_f32_32x32x16_bf16(kf, qf[ds], sacc[kt], 0, 0, 0); }
        }
        float mx = -INFINITY;
#pragma unroll
        for (int kt = 0; kt < 8; ++kt)
#pragma unroll
            for (int i = 0; i < 16; ++i) mx = fmaxf(mx, sacc[kt][i]);
        mx = fmaxf(mx, __shfl_xor(mx, 32));
        float sum = 0.f; bf16x8v pf[8][2];
#pragma unroll
        for (int kt = 0; kt < 8; ++kt)
#pragma unroll
            for (int s2 = 0; s2 < 2; ++s2) { float pv[8];
#pragma unroll
                for (int j = 0; j < 8; ++j) { pv[j] = __builtin_amdgcn_exp2f(sacc[kt][8 * s2 + j] - mx); sum += pv[j]; }
                v4u t; t.x = pk2(pv[0], pv[1]); t.y = pk2(pv[2], pv[3]); t.z = pk2(pv[4], pv[5]); t.w = pk2(pv[6], pv[7]); pf[kt][s2] = __builtin_bit_cast(bf16x8v, t); }
        sum += __shfl_xor(sum, 32);
        const float inv = 1.0f / sum;
        __syncthreads();
#pragma unroll
        for (int i = 0; i < 16; ++i) { const int idx = i * NTHR + tid, row = idx >> 5, piece = idx & 31;
            const v4u v = *(const GAS v4u*)(VT + (size_t)(hh * HD + row) * MKV + b * MEMLEN + 8 * piece);
            *(LAS v4u*)(F.lds + row * AT_P + piece * 16) = v; }
        __syncthreads();
        unsigned char* op = O + (size_t)(t0 + r) * D + hh * HD + 4 * h;
#pragma unroll
        for (int dt = 0; dt < 8; ++dt) { f32x16 oacc;
#pragma unroll
            for (int i = 0; i < 16; ++i) oacc[i] = 0.f;
#pragma unroll
            for (int kt = 0; kt < 8; ++kt)
#pragma unroll
                for (int s2 = 0; s2 < 2; ++s2) { const bf16x8v vf = *(const LAS bf16x8v*)(F.lds + (32 * dt + r) * AT_P + (32 * kt + 16 * s2 + 8 * h) * 2);
                    oacc = __builtin_amdgcn_mfma_f32_32x32x16_bf16(vf, pf[kt][s2], oacc, 0, 0, 0); }
#pragma unroll
            for (int i = 0; i < 4; ++i) *(GAS unsigned*)(op + 32 * dt + 8 * i) = pg8::pk4_fp8(oacc[4 * i] * inv, oacc[4 * i + 1] * inv, oacc[4 * i + 2] * inv, oacc[4 * i + 3] * inv);
        }
    }
}
constexpr int RT_P = 2064;
constexpr int RT_LO = 32 * RT_P, RT_PART = 2 * 32 * RT_P, RT_SQP = RT_PART + 8192, RT_RSB = RT_SQP + 256, RT_HIST = RT_RSB + 256, RT_BASE = RT_HIST + 128;
static_assert(RT_BASE + 128 <= MOE_TAB_OFF, "router LDS map");
__device__ __forceinline__ void router_phase(Frame& F, const Args& a, int blk0, unsigned long long* gs1) {
    const bf16* XR = (const bf16*)(F.ws + WS_XR); unsigned char* XN3 = F.ws + WS_XN3; const float* wrgT = (const float*)(F.ws + WS_WRG);
    int* tok_e = (int*)(F.ws + WS_TOK); float* tok_w = (float*)(F.ws + WS_TOK + 256 * 1024); int* tok_rank = (int*)(F.ws + WS_TOK + 512 * 1024);
    int* etok = (int*)(F.ws + WS_ETOK); unsigned* ctl = (unsigned*)(F.ws + WS_CTL);
    const int tid = F.tid(), lane = F.lane(), w = F.wave, tt = w & 3, kh = w >> 2, li = lane & 15, kq = lane >> 4;
    LAS float* part = (LAS float*)(F.lds + RT_PART); LAS float* sqp = (LAS float*)(F.lds + RT_SQP); LAS float* rsb = (LAS float*)(F.lds + RT_RSB);
    LAS unsigned* hist = (LAS unsigned*)(F.lds + RT_HIST); LAS unsigned* base = (LAS unsigned*)(F.lds + RT_BASE);
    const float* gain = a.in[14]; const float* brt = a.in[16];
    __syncthreads();
#pragma unroll
    for (int i = 0; i < 16; ++i) { const int idx = i * NTHR + tid, e = idx >> 8, piece = idx & 255;
        const f32x4 v = *(const GAS f32x4*)(wrgT + (size_t)e * D + 4 * piece);
        v2u hi; hi.x = pk2(v.x, v.y); hi.y = pk2(v.z, v.w);
        v2u lo; lo.x = pk2(v.x - bflo(hi.x), v.y - bfhi(hi.x)); lo.y = pk2(v.z - bflo(hi.y), v.w - bfhi(hi.y));
        *(LAS v2u*)(F.lds + e * RT_P + piece * 8) = hi; *(LAS v2u*)(F.lds + RT_LO + e * RT_P + piece * 8) = lo; }
    if (tid < NE) hist[tid] = 0u;
    if (gs1) group_sync(ctl + CW_BAR, gs1, (unsigned*)gs1 + 2, F.wave == 0 && lane_id() == 0);
    f32x4 gv[4];
#pragma unroll
    for (int j = 0; j < 4; ++j) gv[j] = ((const GAS f32x4*)gain + lane)[64 * j];
    for (int blk = blk0; blk < M / 64; blk += F.G) {
        __syncthreads();
        const int t = blk * 64 + 16 * tt + li;
        f32x4 acc[2]; acc[0] = (f32x4){0.f, 0.f, 0.f, 0.f}; acc[1] = (f32x4){0.f, 0.f, 0.f, 0.f}; float ssq = 0.f;
        const bf16* xp = XR + (size_t)t * D + 512 * kh + 8 * kq;
        bf16x8v xb[16];
#pragma unroll
        for (int ks = 0; ks < 16; ++ks) xb[ks] = *(const GAS bf16x8v*)(xp + 32 * ks);
        v2u xw[8][4];
#pragma unroll
        for (int i = 0; i < 8; ++i) { const GAS v2u* xr = (const GAS v2u*)(XR + (size_t)(blk * 64 + 8 * w + i) * D) + lane;
#pragma unroll
            for (int j = 0; j < 4; ++j) xw[i][j] = xr[64 * j]; }
#pragma unroll
        for (int ks = 0; ks < 16; ++ks) {
            { const v4u u4 = __builtin_bit_cast(v4u, xb[ks]); const float x0 = bflo(u4.x), x1 = bfhi(u4.x), x2 = bflo(u4.y), x3 = bfhi(u4.y), x4 = bflo(u4.z), x5 = bfhi(u4.z), x6 = bflo(u4.w), x7 = bfhi(u4.w);
              ssq += ((x0 * x0 + x1 * x1) + (x2 * x2 + x3 * x3)) + ((x4 * x4 + x5 * x5) + (x6 * x6 + x7 * x7)); }
#pragma unroll
            for (int mt = 0; mt < 2; ++mt) { const int off = (16 * mt + li) * RT_P + (512 * kh + 32 * ks + 8 * kq) * 2;
                const bf16x8v whi = *(const LAS bf16x8v*)(F.lds + off), wlo = *(const LAS bf16x8v*)(F.lds + RT_LO + off);
                acc[mt] = __builtin_amdgcn_mfma_f32_16x16x32_bf16(whi, xb[ks], acc[mt], 0, 0, 0);
                acc[mt] = __builtin_amdgcn_mfma_f32_16x16x32_bf16(wlo, xb[ks], acc[mt], 0, 0, 0); }
        }
        ssq += __shfl_xor(ssq, 16); ssq += __shfl_xor(ssq, 32);
        if (kh == 1) {
#pragma unroll
            for (int mt = 0; mt < 2; ++mt)
#pragma unroll
                for (int rg = 0; rg < 4; ++rg) part[(tt * 32 + 16 * mt + 4 * kq + rg) * 16 + li] = acc[mt][rg];
            if (lane < 16) sqp[tt * 16 + lane] = ssq;
        }
        __syncthreads();
        int my_e = 0; float my_w = 0.f; unsigned my_lr = 0u;
        if (kh == 0) {
            const float rs = 1.0f / sqrtf((ssq + sqp[tt * 16 + li]) * (1.f / D) + EPS);
            if (kq == 0) rsb[16 * tt + li] = rs;
            float val[8];
#pragma unroll
            for (int mt = 0; mt < 2; ++mt)
#pragma unroll
                for (int rg = 0; rg < 4; ++rg) { const int e = 16 * mt + 4 * kq + rg; val[4 * mt + rg] = (acc[mt][rg] + part[(tt * 32 + e) * 16 + li]) * rs + brt[e]; }
            float sv[4]; int se[4];
#pragma unroll
            for (int k = 0; k < TOPK; ++k) {
                float bv = val[0]; int be = 4 * kq;
#pragma unroll
                for (int i = 1; i < 8; ++i) { const int e = 16 * (i >> 2) + 4 * kq + (i & 3); if (val[i] > bv) { bv = val[i]; be = e; } }
#pragma unroll
                for (int o = 16; o < 64; o <<= 1) { const float ov = __shfl_xor(bv, o); const int oe = __shfl_xor(be, o); if (ov > bv || (ov == bv && oe < be)) { bv = ov; be = oe; } }
                sv[k] = bv; se[k] = be;
#pragma unroll
                for (int i = 0; i < 8; ++i) { const int e = 16 * (i >> 2) + 4 * kq + (i & 3); if (e == be) val[i] = -INFINITY; }
            }
            float wk[4]; float wsum = 0.f;
#pragma unroll
            for (int k = 0; k < TOPK; ++k) { wk[k] = __expf(sv[k] - sv[0]); wsum += wk[k]; }
            my_e = (kq == 0) ? se[0] : (kq == 1) ? se[1] : (kq == 2) ? se[2] : se[3];
            my_w = ((kq == 0) ? wk[0] : (kq == 1) ? wk[1] : (kq == 2) ? wk[2] : wk[3]) / wsum;
            my_lr = __hip_atomic_fetch_add(hist + my_e, 1u, __ATOMIC_RELAXED, __HIP_MEMORY_SCOPE_WORKGROUP);
        }
        __syncthreads();
        unsigned basev = 0u;
        if (tid < NE) { const unsigned c = hist[tid]; basev = c ? __hip_atomic_fetch_add(ctl + CW_CNT + 64 * tid, c, RLX_AGENT) : 0u; hist[tid] = 0u; }
#pragma unroll
        for (int i = 0; i < 8; ++i) { const int tk = blk * 64 + 8 * w + i; const float rs = rsb[8 * w + i]; GAS unsigned* o4 = (GAS unsigned*)(XN3 + (size_t)tk * D) + lane;
#pragma unroll
            for (int j = 0; j < 4; ++j) { const v2u x2 = xw[i][j]; const f32x4 g = gv[j];
                o4[64 * j] = pg8::pk4_fp8(bflo(x2.x) * rs * g.x, bfhi(x2.x) * rs * g.y, bflo(x2.y) * rs * g.z, bfhi(x2.y) * rs * g.w); } }
        if (tid < NE) base[tid] = basev;
        __syncthreads();
        if (kh == 0) { const unsigned rank = base[my_e] + my_lr;
            tok_e[t * 4 + kq] = my_e; tok_w[t * 4 + kq] = my_w; tok_rank[t * 4 + kq] = (int)rank; etok[(size_t)my_e * ECAP + rank] = t; }
    }
}
__device__ __forceinline__ int moe_tables(Frame& F) {
    LAS int* tile_e = (LAS int*)(F.lds + MOE_TAB_OFF); LAS int* tile0 = tile_e + 320; LAS int* cnt = tile0 + 40;
    const unsigned* ctl = (const unsigned*)(F.ws + WS_CTL);
    __syncthreads();
    if (F.tid() < NE) cnt[F.tid()] = (int)__hip_atomic_load(ctl + CW_CNT + 64 * F.tid(), RLX_AGENT);
    __syncthreads();
    if (F.tid() == 0) { int acc = 0; for (int e = 0; e < NE; ++e) { tile0[e] = acc; acc += (cnt[e] + 255) >> 8; } tile0[NE] = acc; }
    __syncthreads();
    const int R = tile0[NE];
    for (int rt = F.tid(); rt < R; rt += NTHR) { int e = 0; for (int q = 0; q < NE; ++q) if (rt >= tile0[q] && rt < tile0[q + 1]) e = q; tile_e[rt] = e; }
    __syncthreads();
    return R;
}
__device__ __forceinline__ void combine_phase(Frame& F, const Args& a) {
    const bf16* XR = (const bf16*)(F.ws + WS_XR); const unsigned char* CTR = F.ws + WS_CTR;
    const int* tok_e = (const int*)(F.ws + WS_TOK); const float* tok_w = (const float*)(F.ws + WS_TOK + 256 * 1024); const int* tok_rank = (const int*)(F.ws + WS_TOK + 512 * 1024);
    LAS int* tile0 = (LAS int*)(F.lds + MOE_TAB_OFF) + 320;
    const int gw = F.vcu * NWAVES + F.wave, NGW = F.G * NWAVES, lane = F.lane();
    const float* gain = a.in[21];
    constexpr int TPW = 8;
    const GAS f32x4* gr = (const GAS f32x4*)gain; const f32x4 gv[4] = {gr[2 * lane], gr[2 * lane + 1], gr[128 + 2 * lane], gr[128 + 2 * lane + 1]};
    for (int tb = gw * TPW; tb < M; tb += NGW * TPW) {
        int myslot = 0; float myw = 0.f;
        if (lane < 4 * TPW) { const int q = (tb + (lane >> 2)) * 4 + (lane & 3); const int e = tok_e[q]; myw = tok_w[q]; myslot = tile0[e] * 256 + tok_rank[q]; }
#pragma unroll 4
        for (int i = 0; i < TPW; ++i) {
            const int t = tb + i;
            const GAS v4u* xr = (const GAS v4u*)(XR + (size_t)t * D);
            v4u xw[2]; v2u cw[4][2]; float wk[4];
            xw[0] = xr[lane]; xw[1] = xr[64 + lane];
#pragma unroll
            for (int k = 0; k < TOPK; ++k) { const int slot = __builtin_amdgcn_readlane(myslot, 4 * i + k); wk[k] = __builtin_bit_cast(float, __builtin_amdgcn_readlane(__builtin_bit_cast(int, myw), 4 * i + k));
                const GAS v2u* cp = (const GAS v2u*)(CTR + (size_t)slot * D); cw[k][0] = cp[lane]; cw[k][1] = cp[64 + lane]; }
            f32x4 v[4]; float s = 0.f;
#pragma unroll
            for (int h = 0; h < 2; ++h) { v[2 * h] = (f32x4){bflo(xw[h].x), bfhi(xw[h].x), bflo(xw[h].y), bfhi(xw[h].y)}; v[2 * h + 1] = (f32x4){bflo(xw[h].z), bfhi(xw[h].z), bflo(xw[h].w), bfhi(xw[h].w)};
#pragma unroll
                for (int k = 0; k < TOPK; ++k) {
#pragma unroll
                    for (int u = 0; u < 2; ++u) { const int cwd = (int)(u ? cw[k][h].y : cw[k][h].x); const f32x2v lo = __builtin_amdgcn_cvt_pk_f32_fp8(cwd, false), hi = __builtin_amdgcn_cvt_pk_f32_fp8(cwd, true);
                        v[2 * h + u].x += wk[k] * lo.x; v[2 * h + u].y += wk[k] * lo.y; v[2 * h + u].z += wk[k] * hi.x; v[2 * h + u].w += wk[k] * hi.y; } }
#pragma unroll
                for (int u = 0; u < 2; ++u) s += (v[2 * h + u].x * v[2 * h + u].x + v[2 * h + u].y * v[2 * h + u].y) + (v[2 * h + u].z * v[2 * h + u].z + v[2 * h + u].w * v[2 * h + u].w); }
            const float rs = 1.0f / sqrtf(wave_sum(s) * (1.f / D) + EPS);
            GAS f32x4* op = (GAS f32x4*)(a.out + (size_t)t * D);
#pragma unroll
            for (int h = 0; h < 2; ++h)
#pragma unroll
                for (int u = 0; u < 2; ++u) { const f32x4 g = gv[2 * h + u], w4 = v[2 * h + u]; op[128 * h + 2 * lane + u] = (f32x4){w4.x * rs * g.x, w4.y * rs * g.y, w4.z * rs * g.z, w4.w * rs * g.w}; }
        }
    }
}

struct MoeSel { int nM, lo, start, stride, limit, xhas, xnM, xlo, xslot; };
__device__ __forceinline__ bool moe_plan(int R, int G, int y, int w, int which, MoeSel& s) {
    if (G != 256 || R <= 256 || R > 288) return false;
    int NI = 0, pre = 0; bool bad = false;
#pragma unroll
    for (int yy = 0; yy < 8; ++yy) { const int l0 = (yy * R) >> 3, nj = (((yy + 1) * R) >> 3) - l0, left = 8 * nj - 256;
        bad = bad || left < 0 || left > 32; NI += 32 - left; pre += (yy < y) ? 32 - left : 0; }
    if (bad || NI < 4 * R - 1024) return false;
    if (which < 0) return true;
    const int l0 = (y * R) >> 3, nj = (((y + 1) * R) >> 3) - l0, left = 8 * nj - 256;
    s.nM = nj; s.lo = l0; s.start = w; s.stride = 32; s.xhas = 0; s.xnM = 0; s.xlo = 0; s.xslot = 0;
    if (which == 0) { s.limit = 8 * nj; return true; }
    s.limit = 128;
    if (w >= left) { int e = pre + (w - left); bool found = false;
#pragma unroll
        for (int yy = 0; yy < 8; ++yy) { const int m0 = (yy * R) >> 3, mj = (((yy + 1) * R) >> 3) - m0, Ex = 4 * mj - 128;
            if (!found) { if (e < Ex) { found = true; s.xhas = 1; s.xnM = mj; s.xlo = m0; s.xslot = 128 + e; } else e -= Ex; } } }
    return true;
}

constexpr int NPHASE = 14;
__global__ void __launch_bounds__(NTHR, 2) mk_fwd(Args args) {
    extern __shared__ __attribute__((aligned(16))) unsigned char lds[];
    Frame F;
    F.lds = (LAS unsigned char*)lds; F.ws = args.ws;
    F.wave = __builtin_amdgcn_readfirstlane((int)threadIdx.x >> 6);
    F.G = gridDim.x; { const int bx = blockIdx.x; F.vcu = (F.G % 8 == 0) ? (bx % 8) * (F.G / 8) + bx / 8 : bx; }
    unsigned char* ws = args.ws;
    for (int u = F.tid(); u < (LDS_BYTES - LDSCTL_OFF) / 4; u += NTHR) ((LAS unsigned*)(F.lds + LDSCTL_OFF))[u] = 0u;
    __syncthreads();
    volatile LAS unsigned* MISC = (volatile LAS unsigned*)(F.lds + MISC_OFF);
    XcdBarrier bar; bar.bar = (unsigned*)(ws + WS_CTL) + CW_BAR; bar.x = 0; bar.st = nullptr;
#if MK_ONE_LAUNCH
    bar = xcd_barrier_post((unsigned*)(ws + WS_CTL) + CW_BAR, MISC + 8, F.wave == 0 && lane_id() == 0);
#define GRID_BAR() xcd_barrier(bar, F.wave == 0 && lane_id() == 0)
#else
#define GRID_BAR() do { } while (0)
#endif
    const int lo = args.ph_lo, hi = args.ph_hi;
#define IN(k) (lo <= (k) && (k) < hi)
#define REP(k) for (int _rep = 0; _rep < (((MK_DUP) >> (k)) & 1) + 1; ++_rep)
#define SEAM(k) do { if (IN(k) && IN((k) + 1)) GRID_BAR(); } while (0)
    int gpm = 0, gpn = 0; const bool lsync = MK_ONE_LAUNCH && (F.G == (M / 256) * (D / 256));
    if (lsync) { pg8::StaticOrder S0; S0.init(M, D, F.G, (int)blockIdx.x); pg8::Unit u0; (void)S0.next(0, u0); gpm = u0.pm; gpn = u0.pn; }
#define GSW(s) ((unsigned long long*)((unsigned*)(ws + WS_CTL) + CW_GRP + 64 * (64 * (s) + gpm)))
#define LSEAM(k, s) do { if (IN(k) && IN((k) + 1)) { if (lsync) group_sync((unsigned*)(ws + WS_CTL) + CW_BAR, GSW(s), (unsigned*)GSW(s) + 2, F.wave == 0 && lane_id() == 0); else GRID_BAR(); } } while (0)
    using pg8::Gemm; using pg8::StaticOrder; using pg8::GroupedOrder; using pg8::gemm_phase; using pg8::bf16_t; using pg8::EpiBf16; using pg8::EpiRowScaleBf16; using pg8::EpiResidIn; using pg8::EpiResidBf; using pg8::EpiSwiGLU; using pg8::EpiBiasF8; using pg8::EpiSoftmaxF8;
    if (IN(0)) REP(0) { p0_prologue(F, args); } SEAM(0);
    if (IN(1)) REP(1) { Gemm g{(const bf16_t*)(ws + WS_XN), (const bf16_t*)(ws + WS_WINT), D, 0}; StaticOrder S; S.init(M, NZ, F.G, (int)blockIdx.x);
        const bool split = (F.G % 16) == 0; const int grp = split ? (((int)blockIdx.x >> 3) & 1) : 0, ng = split ? F.G / 2 : F.G;
        const int gi = split ? (((int)blockIdx.x >> 4) * 8 + ((int)blockIdx.x & 7)) : (int)blockIdx.x, mlo = (split && grp) ? MOE_ITEMS / 2 : 0, mhi = (split && !grp) ? MOE_ITEMS / 2 : MOE_ITEMS;
        if (grp == 0) { p0_moe_stream(F, args, mlo, mhi, gi * NWAVES + F.wave, ng * NWAVES); __syncthreads(); }
        EpiBf16 E{(bf16_t*)(ws + WS_Z), NZ, 1.0f}; gemm_phase<EpiBf16, StaticOrder, true>(F.lds, g, S, E, F.wave);
        if (grp == 1) { __syncthreads(); p0_moe_stream(F, args, mlo, mhi, gi * NWAVES + F.wave, ng * NWAVES); } } SEAM(1);
    if (IN(3)) REP(3) {
        const bool split = F.G >= 64;
        if (!split || blockIdx.x < 16) {
            { Gemm g{(const bf16_t*)(ws + WS_MEMN), (const bf16_t*)(ws + WS_WKT), D / 2, 0}; StaticOrder S; S.init(MKV, D, F.G, (int)blockIdx.x);
              EpiBf16 E{(bf16_t*)(ws + WS_KB), D, 1.0f / WSCALE}; gemm_phase<EpiBf16, StaticOrder, true, true>(F.lds, g, S, E, F.wave); }
            { Gemm g{(const bf16_t*)(ws + WS_MEMN), (const bf16_t*)(ws + WS_WVT), D / 2, 0}; StaticOrder S; S.init(MKV, D, F.G, (int)((blockIdx.x + F.G - 8) % F.G));
              EpiBf16 E{(bf16_t*)(ws + WS_VT), D, 1.0f / WSCALE}; gemm_phase<EpiBf16, StaticOrder, true, true>(F.lds, g, S, E, F.wave); }
        }
        if (!split) conv_phase(F, args, F.vcu, F.G); else if (blockIdx.x >= 16) conv_phase(F, args, (int)blockIdx.x - 16, F.G - 16);
        fftA_phase(F); } SEAM(3);
    if (IN(4)) REP(4) { absorb_phase(F); fftC_phase(F); } SEAM(4);
    if (IN(6)) REP(6) { Gemm g{(const bf16_t*)(ws + WS_Y), (const bf16_t*)(ws + WS_WOUTT), D, 0}; StaticOrder S; S.init(M, D, F.G, (int)blockIdx.x);
        EpiResidIn E{args.in[0], (bf16_t*)(ws + WS_XR), ws + WS_XB, (float*)(ws + WS_CTL) + CW_ROWSQ, D}; gemm_phase<EpiResidIn, StaticOrder, false>(F.lds, g, S, E, F.wave); } LSEAM(6, 0);
    if (IN(7)) REP(7) { Gemm g{(const bf16_t*)(ws + WS_XB), (const bf16_t*)(ws + WS_MK), D / 2, MiB}; StaticOrder S; S.init(M, D, F.G, (int)blockIdx.x, 5);
        EpiSoftmaxF8 E{ws + WS_P, D, (const float*)(ws + WS_CTL) + CW_ROWSQ, 1.0f / D, EPS, QSCALE / WSCALE, (LAS float*)(F.lds + RING_BYTES)}; gemm_phase<EpiSoftmaxF8, StaticOrder, true, true>(F.lds, g, S, E, F.wave); } LSEAM(7, 1);
    if (IN(9)) REP(9) { Gemm g{(const bf16_t*)(ws + WS_P), (const bf16_t*)(ws + WS_MV), D / 2, MiB}; StaticOrder S; S.init(M, D, F.G, (int)blockIdx.x, 5);
        EpiResidBf E{(bf16_t*)(ws + WS_XR), D, 1.0f / (128.0f * WSCALE)}; gemm_phase<EpiResidBf, StaticOrder, false, true>(F.lds, g, S, E, F.wave); } if (!lsync) SEAM(9);
    if (IN(10)) REP(10) { router_phase(F, args, lsync ? 4 * gpm + gpn : F.vcu, (lsync && IN(9)) ? GSW(2) : nullptr); } SEAM(10);
    if (IN(11) || IN(12)) {
        const int R = moe_tables(F);
        LAS int* tile_e = (LAS int*)(F.lds + MOE_TAB_OFF);
        const int cy = (int)blockIdx.x & 7, cw = (int)blockIdx.x >> 3;
        bool df; { MoeSel m0; df = MK_ONE_LAUNCH && IN(11) && IN(12) && moe_plan(R, F.G, cy, cw, -1, m0); }
        unsigned* ctlw = (unsigned*)(ws + WS_CTL);
        if (IN(11)) { MoeSel ms = {0, 0, 0, 0, 0, 0, 0, 0, 0}; if (df) (void)moe_plan(R, F.G, cy, cw, 0, ms);
            GroupedOrder<true> S; S.nM = df ? ms.nM : R; S.nN = 2 * DE / 256; S.nwg = R * S.nN; S.G = F.G; S.c = (int)blockIdx.x; S.own = df ? 1 : 0; S.lo = ms.lo; S.start = ms.start; S.stride = ms.stride; S.limit = ms.limit;
            S.xhas = 0; S.xnM = 0; S.xlo = 0; S.xslot = 0; S.done = df ? ctlw + CW_DONE : nullptr; S.tmo = ctlw + CW_BAR + XB_TMO;
            S.tile_e = tile_e; S.tile0 = tile_e + 320; S.cnt = tile_e + 360; S.etok = (const int*)(ws + WS_ETOK); S.ecap = ECAP;
            { LAS int* rowtok = (LAS int*)(F.lds + RING_BYTES); pg8::Unit u;
              for (int ui = 0; ui < 12 && S.next(ui, u); ++ui) if (F.tid() < 256) { const int idx = (u.pm - S.tile0[u.e]) * 256 + F.tid(); rowtok[ui * 256 + F.tid()] = idx < S.cnt[u.e] ? S.etok[(size_t)u.e * ECAP + idx] : 0; }
              __syncthreads(); S.rowtok = rowtok; }
            Gemm g{(const bf16_t*)(ws + WS_XN3), (const bf16_t*)(ws + WS_WGUT), D / 2, WGU6_E};
            EpiSwiGLU E{ws + WS_ACT, args.in[18], 1.0f / W6SCALE, df}; gemm_phase<EpiSwiGLU, GroupedOrder<true>, true, 2>(F.lds, g, S, E, F.wave); }
        if (!df) SEAM(11);
        if (IN(12)) { MoeSel ms = {0, 0, 0, 0, 0, 0, 0, 0, 0}; if (df) (void)moe_plan(R, F.G, cy, cw, 1, ms);
            GroupedOrder<false> S; S.nM = df ? ms.nM : R; S.nN = D / 256; S.nwg = R * S.nN; S.G = F.G; S.c = (int)blockIdx.x; S.own = df ? 1 : 0; S.lo = ms.lo; S.start = ms.start; S.stride = ms.stride; S.limit = ms.limit;
            S.xhas = ms.xhas; S.xnM = ms.xnM; S.xlo = ms.xlo; S.xslot = ms.xslot; S.done = df ? ctlw + CW_DONE : nullptr; S.tmo = ctlw + CW_BAR + XB_TMO;
            S.tile_e = tile_e; S.tile0 = tile_e + 320; S.cnt = tile_e + 360; S.etok = nullptr; S.ecap = ECAP; S.rowtok = nullptr;
            Gemm g{(const bf16_t*)(ws + WS_ACT), (const bf16_t*)(ws + WS_WDT), DE / 2, WDN6_E};
            EpiBiasF8 E{ws + WS_CTR, args.in[20], 1.0f / W6SCALE}; gemm_phase<EpiBiasF8, GroupedOrder<false>, true, 2>(F.lds, g, S, E, F.wave); }
        SEAM(12);
    }
    if (IN(13)) REP(13) { (void)moe_tables(F); combine_phase(F, args); }
#undef IN
#undef SEAM
}

extern "C" void kernel_launch(void* const* d_in, const int* in_sizes, int n_in, void* d_out, int out_size, void* d_ws, size_t ws_size, hipStream_t stream) {
    static int grid = 0;
    if (grid == 0) {
        if (n_in != 22 || in_sizes[0] != M * D || out_size != M * D || ws_size < WS_END) { fprintf(stderr, "kernel_launch: unexpected problem (n_in %d, in0 %d, out %d, ws %zu)\n", n_in, n_in > 0 ? in_sizes[0] : -1, out_size, ws_size); grid = -1; return; }
        int dev = 0, cus = 0;
        if (hipGetDevice(&dev) != hipSuccess || hipDeviceGetAttribute(&cus, hipDeviceAttributeMultiprocessorCount, dev) != hipSuccess) { grid = -1; return; }
        if (hipFuncSetAttribute((const void*)mk_fwd, hipFuncAttributeMaxDynamicSharedMemorySize, LDS_BYTES) != hipSuccess) { fprintf(stderr, "kernel_launch: hipFuncSetAttribute failed\n"); grid = -1; return; }
        int per_cu = 0;
        if (hipOccupancyMaxActiveBlocksPerMultiprocessor(&per_cu, (const void*)mk_fwd, NTHR, LDS_BYTES) != hipSuccess || per_cu < 1) fprintf(stderr, "kernel_launch: occupancy query reports %d\n", per_cu);
        (void)hipGetLastError();
        grid = cus;
    }
    if (grid < 0) return;
    if (hipMemsetAsync((char*)d_ws + WS_CTL, 0, CTL_ZERO_BYTES, stream) != hipSuccess) return;
    Args a{};
    for (int i = 0; i < 22; ++i) a.in[i] = (const float*)d_in[i];
    a.out = (float*)d_out; a.ws = (unsigned char*)d_ws;
#if MK_ONE_LAUNCH
    a.ph_lo = 0; a.ph_hi = NPHASE;
    hipLaunchKernelGGL(mk_fwd, dim3(grid), dim3(NTHR), LDS_BYTES, stream, a);
#else
    for (int p = 0; p < NPHASE; ++p) { a.ph_lo = p; a.ph_hi = p + 1; hipLaunchKernelGGL(mk_fwd, dim3(grid), dim3(NTHR), LDS_BYTES, stream, a); }
#endif
}
```
